# Optimizing an MI355X kernel written in HIP

```python
import math
import jax
import jax.numpy as jnp
from jax import lax
import numpy as np

D_MODEL = 1024
BATCH = 8
SEQ = 2048
DEPTH = 2
DEC_BATCH = 128
DEC_SEQ = 4
PAST_LEN = 16384
PAGE_SIZE = 128

MIX_WIDTH = D_MODEL
GROUP_WIDTH = MIX_WIDTH // 4
HEAD_DIM = 64
A_WIDTH = GROUP_WIDTH
A_HEADS = A_WIDTH // HEAD_DIM
A_CHUNK = 128
B_WIDTH = GROUP_WIDTH
B_HEADS = B_WIDTH // HEAD_DIM
B_DK = HEAD_DIM
B_DV = HEAD_DIM
B_CONV = 4
B_CHUNK = 64
C_WIDTH = GROUP_WIDTH
C_HEADS = C_WIDTH // HEAD_DIM
C_HD = HEAD_DIM
C_DECAY_LORA = 64
C_AAA_LORA = 64
C_GATE_LORA = 128
C_PROJ = 3 * C_WIDTH + C_DECAY_LORA + C_AAA_LORA + C_GATE_LORA
D_WIDTH = GROUP_WIDTH
POOL_WINDOWS = (2, 4, 8, 16)
D_GROUPS = len(POOL_WINDOWS)
D_GC = D_WIDTH // D_GROUPS
POOL_BUF = max(POOL_WINDOWS) - 1
D_FF = 4 * D_MODEL
NORM_EPS = 1e-6
L2_EPS = 1e-6
GN_EPS = 64e-5
A_COLS = 2 * A_WIDTH
B_COLS = 4 * B_WIDTH + 2 * B_HEADS
B_OFF = A_COLS
C_OFF = B_OFF + B_COLS
D_OFF = C_OFF + C_PROJ
IN_COLS = D_OFF + D_WIDTH

kernel_name = 'hybrid_gmlp_gdn_rwkv7_pool_step'


def rmsnorm(x, g):
    xf = x.astype(jnp.float32)
    y = xf * lax.rsqrt(jnp.mean(xf * xf, axis=-1, keepdims=True) + NORM_EPS)
    return (y * g.astype(jnp.float32)).astype(x.dtype)


def l2norm(x):
    xf = x.astype(jnp.float32)
    return xf * lax.rsqrt(jnp.sum(xf * xf, axis=-1, keepdims=True) + L2_EPS)


def chunk_gmlp(ap, ws, bs, vg):
    bn, L, _ = ap.shape
    u = jax.nn.gelu(ap[..., :A_WIDTH])
    v = rmsnorm(jax.nn.gelu(ap[..., A_WIDTH:]), vg)
    pad = (-L) % A_CHUNK
    vc = jnp.pad(v, ((0, 0), (0, pad), (0, 0))).reshape(bn, -1, A_CHUNK, A_HEADS, HEAD_DIM)
    causal = jnp.tril(jnp.ones((A_CHUNK, A_CHUNK), dtype=bool))
    wm = jnp.where(causal, ws, jnp.zeros_like(ws))
    mix = jnp.einsum('hts,bnshd->bnthd', wm, vc) + bs.T[None, None, :, :, None]
    mix = mix.reshape(bn, -1, A_WIDTH)[:, :L]
    return u * mix, v


def causal_dwconv(x, buf, w):
    K = w.shape[0]
    L = x.shape[1]
    xp = jnp.concatenate([buf.astype(x.dtype), x], axis=1)
    out = xp[:, 0:L] * w[0]
    for i in range(1, K):
        out = out + xp[:, i:i + L] * w[i]
    return out, xp[:, -(K - 1):]


def gated_delta_chunked(q, k, v, g, beta, S0):
    bn, L, H, dk = q.shape
    dv = v.shape[-1]
    C = B_CHUNK
    pad = (-L) % C
    if pad:
        pw = ((0, 0), (0, pad), (0, 0), (0, 0))
        q, k, v = jnp.pad(q, pw), jnp.pad(k, pw), jnp.pad(v, pw)
        g, beta = jnp.pad(g, pw[:3]), jnp.pad(beta, pw[:3])
    N = (L + pad) // C

    def blk(t):
        return jnp.moveaxis(t.reshape((bn, N, C) + t.shape[2:]), 3, 2)

    q, k, v, g, beta = blk(q), blk(k), blk(v), blk(g), blk(beta)
    G = jnp.cumsum(g, axis=-1)
    incl = jnp.tril(jnp.ones((C, C), dtype=bool))
    strict = jnp.tril(jnp.ones((C, C), dtype=bool), -1)
    decay = jnp.exp(jnp.where(incl, G[..., :, None] - G[..., None, :], -jnp.inf))
    kk = jnp.einsum('bnhid,bnhjd->bnhij', k, k)
    amat = jnp.eye(C, dtype=jnp.float32) + jnp.where(strict, beta[..., :, None] * kk * decay, 0.0)
    U = lax.linalg.triangular_solve(amat, beta[..., None] * v, left_side=True, lower=True,
                                    unit_diagonal=True)
    Wk = lax.linalg.triangular_solve(amat, (beta * jnp.exp(G))[..., None] * k, left_side=True,
                                     lower=True, unit_diagonal=True)
    QK = jnp.einsum('bnhid,bnhjd->bnhij', q, k) * decay
    Qg = q * jnp.exp(G)[..., None]
    Kt = k * jnp.exp(G[..., -1:] - G)[..., None]
    gl = jnp.exp(G[..., -1])

    def step(S, xs):
        u_n, wk_n, qk_n, qg_n, kt_n, gl_n = xs
        W = u_n - jnp.einsum('bhcd,bhde->bhce', wk_n, S)
        O = jnp.einsum('bhcd,bhde->bhce', qg_n, S) + jnp.einsum('bhij,bhje->bhie', qk_n, W)
        S = gl_n[..., None, None] * S + jnp.einsum('bhcd,bhce->bhde', kt_n, W)
        return S, O

    xs = tuple(jnp.moveaxis(t, 1, 0) for t in (U, Wk, QK, Qg, Kt, gl))
    S, O = lax.scan(step, S0, xs)
    O = jnp.transpose(O, (1, 0, 3, 2, 4)).reshape(bn, N * C, H, dv)[:, :L]
    return O, S


def gated_deltanet(bp, conv_buf, S0, conv_w, a_log, dt_bias, onorm_g):
    bn, L, _ = bp.shape
    qkv, new_buf = causal_dwconv(bp[..., :3 * B_WIDTH], conv_buf, conv_w)
    qkv = jax.nn.silu(qkv)
    gate = bp[..., 3 * B_WIDTH:4 * B_WIDTH].reshape(bn, L, B_HEADS, B_DV).astype(jnp.float32)
    beta_logit = bp[..., 4 * B_WIDTH:4 * B_WIDTH + B_HEADS].astype(jnp.float32)
    a_logit = bp[..., 4 * B_WIDTH + B_HEADS:].astype(jnp.float32)
    q = l2norm(qkv[..., :B_WIDTH].reshape(bn, L, B_HEADS, B_DK)) * (B_DK ** -0.5)
    k = l2norm(qkv[..., B_WIDTH:2 * B_WIDTH].reshape(bn, L, B_HEADS, B_DK))
    v = qkv[..., 2 * B_WIDTH:].reshape(bn, L, B_HEADS, B_DV).astype(jnp.float32)
    beta = jax.nn.sigmoid(beta_logit)
    g = -jnp.exp(a_log.astype(jnp.float32)) * jax.nn.softplus(a_logit + dt_bias.astype(jnp.float32))
    o, S = gated_delta_chunked(q, k, v, g, beta, S0.astype(jnp.float32))
    o = rmsnorm(o, onorm_g) * jax.nn.silu(gate)
    return o.reshape(bn, L, B_WIDTH).astype(bp.dtype), new_buf, S


def rwkv7_scan(r, w, k, v, kk, b, S0):
    def step(S, xs):
        r_t, w_t, k_t, v_t, kk_t, b_t = xs
        sk = jnp.einsum('bhk,bhkv->bhv', kk_t, S)
        S = (w_t[..., :, None] * S - b_t[..., :, None] * sk[..., None, :]
             + k_t[..., :, None] * v_t[..., None, :])
        return S, jnp.einsum('bhk,bhkv->bhv', r_t, S)

    xs = tuple(jnp.moveaxis(t, 1, 0) for t in (r, w, k, v, kk, b))
    S, ys = lax.scan(step, S0, xs)
    return jnp.moveaxis(ys, 0, 1), S


def rwkv7_mix(cp, shift_prev, S0, mu, w0, w2, a0, a2, g2, k_k, k_a, r_k, ln_g, ln_b):
    bn, L, _ = cp.shape
    prev = jnp.concatenate([shift_prev[:, None].astype(cp.dtype), cp[:, :-1]], axis=1)
    xm = (cp + (prev - cp) * mu).astype(jnp.float32)
    o1, o2, o3 = C_WIDTH, 2 * C_WIDTH, 3 * C_WIDTH
    o4, o5 = o3 + C_DECAY_LORA, o3 + C_DECAY_LORA + C_AAA_LORA
    r, k, v = xm[..., :o1], xm[..., o1:o2], xm[..., o2:o3]
    wl, al, gl = xm[..., o3:o4], xm[..., o4:o5], xm[..., o5:]
    w_log = -jax.nn.softplus(-(w0 + jnp.tanh(wl) @ w2)) - 0.5
    decay = jnp.exp(-jnp.exp(w_log))
    a = jax.nn.sigmoid(a0 + al @ a2)
    g = jax.nn.sigmoid(gl) @ g2

    def hs(t):
        return t.reshape(bn, L, C_HEADS, C_HD)

    kk = l2norm(hs(k * k_k))
    k = k * (1.0 + (a - 1.0) * k_a)
    r_h, k_h, v_h, a_h = hs(r), hs(k), hs(v), hs(a)
    y, S = rwkv7_scan(r_h, hs(decay), k_h, v_h, kk, kk * a_h, S0.astype(jnp.float32))
    mean = jnp.mean(y, axis=-1, keepdims=True)
    var = jnp.mean(jnp.square(y - mean), axis=-1, keepdims=True)
    y = ((y - mean) * lax.rsqrt(var + GN_EPS)).reshape(bn, L, C_WIDTH) * ln_g + ln_b
    y = y + (jnp.sum(r_h * k_h * r_k, axis=-1, keepdims=True) * v_h).reshape(bn, L, C_WIDTH)
    return (y * g).astype(cp.dtype), cp[:, -1], S


def multiscale_pool(dp, buf, start, d_w, d_scale):
    bn, L, _ = dp.shape
    xp = jnp.concatenate([buf.astype(dp.dtype), dp], axis=1)
    cs = jnp.pad(jnp.cumsum(xp.astype(jnp.float32), axis=1), ((0, 0), (1, 0), (0, 0)))
    pos = start + jnp.arange(L)
    end = cs[:, POOL_BUF + 1:POOL_BUF + 1 + L]
    means = []
    for gi, w in enumerate(POOL_WINDOWS):
        sl = slice(gi * D_GC, (gi + 1) * D_GC)
        s = end[..., sl] - cs[:, POOL_BUF + 1 - w:POOL_BUF + 1 - w + L, sl]
        cnt = jnp.minimum(pos + 1, w).astype(jnp.float32)[None, :, None]
        means.append(s / cnt)
    mean = jnp.stack(means, axis=2)
    diff = mean - dp.reshape(bn, L, D_GROUPS, D_GC).astype(jnp.float32)
    out = jnp.einsum('blgc,gcd->blgd', diff, d_w.astype(jnp.float32)).reshape(bn, L, D_WIDTH)
    return (out * d_scale).astype(dp.dtype), xp[:, -POOL_BUF:]


def run_trunk(x, start, b_conv, b_ssm, c_shift, c_wkv, d_pool, p):
    n_av, n_bc, n_bs, n_cs, n_cw, n_dp = [], [], [], [], [], []
    for l in range(DEPTH):
        h = rmsnorm(x, p['norm1_g'][l])
        proj = h @ p['w_in'][l]
        a_out, a_v = chunk_gmlp(proj[..., :B_OFF], p['a_ws'][l], p['a_bs'][l], p['a_vnorm_g'][l])
        b_out, nb_conv, nb_ssm = gated_deltanet(proj[..., B_OFF:C_OFF], b_conv[l], b_ssm[l],
                                                p['b_conv_w'][l], p['b_a_log'][l],
                                                p['b_dt_bias'][l], p['b_onorm_g'][l])
        c_out, nc_shift, nc_wkv = rwkv7_mix(proj[..., C_OFF:D_OFF], c_shift[l], c_wkv[l],
                                            p['c_mu'][l], p['c_w0'][l], p['c_w2'][l],
                                            p['c_a0'][l], p['c_a2'][l], p['c_g2'][l],
                                            p['c_k_k'][l], p['c_k_a'][l], p['c_r_k'][l],
                                            p['c_ln_g'][l], p['c_ln_b'][l])
        d_out, nd_pool = multiscale_pool(proj[..., D_OFF:], d_pool[l], start,
                                         p['d_w'][l], p['d_scale'][l])
        mixed = jnp.concatenate([a_out, b_out, c_out, d_out], axis=-1).astype(x.dtype)
        x = x + mixed @ p['w_out'][l]
        hm = rmsnorm(x, p['norm2_g'][l])
        x = x + jnp.square(jax.nn.relu(hm @ p['w_up'][l])) @ p['w_down'][l]
        n_av.append(a_v)
        n_bc.append(nb_conv)
        n_bs.append(nb_ssm)
        n_cs.append(nc_shift)
        n_cw.append(nc_wkv)
        n_dp.append(nd_pool)
    y = rmsnorm(x, p['final_g'])
    return (y, jnp.stack(n_av), jnp.stack(n_bc), jnp.stack(n_bs), jnp.stack(n_cs),
            jnp.stack(n_cw), jnp.stack(n_dp))


def setup_inputs(seed: int = 0) -> dict:
    key = jax.random.key(seed)
    keys = iter(jax.random.split(key, 48))

    def nrm(shape, scale):
        return scale * jax.random.normal(next(keys), shape, jnp.float32)

    def unif(shape, lo, hi):
        return jax.random.uniform(next(keys), shape, jnp.float32, lo, hi)

    dt = jnp.exp(unif((DEPTH, B_HEADS), math.log(1e-3), math.log(1e-1)))
    return {
        'x_prompt': nrm((BATCH, SEQ, D_MODEL), 1.0),
        'x_sample': nrm((DEC_BATCH, DEC_SEQ, D_MODEL), 1.0),
        'state_b_conv': nrm((DEPTH, DEC_BATCH, B_CONV - 1, 3 * B_WIDTH), 1.0),
        'state_b_ssm': nrm((DEPTH, DEC_BATCH, B_HEADS, B_DK, B_DV), 0.1),
        'state_c_shift': nrm((DEPTH, DEC_BATCH, C_PROJ), 1.0),
        'state_c_wkv': nrm((DEPTH, DEC_BATCH, C_HEADS, C_HD, C_HD), 0.1),
        'state_d_pool': nrm((DEPTH, DEC_BATCH, POOL_BUF, D_WIDTH), 1.0),
        'norm1_g': 1.0 + nrm((DEPTH, D_MODEL), 0.02),
        'w_in': nrm((DEPTH, D_MODEL, IN_COLS), D_MODEL ** -0.5),
        'a_ws': nrm((DEPTH, A_HEADS, A_CHUNK, A_CHUNK), A_CHUNK ** -0.5),
        'a_bs': 1.0 + nrm((DEPTH, A_HEADS, A_CHUNK), 0.1),
        'a_vnorm_g': 1.0 + nrm((DEPTH, A_WIDTH), 0.02),
        'b_conv_w': nrm((DEPTH, B_CONV, 3 * B_WIDTH), B_CONV ** -0.5),
        'b_a_log': jnp.log(unif((DEPTH, B_HEADS), 1.0, 16.0)),
        'b_dt_bias': dt + jnp.log(-jnp.expm1(-dt)),
        'b_onorm_g': 1.0 + nrm((DEPTH, B_DV), 0.02),
        'c_mu': unif((DEPTH, C_PROJ), 0.0, 1.0),
        'c_w0': unif((DEPTH, C_WIDTH), -6.0, 1.0),
        'c_w2': nrm((DEPTH, C_DECAY_LORA, C_WIDTH), 0.1 * C_DECAY_LORA ** -0.5),
        'c_a0': nrm((DEPTH, C_WIDTH), 0.1),
        'c_a2': nrm((DEPTH, C_AAA_LORA, C_WIDTH), C_AAA_LORA ** -0.5),
        'c_g2': nrm((DEPTH, C_GATE_LORA, C_WIDTH), C_GATE_LORA ** -0.5),
        'c_k_k': 0.85 + nrm((DEPTH, C_WIDTH), 0.02),
        'c_k_a': 1.0 + nrm((DEPTH, C_WIDTH), 0.02),
        'c_r_k': nrm((DEPTH, C_HEADS, C_HD), 0.1),
        'c_ln_g': 1.0 + nrm((DEPTH, C_WIDTH), 0.02),
        'c_ln_b': nrm((DEPTH, C_WIDTH), 0.02),
        'd_w': nrm((DEPTH, D_GROUPS, D_GC, D_GC), D_GC ** -0.5),
        'd_scale': 1.0 + nrm((DEPTH, D_WIDTH), 0.1),
        'w_out': nrm((DEPTH, MIX_WIDTH, D_MODEL), MIX_WIDTH ** -0.5),
        'norm2_g': 1.0 + nrm((DEPTH, D_MODEL), 0.02),
        'w_up': nrm((DEPTH, D_MODEL, D_FF), D_MODEL ** -0.5),
        'w_down': nrm((DEPTH, D_FF, D_MODEL), D_FF ** -0.5),
        'final_g': 1.0 + nrm((D_MODEL,), 0.02),
    }


def reference(x_prompt, x_sample, state_b_conv, state_b_ssm, state_c_shift, state_c_wkv,
              state_d_pool, norm1_g, w_in, a_ws, a_bs, a_vnorm_g, b_conv_w, b_a_log, b_dt_bias,
              b_onorm_g, c_mu, c_w0, c_w2, c_a0, c_a2, c_g2, c_k_k, c_k_a, c_r_k, c_ln_g, c_ln_b,
              d_w, d_scale, w_out, norm2_g, w_up, w_down, final_g):
    p = dict(norm1_g=norm1_g, w_in=w_in, a_ws=a_ws, a_bs=a_bs, a_vnorm_g=a_vnorm_g,
             b_conv_w=b_conv_w, b_a_log=b_a_log, b_dt_bias=b_dt_bias, b_onorm_g=b_onorm_g,
             c_mu=c_mu, c_w0=c_w0, c_w2=c_w2, c_a0=c_a0, c_a2=c_a2, c_g2=c_g2, c_k_k=c_k_k,
             c_k_a=c_k_a, c_r_k=c_r_k, c_ln_g=c_ln_g, c_ln_b=c_ln_b, d_w=d_w, d_scale=d_scale,
             w_out=w_out, norm2_g=norm2_g, w_up=w_up, w_down=w_down, final_g=final_g)
    z_conv = jnp.zeros((DEPTH, BATCH, B_CONV - 1, 3 * B_WIDTH), x_prompt.dtype)
    z_ssm = jnp.zeros((DEPTH, BATCH, B_HEADS, B_DK, B_DV), jnp.float32)
    z_shift = jnp.zeros((DEPTH, BATCH, C_PROJ), x_prompt.dtype)
    z_wkv = jnp.zeros((DEPTH, BATCH, C_HEADS, C_HD, C_HD), jnp.float32)
    z_pool = jnp.zeros((DEPTH, BATCH, POOL_BUF, D_WIDTH), x_prompt.dtype)
    y_prompt, _, p_b_conv, p_b_ssm, p_c_shift, p_c_wkv, p_d_pool = run_trunk(
        x_prompt, 0, z_conv, z_ssm, z_shift, z_wkv, z_pool, p)
    y_sample, s_a_v, s_b_conv, s_b_ssm, s_c_shift, s_c_wkv, s_d_pool = run_trunk(
        x_sample, PAST_LEN, state_b_conv, state_b_ssm, state_c_shift, state_c_wkv,
        state_d_pool, p)
    return (y_prompt, y_sample, p_b_conv, p_b_ssm, p_c_shift, p_c_wkv, p_d_pool,
            s_a_v, s_b_conv, s_b_ssm, s_c_shift, s_c_wkv, s_d_pool)
```

```cpp
#include <hip/hip_runtime.h>
#include <hip/hip_cooperative_groups.h>
#include <cstdio>
#include <cstdint>
namespace cg = cooperative_groups;
#define MK_PER_PHASE 0
namespace pg8 {
#define PG8_LAS __attribute__((address_space(3)))
typedef unsigned short bf16_t;
typedef short bf16x8 __attribute__((ext_vector_type(8)));
typedef float f32x4 __attribute__((ext_vector_type(4)));
typedef unsigned u32x4 __attribute__((ext_vector_type(4)));
constexpr int BM = 256, BK = 64, HALF = 128, HTB = HALF * BK * 2  , STAGE_BYTES = 8 * HTB, NXCD = 8, WGM = 8;

__host__ __device__ __forceinline__ int lds_byte(int r, int c) { const int st = (r >> 4) * 2 + (c >> 5), rr = r & 15, cc = c & 31, ob = rr * 64 + cc * 2; return st * 1024 + (ob ^ (((ob >> 9) & 1) << 5)); }
__host__ __device__ __forceinline__ void stage_rc(int b, int& R, int& C) { const int st = b / 1024, sb = b % 1024, swz = sb ^ (((sb >> 9) & 1) << 5); R = (st >> 1) * 16 + swz / 64; C = (st & 1) * 32 + (swz % 64) / 2; }
__host__ __device__ __forceinline__ int perm32(int rho) { const int n = rho >> 4, i = rho & 15; return 8 * (i >> 2) + 4 * n + (i & 3); }

struct Unit { int pm, pn, kofs, nt, part; };
struct Gemm { const bf16_t* A; const bf16_t* Bt; int M, N, K; };

struct StaticOrder {
    int nM, nN, nwg, G, c;
    __host__ __device__ void init(int M, int N, int G_, int c_) { nM = M / BM; nN = N / BM; nwg = nM * nN; G = G_; c = c_; }
    __host__ __device__ bool next(int i, Unit& u) const {
        const long L = (long)i * G + c; if (L >= nwg) return false;
        int wgid = (int)L; { const int q = nwg / NXCD, r = nwg % NXCD, xcd = wgid % NXCD, off = wgid / NXCD; wgid = (xcd < r ? xcd * (q + 1) : r * (q + 1) + (xcd - r) * q) + off; }
        const int nig = WGM * nN, gid = wgid / nig, fm = gid * WGM, gsz = (nM - fm) < WGM ? (nM - fm) : WGM;
        u.pm = fm + ((wgid % nig) % gsz); u.pn = (wgid % nig) / gsz; u.kofs = 0; u.nt = 0; u.part = -1; return true;
    }
    __device__ __forceinline__ void a_ready(const Unit&) const {}
    __device__ __forceinline__ void done(const Unit&) const {}
};

__device__ __forceinline__ unsigned cvt_pk_bf16(float lo, float hi) { unsigned r; asm volatile("v_cvt_pk_bf16_f32 %0, %1, %2" : "=v"(r) : "v"(lo), "v"(hi)); return r; }
typedef float f32x2 __attribute__((ext_vector_type(2)));
template <class Epi, class Sched, bool ALIGN_EPI = false, bool SP2 = false>
__device__ __forceinline__ void gemm_phase(PG8_LAS unsigned char* lds, const Gemm g, const Sched& S, const Epi& E) {
    int tid_ = threadIdx.x; asm volatile("" : "+v"(tid_)); const int tid = tid_, wid = __builtin_amdgcn_readfirstlane(tid >> 6), lane = tid & 63, wr = wid >> 2, wc = wid & 3, fr = lane & 15, fq = lane >> 4;
    const int K = g.K, nt = K / BK;
    unsigned voffA[2], voffB[2];
#pragma unroll
    for (int i = 0; i < 2; ++i) { int R, C; stage_rc(tid * 16 + i * 8192, R, C); const int Rb = Epi::PERM ? ((R & ~31) + perm32(R & 31)) : R;
        voffA[i] = (unsigned)(R * K + C) * 2u; voffB[i] = (unsigned)(Rb * K + C) * 2u; }
    const size_t kstep = (size_t)(BK * 2);
    const size_t hstep = (size_t)HALF * K * 2;
    const size_t tstep = 2 * hstep;
    const unsigned ldsw = (unsigned)wid * 1024u;
    const int aoff = lds_byte(wr * 64 + fr, fq * 8), boff = lds_byte(wc * 32 + fr, fq * 8);
#define PG8_SA(b, h) (((b) * 2 + (h)) * HTB)
#define PG8_SB(b, h) ((4 + (b) * 2 + (h)) * HTB)
#define PG8_STAGE(bufoff, gbase, voff) do { _Pragma("unroll") for (int _i = 0; _i < 2; ++_i) \
        __builtin_amdgcn_global_load_lds((const unsigned*)((const char*)(gbase) + (voff)[_i]), (PG8_LAS unsigned*)(lds + (bufoff) + ldsw + _i * 8192), 16, 0, 0); } while (0)
#define PG8_LDA(dst, b, h) do { _Pragma("unroll") for (int m = 0; m < 4; ++m) _Pragma("unroll") for (int k = 0; k < 2; ++k) dst[m][k] = *(const PG8_LAS bf16x8*)(lds + PG8_SA(b, h) + aoff + m * 2048 + k * 1024); } while (0)
#define PG8_LDB(dst, b, h) do { _Pragma("unroll") for (int n = 0; n < 2; ++n) _Pragma("unroll") for (int k = 0; k < 2; ++k) dst[n][k] = *(const PG8_LAS bf16x8*)(lds + PG8_SB(b, h) + boff + n * 2048 + k * 1024); } while (0)
#define PG8_MMA(ai, bj, At, Bt) do { __builtin_amdgcn_s_setprio(1); _Pragma("unroll") for (int m = 0; m < 4; ++m) _Pragma("unroll") for (int n = 0; n < 2; ++n) _Pragma("unroll") for (int k = 0; k < 2; ++k) \
        acc[ai][bj][m][n] = __builtin_amdgcn_mfma_f32_16x16x32_bf16(Bt[n][k], At[m][k], acc[ai][bj][m][n], 0, 0, 0); __builtin_amdgcn_s_setprio(0); } while (0)
#define PG8_WAIT_V(n) asm volatile("s_waitcnt vmcnt(" #n ")" ::: "memory")
#define PG8_WAIT_L(n) asm volatile("s_waitcnt lgkmcnt(" #n ")" ::: "memory")
#define PG8_BAR __builtin_amdgcn_s_barrier()
#define PG8_SCHED __builtin_amdgcn_sched_barrier(0)
    Unit cur, nxt; int ui = 0;
    if (!S.next(0, cur)) return;
    f32x4 acc[2][2][4][2];
#pragma unroll
    for (int a = 0; a < 2; ++a)
#pragma unroll
        for (int b = 0; b < 2; ++b)
#pragma unroll
            for (int m = 0; m < 4; ++m)
#pragma unroll
                for (int n = 0; n < 2; ++n) acc[a][b][m][n] = (f32x4){0.f, 0.f, 0.f, 0.f};
    bf16x8 At[4][2], B0[2][2], B1[2][2];
    const char* cA = (const char*)g.A + (size_t)cur.pm * tstep + cur.kofs; const char* cB = (const char*)g.Bt + (size_t)cur.pn * tstep + cur.kofs;
    S.a_ready(cur);
    if constexpr (SP2) {
        PG8_STAGE(PG8_SB(0, 0), cB, voffB); PG8_STAGE(PG8_SB(0, 1), cB + hstep, voffB); PG8_STAGE(PG8_SA(0, 0), cA, voffA); PG8_STAGE(PG8_SA(0, 1), cA + hstep, voffA);
        if (wr == 1) PG8_BAR;
        PG8_WAIT_V(2); PG8_BAR;
        PG8_STAGE(PG8_SB(1, 0), cB + kstep, voffB); PG8_STAGE(PG8_SA(1, 0), cA + kstep, voffA); PG8_STAGE(PG8_SB(1, 1), cB + hstep + kstep, voffB);
        PG8_WAIT_V(6); PG8_BAR;
    } else {
        PG8_STAGE(PG8_SB(0, 0), cB, voffB); PG8_STAGE(PG8_SA(0, 0), cA, voffA); PG8_STAGE(PG8_SB(0, 1), cB + hstep, voffB); PG8_STAGE(PG8_SA(0, 1), cA + hstep, voffA);
        if (wr == 1) PG8_BAR;
        PG8_WAIT_V(4); PG8_BAR;
        PG8_STAGE(PG8_SB(1, 0), cB + kstep, voffB); PG8_STAGE(PG8_SA(1, 0), cA + kstep, voffA); PG8_STAGE(PG8_SB(1, 1), cB + hstep + kstep, voffB);
        PG8_WAIT_V(6); PG8_BAR;
    }
    for (;;) {
        const bool has_next = S.next(ui + 1, nxt);
        const char* nA = has_next ? (const char*)g.A + (size_t)nxt.pm * tstep + nxt.kofs : cA; const char* nB = has_next ? (const char*)g.Bt + (size_t)nxt.pn * tstep + nxt.kofs : cB;
        const int cnt = cur.nt ? cur.nt : nt;
        for (int t = 0; t < cnt; t += 2) {
            const bool last = (t == cnt - 2);
            const char* a1 = cA + (size_t)(t + 1) * kstep;
            const char* a2 = last ? nA : cA + (size_t)(t + 2) * kstep; const char* b2 = last ? nB : cB + (size_t)(t + 2) * kstep;
            const char* a3 = a2 + kstep; const char* b3 = b2 + kstep;
            if (last && has_next) S.a_ready(nxt);
            if constexpr (SP2) {
            PG8_LDB(B0, 0, 0); PG8_LDB(B1, 0, 1); PG8_SCHED; PG8_LDA(At, 0, 0); PG8_STAGE(PG8_SA(1, 1), a1 + hstep, voffA);
            PG8_WAIT_V(8); PG8_WAIT_L(0); PG8_BAR; PG8_MMA(0, 0, At, B0); PG8_MMA(0, 1, At, B1); PG8_BAR; PG8_SCHED;
            PG8_LDA(At, 0, 1); PG8_STAGE(PG8_SB(0, 0), b2, voffB); PG8_STAGE(PG8_SB(0, 1), b2 + hstep, voffB); PG8_STAGE(PG8_SA(0, 0), a2, voffA);
            PG8_WAIT_V(8); PG8_WAIT_L(0); PG8_BAR; PG8_MMA(1, 0, At, B0); PG8_MMA(1, 1, At, B1); PG8_BAR; PG8_SCHED;
            PG8_LDB(B0, 1, 0); PG8_LDB(B1, 1, 1); PG8_SCHED; PG8_LDA(At, 1, 0); PG8_STAGE(PG8_SA(0, 1), a2 + hstep, voffA);
            PG8_WAIT_V(8); PG8_WAIT_L(0); PG8_BAR; PG8_MMA(0, 0, At, B0); PG8_MMA(0, 1, At, B1); PG8_BAR; PG8_SCHED;
            PG8_LDA(At, 1, 1); PG8_STAGE(PG8_SB(1, 0), b3, voffB); PG8_STAGE(PG8_SB(1, 1), b3 + hstep, voffB); PG8_STAGE(PG8_SA(1, 0), a3, voffA);
            PG8_WAIT_V(8); PG8_WAIT_L(0); PG8_BAR; PG8_MMA(1, 0, At, B0); PG8_MMA(1, 1, At, B1); PG8_BAR; PG8_SCHED;
            } else {
            PG8_LDB(B0, 0, 0); PG8_SCHED; PG8_LDA(At, 0, 0); PG8_STAGE(PG8_SA(1, 1), a1 + hstep, voffA);
            PG8_WAIT_L(8); PG8_BAR; PG8_WAIT_L(0); PG8_MMA(0, 0, At, B0); PG8_BAR; PG8_SCHED;
            PG8_LDB(B1, 0, 1); PG8_STAGE(PG8_SB(0, 0), b2, voffB);
            PG8_BAR; PG8_WAIT_L(0); PG8_MMA(0, 1, At, B1); PG8_BAR;
            PG8_LDA(At, 0, 1); PG8_STAGE(PG8_SA(0, 0), a2, voffA);
            PG8_BAR; PG8_WAIT_L(0); PG8_MMA(1, 0, At, B0); PG8_BAR; PG8_SCHED;
            PG8_STAGE(PG8_SB(0, 1), b2 + hstep, voffB);
            PG8_WAIT_V(6); PG8_BAR; PG8_MMA(1, 1, At, B1); PG8_BAR;
            PG8_LDB(B0, 1, 0); PG8_SCHED; PG8_LDA(At, 1, 0); PG8_STAGE(PG8_SA(0, 1), a2 + hstep, voffA);
            PG8_WAIT_L(8); PG8_BAR; PG8_WAIT_L(0); PG8_MMA(0, 0, At, B0); PG8_BAR; PG8_SCHED;
            PG8_LDB(B1, 1, 1); PG8_STAGE(PG8_SB(1, 0), b3, voffB);
            PG8_BAR; PG8_WAIT_L(0); PG8_MMA(0, 1, At, B1); PG8_BAR;
            PG8_LDA(At, 1, 1); PG8_STAGE(PG8_SA(1, 0), a3, voffA);
            PG8_BAR; PG8_WAIT_L(0); PG8_MMA(1, 0, At, B0); PG8_BAR; PG8_SCHED;
            PG8_STAGE(PG8_SB(1, 1), b3 + hstep, voffB);
            PG8_WAIT_V(6); PG8_BAR; PG8_MMA(1, 1, At, B1); PG8_BAR;
            }
        }
        if constexpr (ALIGN_EPI) { if (wr == 0) PG8_BAR; }
        if constexpr (!Epi::AFTER_DRAIN) { E(acc, cur, wr, wc, fr, fq); S.done(cur); }
        if (!has_next) break;
#pragma unroll
        for (int a = 0; a < 2; ++a)
#pragma unroll
            for (int b = 0; b < 2; ++b)
#pragma unroll
                for (int m = 0; m < 4; ++m)
#pragma unroll
                    for (int n = 0; n < 2; ++n) acc[a][b][m][n] = (f32x4){0.f, 0.f, 0.f, 0.f};
        cur = nxt; cA = nA; cB = nB; ++ui;
        if constexpr (ALIGN_EPI) { if (wr == 1) PG8_BAR; }
    }
    PG8_WAIT_V(0);
    if constexpr (!ALIGN_EPI) { if (wr == 0) PG8_BAR; }
    PG8_BAR;
    if constexpr (Epi::AFTER_DRAIN) { E.fused(acc, cur, wr, wc, fr, fq, lds, wid, lane); S.done(cur); }
#undef PG8_SA
#undef PG8_SB
#undef PG8_STAGE
#undef PG8_LDA
#undef PG8_LDB
#undef PG8_MMA
#undef PG8_WAIT_V
#undef PG8_WAIT_L
#undef PG8_BAR
#undef PG8_SCHED
}
}

#define LAS __attribute__((address_space(3)))

#define XB_TMO      128
#define XB_XCNT(j)  (256  + 64 * (j))
#define XB_XSUB(j)  (1280 + 64 * (j))
#define XB_XGEN(j)  (2304 + 64 * (j))
#define XB_TOP      3328
#define XB_TOPGEN   3392
#define XCD_BAR_WORDS 3456
#define XB_SPIN_CAP (1u << 18)

__device__ __forceinline__ unsigned xb_ld(unsigned* p)              { return __hip_atomic_load(p, __ATOMIC_RELAXED, __HIP_MEMORY_SCOPE_AGENT); }
__device__ __forceinline__ unsigned xb_add(unsigned* p, unsigned v) { return __hip_atomic_fetch_add(p, v, __ATOMIC_RELAXED, __HIP_MEMORY_SCOPE_AGENT); }
__device__ __forceinline__ unsigned xb_xcc_id() { return (unsigned)__builtin_amdgcn_s_getreg((3 << 11) | 20) & 0xFu; }
#define XB_SPIN(cond, bar) do { unsigned _sp = 0; while (cond) { __builtin_amdgcn_s_sleep(1); \
    if ((++_sp & 255u) == 0u) { if (xb_ld(&(bar)[XB_TMO])) break; if (_sp > XB_SPIN_CAP) { atomicAdd(&(bar)[XB_TMO], 1u); break; } } } } while (0)

struct XcdBarrier {
    unsigned* bar; unsigned x;
    volatile LAS unsigned* st;
};

__device__ __forceinline__ XcdBarrier xcd_barrier_post(unsigned* bar, volatile LAS unsigned* st) {
    XcdBarrier b; b.bar = bar; b.x = xb_xcc_id(); b.st = st;
    if (threadIdx.x == 0) (void)xb_add(&bar[XB_XCNT(b.x)], 1u);
    return b;
}
__device__ __forceinline__ void xcd_barrier_complete(unsigned* bar, unsigned x, unsigned& nloc, unsigned& nx) {
    const unsigned G = gridDim.x * gridDim.y * gridDim.z;
    unsigned sum, cnt, mine, sp = 0u;
    for (;;) {
        sum = 0u; cnt = 0u; mine = 0u;
#pragma unroll
        for (unsigned j = 0; j < 16; ++j) { const unsigned c = xb_ld(&bar[XB_XCNT(j)]); sum += c; cnt += (c > 0u) ? 1u : 0u; mine = (j == x) ? c : mine; }
        if (sum == G) break;
        __builtin_amdgcn_s_sleep(1);
        if ((++sp & 255u) == 0u) { if (xb_ld(&bar[XB_TMO])) break; if (sp > XB_SPIN_CAP) { atomicAdd(&bar[XB_TMO], 1u); break; } }
    }
    nloc = mine > 0u ? mine : 1u; nx = cnt > 0u ? cnt : 1u;
}

__device__ __forceinline__ void xcd_barrier(const XcdBarrier& b) {
    asm volatile("s_waitcnt vmcnt(0)" ::: "memory");
    __syncthreads();
    if (threadIdx.x == 0) {
        unsigned* bar = b.bar;
        __builtin_amdgcn_s_waitcnt(0);
        unsigned nloc = b.st[0], nx = b.st[1];
        if (nloc == 0u) { xcd_barrier_complete(bar, b.x, nloc, nx); b.st[0] = nloc; b.st[1] = nx; }
        const unsigned old = xb_add(&bar[XB_XSUB(b.x)], 1u);
        const unsigned gen = old / nloc;
        if (old + 1u == (gen + 1u) * nloc) {
            __builtin_amdgcn_fence(__ATOMIC_RELEASE, "agent");
            asm volatile("s_waitcnt vmcnt(0)" ::: "memory");
            const unsigned og = xb_add(&bar[XB_TOP], 1u);
            const unsigned tg = og / nx;
            if (og + 1u == (tg + 1u) * nx) xb_add(&bar[XB_TOPGEN], 1u);
            else XB_SPIN(xb_ld(&bar[XB_TOPGEN]) == tg, bar);
            __builtin_amdgcn_fence(__ATOMIC_ACQUIRE, "agent");
            xb_add(&bar[XB_XGEN(b.x)], 1u);
            asm volatile("s_waitcnt vmcnt(0)" ::: "memory");
        } else {
            XB_SPIN(xb_ld(&bar[XB_XGEN(b.x)]) == gen, bar);
            __builtin_amdgcn_fence(__ATOMIC_ACQUIRE, "agent");
            asm volatile("s_waitcnt vmcnt(0)" ::: "memory");
        }
    }
    __syncthreads();
}

typedef unsigned short bf16;
typedef pg8::f32x4 f32x4;
typedef pg8::u32x4 u32x4;
constexpr int DM = 1024, T_P = 16384, T_S = 512, TT = 16896, PN = 3072, NIN = 2816, FF = 4096;
constexpr float NORM_EPS = 1e-6f;
constexpr int PC_A = 0, PC_BQ = 512, PC_BK = 768, PC_BV = 1024, PC_BG = 1280, PC_C = 1536, PC_D = 2560, PC_BA = 2816;
constexpr size_t MiB = 1u << 20;
constexpr size_t WS_ROWSS = 0;
constexpr size_t WS_RK = 512 * 1024;
constexpr size_t WS_BAR = 800 * 1024;
constexpr size_t WS_W = 1 * MiB;
constexpr size_t WS_XB = 49 * MiB;
constexpr size_t WS_P = 82 * MiB;
constexpr size_t WS_MIXED = 181 * MiB;
constexpr size_t WS_HID = 82 * MiB;
constexpr size_t WS_AUXW = 214 * MiB;
constexpr size_t WS_AUXA = WS_AUXW + (size_t)TT * 256 * 4;
constexpr size_t WS_AUXG = WS_AUXA + (size_t)TT * 256 * 2;
constexpr size_t WS_LW = WS_AUXG + (size_t)TT * 256 * 2;
constexpr size_t WS_BAW = WS_LW + 2 * 81920 * 2;
constexpr size_t WS_BA = WS_BAW + 2 * 16 * 1024 * 2;
constexpr size_t WS_END = WS_BA + (size_t)TT * 8 * 4;
static_assert(WS_END <= 256 * MiB, "ws map");
constexpr size_t WOFF_IN = 0, WOFF_OUT = 3145728, WOFF_UP = 4194304, WOFF_DOWN = 8388608, WL_ELEMS = 12582912;
constexpr size_t O_YP = 0, O_YS = O_YP + (size_t)T_P * DM, O_PBC = O_YS + (size_t)T_S * DM, O_PBS = O_PBC + 2 * 8 * 3 * 768, O_PCS = O_PBS + 2 * 8 * 4 * 4096,
                 O_PCW = O_PCS + 2 * 8 * 1024, O_PDP = O_PCW + 2 * 8 * 4 * 4096, O_SAV = O_PDP + 2 * 8 * 15 * 256, O_SBC = O_SAV + 2 * 128 * 4 * 256,
                 O_SBS = O_SBC + 2 * 128 * 3 * 768, O_SCS = O_SBS + 2 * 128 * 4 * 4096, O_SCW = O_SCS + 2 * 128 * 1024, O_SDP = O_SCW + 2 * 128 * 4 * 4096,
                 O_END = O_SDP + 2 * 128 * 15 * 256;
static_assert(O_END == 28426240, "d_out map");
constexpr int LDS_BYTES = 163840;
constexpr int NPHASE = 16;

struct Args { const float* in[34]; float* out; unsigned char* ws; int ph_lo, ph_hi; };
enum { I_XP = 0, I_XS, I_SBC, I_SBS, I_SCS, I_SCW, I_SDP, I_N1G, I_WIN, I_AWS, I_ABS, I_AVG, I_BCW, I_BAL, I_BDT, I_BON, I_CMU, I_CW0, I_CW2, I_CA0, I_CA2, I_CG2,
       I_CKK, I_CKA, I_CRK, I_CLG, I_CLB, I_DW, I_DSC, I_WOUT, I_N2G, I_WUP, I_WDN, I_FG };

#define LDS_WAIT() asm volatile("s_waitcnt lgkmcnt(0)" ::: "memory")

__device__ __forceinline__ int otid() { int t = threadIdx.x; asm volatile("" : "+v"(t)); return t; }
__device__ __forceinline__ float bf2f(unsigned h) { return __uint_as_float(h << 16); }
__device__ __forceinline__ unsigned f2bf(float f) { unsigned u = __float_as_uint(f); return (u + 0x7fffu + ((u >> 16) & 1u)) >> 16; }
__device__ __forceinline__ unsigned pk2(float lo, float hi) { return f2bf(lo) | (f2bf(hi) << 16); }
__device__ __forceinline__ void ld8(const bf16* p, float (&o)[8]) {
    const uint4 u = *(const uint4*)p;
    o[0] = __uint_as_float(u.x << 16); o[1] = __uint_as_float(u.x & 0xffff0000u); o[2] = __uint_as_float(u.y << 16); o[3] = __uint_as_float(u.y & 0xffff0000u);
    o[4] = __uint_as_float(u.z << 16); o[5] = __uint_as_float(u.z & 0xffff0000u); o[6] = __uint_as_float(u.w << 16); o[7] = __uint_as_float(u.w & 0xffff0000u);
}
__device__ __forceinline__ void ld4(const bf16* p, float (&o)[4]) {
    const uint2 u = *(const uint2*)p;
    o[0] = __uint_as_float(u.x << 16); o[1] = __uint_as_float(u.x & 0xffff0000u); o[2] = __uint_as_float(u.y << 16); o[3] = __uint_as_float(u.y & 0xffff0000u);
}
__device__ __forceinline__ void ld2(const bf16* p, float (&o)[2]) { const unsigned u = *(const unsigned*)p; o[0] = __uint_as_float(u << 16); o[1] = __uint_as_float(u & 0xffff0000u); }
template <int N> __device__ __forceinline__ void ldbf(const bf16* p, float (&o)[N]);
template <> __device__ __forceinline__ void ldbf<8>(const bf16* p, float (&o)[8]) { ld8(p, o); }
template <> __device__ __forceinline__ void ldbf<4>(const bf16* p, float (&o)[4]) { ld4(p, o); }
template <> __device__ __forceinline__ void ldbf<2>(const bf16* p, float (&o)[2]) { ld2(p, o); }
template <> __device__ __forceinline__ void ldbf<1>(const bf16* p, float (&o)[1]) { o[0] = bf2f(*p); }
template <int N> __device__ __forceinline__ void ldf(const float* p, float (&o)[N]) {
#pragma unroll
    for (int i = 0; i < N; ++i) o[i] = p[i];
}
__device__ __forceinline__ float sigm(float x) { return __builtin_amdgcn_rcpf(1.f + __expf(-x)); }
__device__ __forceinline__ float silu(float x) { return x * sigm(x); }
__device__ __forceinline__ float tanh_(float y) { return 1.f - 2.f * __builtin_amdgcn_rcpf(1.f + __expf(2.f * y)); }
__device__ __forceinline__ float gelu_t(float x) { return 0.5f * x * (1.f + tanh_(0.7978845608028654f * (x + 0.044715f * x * x * x))); }
__device__ __forceinline__ float softplus_(float x) { const float u = __expf(-fabsf(x)); return fmaxf(x, 0.f) + (u < 1e-3f ? u * (1.f - 0.5f * u) : __logf(1.f + u)); }
__device__ __forceinline__ float wave_sum(float v) {
#pragma unroll
    for (int o = 1; o < 64; o <<= 1) v += __shfl_xor(v, o);
    return v;
}
__device__ __forceinline__ float sum8(float v) { v += __shfl_xor(v, 1); v += __shfl_xor(v, 2); v += __shfl_xor(v, 4); return v; }
__device__ __forceinline__ float sum16(float v) { v = sum8(v); v += __shfl_xor(v, 8); return v; }
__device__ __forceinline__ float dpp_sum16(float x) {
    x += __int_as_float(__builtin_amdgcn_update_dpp(0, __float_as_int(x), 0xB1, 0xF, 0xF, false));
    x += __int_as_float(__builtin_amdgcn_update_dpp(0, __float_as_int(x), 0x4E, 0xF, 0xF, false));
    x += __int_as_float(__builtin_amdgcn_update_dpp(0, __float_as_int(x), 0x141, 0xF, 0xF, false));
    x += __int_as_float(__builtin_amdgcn_update_dpp(0, __float_as_int(x), 0x140, 0xF, 0xF, false));
    return x;
}

template <bool RELU2> struct EpiScale {
    static constexpr bool PERM = true, AFTER_DRAIN = false;
    bf16* O; int ldc; const float* rss;
    __device__ __forceinline__ void operator()(const f32x4 (&acc)[2][2][4][2], const pg8::Unit& u, int wr, int wc, int fr, int fq) const {
        const int row0 = u.pm * 256 + wr * 64 + fr, col0 = u.pn * 256 + wc * 32 + 8 * fq;
#pragma unroll
        for (int ai = 0; ai < 2; ++ai)
#pragma unroll
            for (int m = 0; m < 4; ++m) {
                const int r = row0 + ai * 128 + m * 16;
                const float rs = rsqrtf(rss[r] * (1.f / 1024.f) + NORM_EPS);
                bf16* rowp = O + (size_t)r * ldc + col0;
#pragma unroll
                for (int bj = 0; bj < 2; ++bj) {
                    f32x4 v0 = acc[ai][bj][m][0] * rs, v1 = acc[ai][bj][m][1] * rs;
                    if (RELU2) {
#pragma unroll
                        for (int e = 0; e < 4; ++e) { const float p0 = fmaxf(v0[e], 0.f), p1 = fmaxf(v1[e], 0.f); v0[e] = p0 * p0; v1[e] = p1 * p1; }
                    }
                    u32x4 w; w.x = pg8::cvt_pk_bf16(v0[0], v0[1]); w.y = pg8::cvt_pk_bf16(v0[2], v0[3]); w.z = pg8::cvt_pk_bf16(v1[0], v1[1]); w.w = pg8::cvt_pk_bf16(v1[2], v1[3]);
                    *(u32x4*)(rowp + bj * 128) = w;
                }
            }
    }
};
struct EpiRes {
    static constexpr bool PERM = true, AFTER_DRAIN = false;
    float* X; bf16* XB; float* rss; const float* Sp; const float* Ss;
    __device__ __forceinline__ void operator()(const f32x4 (&acc)[2][2][4][2], const pg8::Unit& u, int wr, int wc, int fr, int fq) const {
        const int row0 = u.pm * 256 + wr * 64 + fr, col0 = u.pn * 256 + wc * 32 + 8 * fq;
#pragma unroll
        for (int ai = 0; ai < 2; ++ai)
#pragma unroll
            for (int m = 0; m < 4; ++m) {
                const int r = row0 + ai * 128 + m * 16;
                const float* srow = Sp ? (r < T_P ? Sp + (size_t)r * 1024 : Ss + (size_t)(r - T_P) * 1024) : X + (size_t)r * 1024;
                float ss = 0.f;
#pragma unroll
                for (int bj = 0; bj < 2; ++bj) {
                    float* xp = X + (size_t)r * 1024 + col0 + bj * 128;
                    const float* sp = srow + col0 + bj * 128;
                    const f32x4 x0 = *(const f32x4*)sp + acc[ai][bj][m][0], x1 = *(const f32x4*)(sp + 4) + acc[ai][bj][m][1];
                    *(f32x4*)xp = x0; *(f32x4*)(xp + 4) = x1;
                    u32x4 w; w.x = pg8::cvt_pk_bf16(x0[0], x0[1]); w.y = pg8::cvt_pk_bf16(x0[2], x0[3]); w.z = pg8::cvt_pk_bf16(x1[0], x1[1]); w.w = pg8::cvt_pk_bf16(x1[2], x1[3]);
                    *(u32x4*)(XB + (size_t)r * 1024 + col0 + bj * 128) = w;
                    ss += (x0[0] * x0[0] + x0[1] * x0[1]) + (x0[2] * x0[2] + x0[3] * x0[3]) + (x1[0] * x1[0] + x1[1] * x1[1]) + (x1[2] * x1[2] + x1[3] * x1[3]);
                }
                ss += __shfl_xor(ss, 16); ss += __shfl_xor(ss, 32);
                if (fq == 0) atomicAdd(rss + r, ss);
            }
    }
};

struct DownOrder {
    int c, snt;
    __device__ __forceinline__ bool next(int i, pg8::Unit& u) const {
        if (i == 0) { const int v = (c & 7) * 32 + (c >> 3); u.pm = v >> 2; u.pn = v & 3; u.kofs = 0; u.nt = 0; u.part = -1; return true; }
        if (i == 1 && c < 64) { const int su = c >> 3, sl = c & 7; u.pm = 64 + (su >> 2); u.pn = su & 3; u.kofs = sl * snt * 64 * 2; u.nt = snt; u.part = sl; return true; }
        return false;
    }
    __device__ __forceinline__ void a_ready(const pg8::Unit&) const {}
    __device__ __forceinline__ void done(const pg8::Unit&) const {}
};
struct EpiResSplit {
    static constexpr bool PERM = true, AFTER_DRAIN = false;
    float* X; bf16* XB; float* rss; float* part; const float* Sp; const float* Ss;
    __device__ __forceinline__ void operator()(const f32x4 (&acc)[2][2][4][2], const pg8::Unit& u, int wr, int wc, int fr, int fq) const {
        if (u.part < 0) { EpiRes E{X, XB, rss, Sp, Ss}; E(acc, u, wr, wc, fr, fq); return; }
        const int row0 = (u.pm - 64) * 256 + wr * 64 + fr, col0 = u.pn * 256 + wc * 32 + 8 * fq;
        float* pp = part + (size_t)u.part * 512 * 1024;
#pragma unroll
        for (int ai = 0; ai < 2; ++ai)
#pragma unroll
            for (int m = 0; m < 4; ++m)
#pragma unroll
                for (int bj = 0; bj < 2; ++bj) {
                    float* xp = pp + (size_t)(row0 + ai * 128 + m * 16) * 1024 + col0 + bj * 128;
                    *(f32x4*)xp = acc[ai][bj][m][0]; *(f32x4*)(xp + 4) = acc[ai][bj][m][1];
                }
    }
};
__device__ __forceinline__ void sample_fix(const Args& a, float* rss, const float* part, const float* Ss = nullptr) {
    const int tid = otid(), lane = tid & 63, wave = tid >> 6;
    bf16* xb = (bf16*)(a.ws + WS_XB);
    for (int r = T_P + blockIdx.x * 8 + wave; r < TT; r += gridDim.x * 8) {
        float4* xi = (float4*)(a.out + (size_t)r * 1024);
        const float4* xs = Ss ? (const float4*)(Ss + (size_t)(r - T_P) * 1024) : (const float4*)xi;
        uint2* bo = (uint2*)(xb + (size_t)r * 1024);
        float ss = 0.f;
#pragma unroll
        for (int j = 0; j < 4; ++j) {
            float4 v = xs[lane + 64 * j];
#pragma unroll
            for (int s = 0; s < 8; ++s) { const float4 p = ((const float4*)(part + ((size_t)s * 512 + (r - T_P)) * 1024))[lane + 64 * j]; v.x += p.x; v.y += p.y; v.z += p.z; v.w += p.w; }
            xi[lane + 64 * j] = v;
            ss += (v.x * v.x + v.y * v.y) + (v.z * v.z + v.w * v.w); uint2 w; w.x = pk2(v.x, v.y); w.y = pk2(v.z, v.w); bo[lane + 64 * j] = w;
        }
        ss = wave_sum(ss);
        if (lane == 0) rss[r] = ss;
    }
}

template <class Epi> __device__ __forceinline__ void skinny_gemm(const bf16* __restrict__ A  , const bf16* __restrict__ Bt, int N, int K, const Epi& E) {
    const int tid = otid(), wave = tid >> 6, lane = tid & 63, fr = lane & 15, fq = lane >> 4;
    const int nN = N >> 7, nU = 8 * nN;
    for (int u = blockIdx.x; u < nU; u += gridDim.x) {
        const int mb = u / nN, nb = u - mb * nN, n0 = nb * 128 + wave * 16;
        const bf16* ap = A + (size_t)(mb * 64 + fr) * K + 8 * fq;
        const bf16* bp = Bt + (size_t)(n0 + fr) * K + 8 * fq;
        f32x4 acc[4];
#pragma unroll
        for (int m = 0; m < 4; ++m) acc[m] = (f32x4){0.f, 0.f, 0.f, 0.f};
#pragma unroll 4
        for (int k = 0; k < K; k += 32) {
            const pg8::bf16x8 bfr = *(const pg8::bf16x8*)(bp + k);
#pragma unroll
            for (int m = 0; m < 4; ++m) { const pg8::bf16x8 af = *(const pg8::bf16x8*)(ap + (size_t)m * 16 * K + k); acc[m] = __builtin_amdgcn_mfma_f32_16x16x32_bf16(bfr, af, acc[m], 0, 0, 0); }
        }
        E(acc, T_P + mb * 64 + fr, n0 + 4 * fq, fq);
    }
}
template <bool RELU2> struct SkScale {
    bf16* O; int ldc; const float* rss;
    __device__ __forceinline__ void operator()(const f32x4 (&acc)[4], int row, int col, int fq) const {
#pragma unroll
        for (int m = 0; m < 4; ++m) {
            const int r = row + 16 * m;
            const float rs = rsqrtf(rss[r] * (1.f / 1024.f) + NORM_EPS);
            f32x4 v = acc[m] * rs;
            if (RELU2) {
#pragma unroll
                for (int e = 0; e < 4; ++e) { const float p = fmaxf(v[e], 0.f); v[e] = p * p; }
            }
            uint2 w; w.x = pg8::cvt_pk_bf16(v[0], v[1]); w.y = pg8::cvt_pk_bf16(v[2], v[3]);
            *(uint2*)(O + (size_t)r * ldc + col) = w;
        }
    }
};
struct SkRes {
    float* X; bf16* XB; float* rss;
    __device__ __forceinline__ void operator()(const f32x4 (&acc)[4], int row, int col, int fq) const {
#pragma unroll
        for (int m = 0; m < 4; ++m) {
            const int r = row + 16 * m;
            float* xp = X + (size_t)r * 1024 + col;
            const f32x4 x = *(const f32x4*)xp + acc[m];
            *(f32x4*)xp = x;
            uint2 w; w.x = pg8::cvt_pk_bf16(x[0], x[1]); w.y = pg8::cvt_pk_bf16(x[2], x[3]);
            *(uint2*)(XB + (size_t)r * 1024 + col) = w;
            float ss = (x[0] * x[0] + x[1] * x[1]) + (x[2] * x[2] + x[3] * x[3]);
            ss += __shfl_xor(ss, 16); ss += __shfl_xor(ss, 32);
            if (fq == 0) atomicAdd(rss + r, ss);
        }
    }
};

__device__ __forceinline__ void tr_item(const float* __restrict__ W, int K, int Nsrc, bf16* __restrict__ WT, const float* __restrict__ gain, bool inmap, float* scr, int item, int nblk, int lane) {
    const int kb = item / nblk, nb = item - kb * nblk, k0 = 64 * kb, n0 = 32 * nb;
    const int n = n0 + (lane & 31);
    int ns = n;
    if (inmap) ns = n < 1536 ? n : n + 8;
    float tv[32];
    const int nsc = ns >= 0 ? ns : 0;
#pragma unroll
    for (int i = 0; i < 32; ++i) tv[i] = W[(size_t)(k0 + 2 * i + (lane >> 5)) * Nsrc + nsc];
#pragma unroll
    for (int i = 0; i < 32; ++i) {
        const int kk = 2 * i + (lane >> 5);
        float v = ns >= 0 ? tv[i] : 0.f;
        if (gain) v *= gain[k0 + kk];
        scr[kk * 33 + (lane & 31)] = v;
    }
    LDS_WAIT();
    const int c = lane & 7;
#pragma unroll
    for (int j = 0; j < 4; ++j) {
        const int nn = (lane >> 3) + 8 * j; const float* s = scr + (8 * c) * 33 + nn;
        uint4 o; o.x = pk2(s[0], s[33]); o.y = pk2(s[66], s[99]); o.z = pk2(s[132], s[165]); o.w = pk2(s[198], s[231]);
        *(uint4*)(WT + (size_t)(n0 + nn) * K + k0 + 8 * c) = o;
    }
    LDS_WAIT();
}

__device__ __forceinline__ void convert_layer(const Args& a, int l, float* scr, int gw, int NGW, int lane) {
    bf16* wb = (bf16*)(a.ws + WS_W) + (size_t)l * WL_ELEMS;
    for (int it = gw; it < 6016; it += NGW) {
        int r = it;
        if (r < 1408) tr_item(a.in[I_WIN] + (size_t)l * 1024 * 2824, 1024, 2824, wb + WOFF_IN, a.in[I_N1G] + l * 1024, true, scr, r, 88, lane);
        else if ((r -= 1408) < 512) tr_item(a.in[I_WOUT] + (size_t)l * 1024 * 1024, 1024, 1024, wb + WOFF_OUT, nullptr, false, scr, r, 32, lane);
        else if ((r -= 512) < 2048) tr_item(a.in[I_WUP] + (size_t)l * 1024 * 4096, 1024, 4096, wb + WOFF_UP, a.in[I_N2G] + l * 1024, false, scr, r, 128, lane);
        else { r -= 2048; tr_item(a.in[I_WDN] + (size_t)l * 4096 * 1024, 4096, 1024, wb + WOFF_DOWN, nullptr, false, scr, r, 32, lane); }
    }
}
__device__ __forceinline__ void phase0(const Args& a, unsigned char* lds) {
    const int tid = otid(), lane = tid & 63, wave = tid >> 6;
    const int gw = blockIdx.x * 8 + wave, NGW = gridDim.x * 8;
    float* scr = (float*)(lds + wave * 16384);
    convert_layer(a, 0, scr, gw, NGW, lane);
    if (MK_PER_PHASE || gridDim.x != 256) convert_layer(a, 1, scr, gw, NGW, lane);
    {
        bf16* BAW = (bf16*)(a.ws + WS_BAW);
        for (int i = blockIdx.x * 512 + tid; i < 2 * 16 * 1024; i += gridDim.x * 512) {
            const int l = i >> 14, n = (i >> 10) & 15, kk = i & 1023;
            const float v = n < 8 ? a.in[I_WIN][((size_t)l * 1024 + kk) * 2824 + 1536 + n] * a.in[I_N1G][l * 1024 + kk] : 0.f;
            BAW[i] = (bf16)f2bf(v);
        }
    }
    float* rowss = (float*)(a.ws + WS_ROWSS);
    bf16* xb = (bf16*)(a.ws + WS_XB);
    for (int r = gw; r < TT; r += NGW) {
        const float* src = r < T_P ? a.in[I_XP] + (size_t)r * 1024 : a.in[I_XS] + (size_t)(r - T_P) * 1024;
        float4 v[4]; float ss = 0.f;
#pragma unroll
        for (int j = 0; j < 4; ++j) { v[j] = ((const float4*)src)[lane + 64 * j]; ss += (v[j].x * v[j].x + v[j].y * v[j].y) + (v[j].z * v[j].z + v[j].w * v[j].w); }
        ss = wave_sum(ss);
        if (lane == 0) rowss[r] = ss;
        uint2* bo = (uint2*)(xb + (size_t)r * 1024);
#pragma unroll
        for (int j = 0; j < 4; ++j) { uint2 w; w.x = pk2(v[j].x, v[j].y); w.y = pk2(v[j].z, v[j].w); bo[lane + 64 * j] = w; }
    }
    for (int i = blockIdx.x * 512 + tid; i < 4 * TT; i += gridDim.x * 512) rowss[TT + i] = 0.f;
    {
        bf16* LW = (bf16*)(a.ws + WS_LW);
        for (int i = blockIdx.x * 512 + tid; i < 2 * 81920; i += gridDim.x * 512) {
            const int l = i / 81920; int r = i - l * 81920; float v;
            if (r < 16384) { const int c = r >> 6, j = r & 63; v = a.in[I_CW2][((size_t)l * 64 + j) * 256 + c]; }
            else if (r < 32768) { r -= 16384; const int c = r >> 6, j = r & 63; v = a.in[I_CA2][((size_t)l * 64 + j) * 256 + c]; }
            else if (r < 65536) { r -= 32768; const int c = r >> 7, j = r & 127; v = a.in[I_CG2][((size_t)l * 128 + j) * 256 + c]; }
            else { r -= 65536; const int c = r >> 6, cin = r & 63; v = a.in[I_DW][(((size_t)l * 4 + (c >> 6)) * 64 + cin) * 64 + (c & 63)]; }
            LW[i] = (bf16)f2bf(v);
        }
    }
}

template <int N> __device__ __forceinline__ void prev_c(const Args& a, int l, int row, int ccol, float (&o)[N]) {
    const bf16* P = (const bf16*)(a.ws + WS_P);
    bool first, smp = row >= T_P; int b = 0;
    if (!smp) first = (row & 2047) == 0; else { const int rs = row - T_P; first = (rs & 3) == 0; b = rs >> 2; }
    const int pr = row > 0 ? row - 1 : 0;
    float pv[N], sv[N];
    ldbf<N>(P + (size_t)pr * PN + PC_C + ccol, pv);
    ldf<N>(a.in[I_SCS] + ((size_t)l * 128 + b) * 1024 + ccol, sv);
#pragma unroll
    for (int i = 0; i < N; ++i) o[i] = first ? (smp ? sv[i] : 0.f) : pv[i];
}

__device__ __forceinline__ int tile_row(int tile, int i) { return i < 64 ? tile * 64 + i : T_P + tile * 2 + (i - 64); }
constexpr int XS = 264;
template <int KSTEPS> __device__ __forceinline__ void lora_mfma(const bf16* X, int joff, const bf16* __restrict__ WT, int wave, int lane, f32x4 (&acc)[5][2]) {
    const int fr = lane & 15, fq = lane >> 4;
#pragma unroll
    for (int m = 0; m < 5; ++m) { acc[m][0] = (f32x4){0.f, 0.f, 0.f, 0.f}; acc[m][1] = (f32x4){0.f, 0.f, 0.f, 0.f}; }
#pragma unroll
    for (int k = 0; k < KSTEPS; ++k) {
        pg8::bf16x8 bf[2];
#pragma unroll
        for (int n = 0; n < 2; ++n) bf[n] = *(const pg8::bf16x8*)(WT + (size_t)(wave * 32 + n * 16 + fr) * (32 * KSTEPS) + k * 32 + 8 * fq);
#pragma unroll
        for (int m = 0; m < 5; ++m) {
            const pg8::bf16x8 af = *(const pg8::bf16x8*)(X + (m * 16 + fr) * XS + joff + k * 32 + 8 * fq);
#pragma unroll
            for (int n = 0; n < 2; ++n) acc[m][n] = __builtin_amdgcn_mfma_f32_16x16x32_bf16(bf[n], af, acc[m][n], 0, 0, 0);
        }
    }
}

__device__ __forceinline__ void aux_tile(const Args& a, int l, int tile, unsigned char* lds) {
    const int tid = otid(), c = tid & 255, half = tid >> 8;
    const bf16* P = (const bf16*)(a.ws + WS_P);
    bf16* X = (bf16*)lds;
    {
        const float mu = a.in[I_CMU][l * 1024 + 768 + c];
#pragma unroll
        for (int j = 0; j < 33; ++j) {
            const int i = half * 33 + j, row = tile_row(tile, i);
            const float cur = bf2f(P[(size_t)row * PN + PC_C + 768 + c]);
            float pv[1]; prev_c<1>(a, l, row, 768 + c, pv);
            float xm = cur + (pv[0] - cur) * mu;
            if (c < 64) xm = tanh_(xm); else if (c >= 128) xm = sigm(xm);
            X[i * XS + c] = (bf16)f2bf(xm);
        }
    }
    __syncthreads();
    const int wave = tid >> 6, lane = tid & 63, fr = lane & 15, fq = lane >> 4;
    const bf16* LW = (const bf16*)(a.ws + WS_LW) + (size_t)l * 81920;
    float* auxw = (float*)(a.ws + WS_AUXW); bf16* auxa = (bf16*)(a.ws + WS_AUXA); bf16* auxg = (bf16*)(a.ws + WS_AUXG);
    f32x4 acc[5][2];
    lora_mfma<2>(X, 0, LW, wave, lane, acc);
#pragma unroll
    for (int n = 0; n < 2; ++n) {
        const int cc = wave * 32 + n * 16 + 4 * fq;
        const float4 w0c = *(const float4*)(a.in[I_CW0] + l * 256 + cc);
#pragma unroll
        for (int m = 0; m < 5; ++m) {
            const int tok = m * 16 + fr;
            if (tok < 66) {
                float4 o;
                o.x = __expf(-__expf(-softplus_(-(w0c.x + acc[m][n][0])) - 0.5f)); o.y = __expf(-__expf(-softplus_(-(w0c.y + acc[m][n][1])) - 0.5f));
                o.z = __expf(-__expf(-softplus_(-(w0c.z + acc[m][n][2])) - 0.5f)); o.w = __expf(-__expf(-softplus_(-(w0c.w + acc[m][n][3])) - 0.5f));
                *(float4*)(auxw + (size_t)tile_row(tile, tok) * 256 + cc) = o;
            }
        }
    }
    lora_mfma<2>(X, 64, LW + 16384, wave, lane, acc);
#pragma unroll
    for (int n = 0; n < 2; ++n) {
        const int cc = wave * 32 + n * 16 + 4 * fq;
        const float4 a0c = *(const float4*)(a.in[I_CA0] + l * 256 + cc);
#pragma unroll
        for (int m = 0; m < 5; ++m) {
            const int tok = m * 16 + fr;
            if (tok < 66) { uint2 o; o.x = pk2(sigm(a0c.x + acc[m][n][0]), sigm(a0c.y + acc[m][n][1])); o.y = pk2(sigm(a0c.z + acc[m][n][2]), sigm(a0c.w + acc[m][n][3])); *(uint2*)(auxa + (size_t)tile_row(tile, tok) * 256 + cc) = o; }
        }
    }
    lora_mfma<4>(X, 128, LW + 32768, wave, lane, acc);
#pragma unroll
    for (int n = 0; n < 2; ++n) {
        const int cc = wave * 32 + n * 16 + 4 * fq;
#pragma unroll
        for (int m = 0; m < 5; ++m) {
            const int tok = m * 16 + fr;
            if (tok < 66) { uint2 o; o.x = pk2(acc[m][n][0], acc[m][n][1]); o.y = pk2(acc[m][n][2], acc[m][n][3]); *(uint2*)(auxg + (size_t)tile_row(tile, tok) * 256 + cc) = o; }
        }
    }
    __syncthreads();
}

__device__ __forceinline__ void pool_tile(const Args& a, int l, int tile, unsigned char* lds) {
    bf16* X = (bf16*)lds;
    const int tid = otid(), c = tid & 255, half = tid >> 8, r0 = tile * 64;
    const bf16* P = (const bf16*)(a.ws + WS_P);
    bf16* mixed = (bf16*)(a.ws + WS_MIXED);
    const int gi = c >> 6, w = 2 << gi;
    unsigned short* Sg = (unsigned short*)(lds + 43008);
#pragma unroll
    for (int j = 0; j < 40; ++j) {
        const int k = half * 40 + j;
        if (k < 79) { const int gr = r0 - 15 + k; unsigned short v = 0; if (gr >= 0) v = P[(size_t)gr * PN + PC_D + c]; Sg[k * 256 + c] = v; }
    }
    __syncthreads();
    for (int j = 0; j < 32; ++j) {
        const int i = half * 32 + j, row = r0 + i;
        const unsigned short* sp = Sg + (15 + i) * 256 + c;
        const float xc = bf2f(sp[0]);
        const int b = row >> 11, t = row & 2047;
        const int n = t + 1 < w ? t + 1 : w;
        float sum = xc;
#pragma unroll
        for (int q = 1; q < 16; ++q) { const float hv = bf2f(sp[-q * 256]); if (q < n) sum += hv; }
        if (t >= 2033) a.out[O_PDP + (((size_t)l * 8 + b) * 15 + (t - 2033)) * 256 + c] = xc;
        X[i * XS + c] = (bf16)f2bf(sum / (float)n - xc);
    }
    {
        const int i = 64 + half, rs = tile * 2 + half, row = T_P + rs, b = rs >> 2, t = rs & 3;
        const float* sb = a.in[I_SDP] + ((size_t)l * 128 + b) * 15 * 256 + c;
        const float xc = bf2f(P[(size_t)row * PN + PC_D + c]);
        float hv[15];
#pragma unroll
        for (int q = 1; q < 16; ++q) {
            const int tq = t - q;
            const float pv = bf2f(P[(size_t)(row - (tq >= 0 ? q : 0)) * PN + PC_D + c]);
            const float sv = sb[(tq >= 0 ? 0 : 15 + tq) * 256];
            hv[q - 1] = tq >= 0 ? pv : sv;
        }
        float sum = xc;
#pragma unroll
        for (int q = 1; q < 16; ++q) if (q < w) sum += hv[q - 1];
        float* so = a.out + O_SDP + ((size_t)l * 128 + b) * 15 * 256 + c;
        so[(11 + t) * 256] = xc;
        if (t == 0) {
            float tv[11];
#pragma unroll
            for (int jj = 0; jj < 11; ++jj) tv[jj] = sb[(jj + 4) * 256];
#pragma unroll
            for (int jj = 0; jj < 11; ++jj) so[jj * 256] = tv[jj];
        }
        X[i * XS + c] = (bf16)f2bf(sum / (float)w - xc);
    }
    __syncthreads();
    {
        const int wave = tid >> 6, lane = tid & 63, fr = lane & 15, fq = lane >> 4;
        const bf16* LW = (const bf16*)(a.ws + WS_LW) + (size_t)l * 81920 + 65536;
        f32x4 acc[5][2];
        lora_mfma<2>(X, (wave >> 1) * 64, LW, wave, lane, acc);
#pragma unroll
        for (int n = 0; n < 2; ++n) {
            const int cc = wave * 32 + n * 16 + 4 * fq;
            const float4 sc = *(const float4*)(a.in[I_DSC] + l * 256 + cc);
#pragma unroll
            for (int m = 0; m < 5; ++m) {
                const int tok = m * 16 + fr;
                if (tok < 66) { uint2 o; o.x = pk2(acc[m][n][0] * sc.x, acc[m][n][1] * sc.y); o.y = pk2(acc[m][n][2] * sc.z, acc[m][n][3] * sc.w); *(uint2*)(mixed + (size_t)tile_row(tile, tok) * 1024 + 768 + cc) = o; }
            }
        }
    }
    for (int i = 0; i < 66; ++i) {
        const int row = tile_row(tile, i); int b, t, tl; bool smp;
        if (row < T_P) { b = row >> 11; t = row & 2047; tl = 2047; smp = false; } else { const int rs = row - T_P; b = rs >> 2; t = rs & 3; tl = 3; smp = true; }
        if (t == tl) {
            float* o = a.out + (smp ? O_SCS + ((size_t)l * 128 + b) * 1024 : O_PCS + ((size_t)l * 8 + b) * 1024);
            const float v0 = bf2f(P[(size_t)row * PN + PC_C + tid]), v1 = bf2f(P[(size_t)row * PN + PC_C + 512 + tid]);
            o[tid] = v0; o[512 + tid] = v1;
        }
        if (t >= tl - 2) {
            const int j = t - (tl - 2);
            float* o = a.out + (smp ? O_SBC + (((size_t)l * 128 + b) * 3 + j) * 768 : O_PBC + (((size_t)l * 8 + b) * 3 + j) * 768);
            const float v0 = bf2f(P[(size_t)row * PN + PC_BQ + tid]);
            o[tid] = v0;
            if (tid < 256) o[512 + tid] = bf2f(P[(size_t)row * PN + PC_BQ + 512 + tid]);
        }
    }
    __syncthreads();
}

__device__ __forceinline__ void gmlp_prompt_item(const Args& a, int l, int it, unsigned char* lds) {
    const int tid = otid(), t = tid >> 2, q = tid & 3;
    const int b = it >> 6, nc = (it >> 2) & 15, h = it & 3;
    const int row = b * 2048 + nc * 128 + t;
    const bf16* Pb = (const bf16*)(a.ws + WS_P);
    const bf16* Prow = Pb + (size_t)row * PN;
    bf16* mixed = (bf16*)(a.ws + WS_MIXED);
    bf16* wsb = (bf16*)lds;
    bf16* vT = (bf16*)(lds + 34816);
    float ss = 0.f;
#pragma unroll
    for (int k = 0; k < 8; ++k) { float x[8]; ld8(Prow + 256 + q * 64 + k * 8, x);
#pragma unroll
        for (int e = 0; e < 8; ++e) { const float g = gelu_t(x[e]); ss += g * g; } }
    ss += __shfl_xor(ss, 1); ss += __shfl_xor(ss, 2);
    const float rstd = rsqrtf(ss * (1.f / 256.f) + NORM_EPS);
    {
        const float* vg = a.in[I_AVG] + l * 256 + h * 64 + q * 16;
#pragma unroll
        for (int k = 0; k < 2; ++k) { float x[8]; ld8(Prow + 256 + h * 64 + q * 16 + k * 8, x);
#pragma unroll
            for (int e = 0; e < 8; ++e) vT[(q * 16 + k * 8 + e) * 136 + t] = (bf16)f2bf(gelu_t(x[e]) * rstd * vg[k * 8 + e]); }
    }
    {
        const float* wsrc = a.in[I_AWS] + ((size_t)l * 4 + h) * 16384;
        float4 wv[8];
#pragma unroll
        for (int j = 0; j < 8; ++j) { const int idx = tid + 512 * j; wv[j] = *(const float4*)(wsrc + (idx >> 5) * 128 + (idx & 31) * 4); }
#pragma unroll
        for (int j = 0; j < 8; ++j) {
            const int idx = tid + 512 * j, rr = idx >> 5, s0 = (idx & 31) * 4;
            uint2 o; o.x = pk2(s0 <= rr ? wv[j].x : 0.f, s0 + 1 <= rr ? wv[j].y : 0.f); o.y = pk2(s0 + 2 <= rr ? wv[j].z : 0.f, s0 + 3 <= rr ? wv[j].w : 0.f);
            *(uint2*)(wsb + rr * 136 + s0) = o;
        }
    }
    __syncthreads();
    const int wave = tid >> 6, lane = tid & 63, fr = lane & 15, fq = lane >> 4;
    f32x4 acc[4];
#pragma unroll
    for (int n = 0; n < 4; ++n) acc[n] = (f32x4){0.f, 0.f, 0.f, 0.f};
    const int nk = (wave >> 1) + 1;
#pragma unroll
    for (int k = 0; k < 4; ++k) {
        if (k < nk) {
            const pg8::bf16x8 af = *(const pg8::bf16x8*)(wsb + (wave * 16 + fr) * 136 + k * 32 + 8 * fq);
#pragma unroll
            for (int n = 0; n < 4; ++n) { const pg8::bf16x8 bfr = *(const pg8::bf16x8*)(vT + (n * 16 + fr) * 136 + k * 32 + 8 * fq); acc[n] = __builtin_amdgcn_mfma_f32_16x16x32_bf16(bfr, af, acc[n], 0, 0, 0); }
        }
    }
    {
        const int tt = wave * 16 + fr, ro = b * 2048 + nc * 128 + tt;
        const float bs = a.in[I_ABS][((size_t)l * 4 + h) * 128 + tt];
#pragma unroll
        for (int n = 0; n < 4; ++n) {
            const int cc = h * 64 + n * 16 + 4 * fq;
            float u[4]; ld4(Pb + (size_t)ro * PN + cc, u);
            uint2 o; o.x = pk2(gelu_t(u[0]) * (acc[n][0] + bs), gelu_t(u[1]) * (acc[n][1] + bs)); o.y = pk2(gelu_t(u[2]) * (acc[n][2] + bs), gelu_t(u[3]) * (acc[n][3] + bs));
            *(uint2*)(mixed + (size_t)ro * 1024 + cc) = o;
        }
    }
    __syncthreads();
}
__device__ __forceinline__ void gmlp_sample_item(const Args& a, int l, int b, float* Ls  ) {
    const int tid = otid(), lane = tid & 63, wave = tid >> 6, t = tid >> 7, c0 = (tid & 127) * 2;
    const int row = T_P + b * 4 + t;
    const bf16* Prow = (const bf16*)(a.ws + WS_P) + (size_t)row * PN;
    bf16* mixed = (bf16*)(a.ws + WS_MIXED);
    float* red = Ls + 1024;
    float x[2]; ld2(Prow + 256 + c0, x);
    const float g0 = gelu_t(x[0]), g1 = gelu_t(x[1]);
    const float ss = wave_sum(g0 * g0 + g1 * g1);
    if (lane == 0) red[wave] = ss;
    __syncthreads();
    const float rstd = rsqrtf((red[2 * t] + red[2 * t + 1]) * (1.f / 256.f) + NORM_EPS);
    const float v0 = g0 * rstd * a.in[I_AVG][l * 256 + c0], v1 = g1 * rstd * a.in[I_AVG][l * 256 + c0 + 1];
    Ls[t * 256 + c0] = v0; Ls[t * 256 + c0 + 1] = v1;
    float* sav = a.out + O_SAV + (((size_t)l * 128 + b) * 4 + t) * 256 + c0;
    sav[0] = v0; sav[1] = v1;
    __syncthreads();
    const int h = c0 >> 6;
    const float* wrow = a.in[I_AWS] + (((size_t)l * 4 + h) * 128 + t) * 128;
    const float bs = a.in[I_ABS][((size_t)l * 4 + h) * 128 + t];
    float m0 = bs, m1 = bs;
    for (int s = 0; s <= t; ++s) { const float ww = wrow[s]; m0 += ww * Ls[s * 256 + c0]; m1 += ww * Ls[s * 256 + c0 + 1]; }
    float u[2]; ld2(Prow + c0, u);
    *(unsigned*)(mixed + (size_t)row * 1024 + c0) = pk2(gelu_t(u[0]) * m0, gelu_t(u[1]) * m1);
    __syncthreads();
}

__device__ __forceinline__ void ba_tile(const Args& a, int l, int tile, unsigned char* lds) {
    const int tid = otid(), wave = tid >> 6, lane = tid & 63, fr = lane & 15, fq = lane >> 4;
    const bf16* xb = (const bf16*)(a.ws + WS_XB);
    const bf16* BAW = (const bf16*)(a.ws + WS_BAW) + (size_t)l * 16384;
    float* red = (float*)lds;
    f32x4 acc[5];
#pragma unroll
    for (int m = 0; m < 5; ++m) acc[m] = (f32x4){0.f, 0.f, 0.f, 0.f};
#pragma unroll
    for (int k = 0; k < 4; ++k) {
        const int kk = wave * 128 + k * 32 + 8 * fq;
        const pg8::bf16x8 bfr = *(const pg8::bf16x8*)(BAW + fr * 1024 + kk);
#pragma unroll
        for (int m = 0; m < 5; ++m) {
            const int tok = m * 16 + fr, row = tile_row(tile, tok < 66 ? tok : 65);
            const pg8::bf16x8 af = *(const pg8::bf16x8*)(xb + (size_t)row * 1024 + kk);
            acc[m] = __builtin_amdgcn_mfma_f32_16x16x32_bf16(bfr, af, acc[m], 0, 0, 0);
        }
    }
#pragma unroll
    for (int m = 0; m < 5; ++m) *(f32x4*)(red + ((wave * 80) + m * 16 + fr) * 16 + 4 * fq) = acc[m];
    __syncthreads();
    const float* rss = (const float*)(a.ws + WS_ROWSS) + (size_t)(2 * l) * TT;
    float* BA = (float*)(a.ws + WS_BA);
    for (int e = tid; e < 66 * 8; e += 512) {
        const int tok = e >> 3, n = e & 7, row = tile_row(tile, tok);
        float s = 0.f;
#pragma unroll
        for (int w = 0; w < 8; ++w) s += red[(w * 80 + tok) * 16 + n];
        BA[(size_t)row * 8 + n] = s * rsqrtf(rss[row] * (1.f / 1024.f) + NORM_EPS);
    }
    __syncthreads();
}

__device__ __forceinline__ void phase_pre(const Args& a, int l, unsigned char* lds, int mode = 0) {
    float* L = (float*)lds;
    const int G = gridDim.x, g = blockIdx.x;
    if (mode != 2) for (int tile = g; tile < 256; tile += G) { aux_tile(a, l, tile, lds); pool_tile(a, l, tile, lds); ba_tile(a, l, tile, lds); }
    if (mode != 1) for (int it = g; it < 512; it += G) gmlp_prompt_item(a, l, it, lds);
    for (int it = g; it < 128; it += G) gmlp_sample_item(a, l, it, L);
}

struct ChunkD { int valid, mixer, h, cg, b, sample, row0, t0, n, first, last; };
__device__ __forceinline__ ChunkD get_chunk(int idx, int g, int G, int mode = 0) {
    ChunkD d; d.valid = 0; d.mixer = 0; d.h = 0; d.cg = 0; d.b = 0; d.sample = 0; d.row0 = 0; d.t0 = 0; d.n = 0; d.first = 0; d.last = 0;
    int nP = g < 256 ? (256 - g + G - 1) / G : 0;
    int nS = g < 4096 ? (4096 - g + G - 1) / G : 0;
    nS = 0;
    if (mode == 2) nP = 0;
    if (idx < nP * 64) {
        const int gi = g + (idx >> 6) * G, ch = idx & 63;
        const int it = (G == 256) ? (gi & 7) * 32 + (gi >> 3) : gi;
        d.valid = 1; d.cg = it & 3; d.mixer = (it >> 2) & 1; d.h = (it >> 3) & 3; d.b = it >> 5; d.sample = 0; d.row0 = d.b * 2048; d.t0 = ch * 32; d.n = 32; d.first = ch == 0; d.last = ch == 63;
    } else {
        const int j = idx - nP * 64;
        if (j < nS) { const int it = g + j * G; d.valid = 1; d.mixer = it & 1; d.cg = (it >> 1) & 3; d.h = (it >> 3) & 3; d.b = it >> 5; d.sample = 1; d.row0 = T_P + d.b * 4; d.t0 = 0; d.n = 4; d.first = 1; d.last = 1; }
    }
    return d;
}
constexpr int OPB_FLOATS = 10752;

struct Raw { uint4 u[8]; unsigned s[4]; float w[2]; };
__device__ __forceinline__ void unpack8(const uint4 u, float (&o)[8]) {
    o[0] = __uint_as_float(u.x << 16); o[1] = __uint_as_float(u.x & 0xffff0000u); o[2] = __uint_as_float(u.y << 16); o[3] = __uint_as_float(u.y & 0xffff0000u);
    o[4] = __uint_as_float(u.z << 16); o[5] = __uint_as_float(u.z & 0xffff0000u); o[6] = __uint_as_float(u.w << 16); o[7] = __uint_as_float(u.w & 0xffff0000u);
}
__device__ __forceinline__ uint4 pack8f(const float* p) {
    const float4 x = *(const float4*)p, y = *(const float4*)(p + 4);
    uint4 o; o.x = pk2(x.x, x.y); o.y = pk2(x.z, x.w); o.z = pk2(y.x, y.y); o.w = pk2(y.z, y.w); return o;
}
__device__ __forceinline__ void raw_load(const Args& a, int l, const ChunkD& d, int ptid, Raw& R) {
    const int tok = ptid >> 3, sub = ptid & 7;
    if (!d.valid || tok >= d.n) return;
    const int t = d.t0 + tok, row = d.row0 + t;
    const bf16* P = (const bf16*)(a.ws + WS_P);
    const uint4 z4 = make_uint4(0u, 0u, 0u, 0u);
    if (d.mixer == 0) {
        const int cq = d.h * 64 + sub * 8, cv = 512 + d.h * 64 + d.cg * 16 + sub * 2;
#pragma unroll
        for (int k = 0; k < 4; ++k) {
            const int tt = t - 3 + k;
            if (tt >= 0) { const bf16* pr = P + (size_t)(d.row0 + tt) * PN + PC_BQ; R.u[k] = *(const uint4*)(pr + cq); R.u[4 + k] = *(const uint4*)(pr + 256 + cq); R.s[k] = *(const unsigned*)(pr + cv); }
            else if (d.sample) { const float* sp = a.in[I_SBC] + (((size_t)l * 128 + d.b) * 3 + (tt + 3)) * 768; R.u[k] = pack8f(sp + cq); R.u[4 + k] = pack8f(sp + 256 + cq); R.s[k] = pk2(sp[cv], sp[cv + 1]); }
            else { R.u[k] = z4; R.u[4 + k] = z4; R.s[k] = 0u; }
        }
        { const float* ba = (const float*)(a.ws + WS_BA) + (size_t)row * 8; R.w[0] = ba[d.h]; R.w[1] = ba[4 + d.h]; }
    } else {
        const int ch = d.h * 64 + sub * 8, vcl = 512 + d.h * 64 + d.cg * 16 + sub * 2;
        const bf16* pc = P + (size_t)row * PN + PC_C;
        R.u[0] = *(const uint4*)(pc + ch); R.u[1] = *(const uint4*)(pc + 256 + ch); R.s[0] = *(const unsigned*)(pc + vcl);
        if (t > 0) { const bf16* pp = pc - PN; R.u[2] = *(const uint4*)(pp + ch); R.u[3] = *(const uint4*)(pp + 256 + ch); R.s[1] = *(const unsigned*)(pp + vcl); }
        else if (d.sample) { const float* sp = a.in[I_SCS] + ((size_t)l * 128 + d.b) * 1024; R.u[2] = pack8f(sp + ch); R.u[3] = pack8f(sp + 256 + ch); R.s[1] = pk2(sp[vcl], sp[vcl + 1]); }
        else { R.u[2] = z4; R.u[3] = z4; R.s[1] = 0u; }
        R.u[4] = *(const uint4*)((const bf16*)(a.ws + WS_AUXA) + (size_t)row * 256 + ch);
        const float* wp = (const float*)(a.ws + WS_AUXW) + (size_t)row * 256 + ch;
        R.u[5] = *(const uint4*)wp; R.u[6] = *(const uint4*)(wp + 4);
    }
}
__device__ __forceinline__ void prep_math(const Args& a, int l, const ChunkD& d, const Raw& R, float* ob, float* CST, int ptid) {
    const int tok = ptid >> 3, sub = ptid & 7;
    if (!d.valid || tok >= d.n) return;
    const int row = d.row0 + d.t0 + tok;
    float* Rp = ob + tok * 64 + sub * 8;
    float* V = ob + 10240 + tok * 16 + sub * 2;
    float r[8], w[8], k[8], kk[8], bb[8], v[2];
    if (d.mixer == 0) {
        const int cq = d.h * 64 + sub * 8, cv = 512 + d.h * 64 + d.cg * 16 + sub * 2;
        float q[8], kr[8];
#pragma unroll
        for (int i = 0; i < 8; ++i) { q[i] = 0.f; kr[i] = 0.f; }
        v[0] = 0.f; v[1] = 0.f;
        float* cst = CST + sub * 80;
        if (d.first) {
#pragma unroll
            for (int kx = 0; kx < 4; ++kx) {
                const float* cw = a.in[I_BCW] + ((size_t)l * 4 + kx) * 768;
                *(float4*)(cst + kx * 20) = *(const float4*)(cw + cq); *(float4*)(cst + kx * 20 + 4) = *(const float4*)(cw + cq + 4);
                *(float4*)(cst + kx * 20 + 8) = *(const float4*)(cw + 256 + cq); *(float4*)(cst + kx * 20 + 12) = *(const float4*)(cw + 256 + cq + 4);
                *(float2*)(cst + kx * 20 + 16) = *(const float2*)(cw + cv);
            }
        }
#pragma unroll
        for (int kx = 0; kx < 4; ++kx) {
            float xq[8], xk[8]; unpack8(R.u[kx], xq); unpack8(R.u[4 + kx], xk);
            const float4 a0 = *(const float4*)(cst + kx * 20), a1 = *(const float4*)(cst + kx * 20 + 4), b0 = *(const float4*)(cst + kx * 20 + 8), b1 = *(const float4*)(cst + kx * 20 + 12);
            const float2 c0 = *(const float2*)(cst + kx * 20 + 16);
            q[0] += xq[0] * a0.x; q[1] += xq[1] * a0.y; q[2] += xq[2] * a0.z; q[3] += xq[3] * a0.w; q[4] += xq[4] * a1.x; q[5] += xq[5] * a1.y; q[6] += xq[6] * a1.z; q[7] += xq[7] * a1.w;
            kr[0] += xk[0] * b0.x; kr[1] += xk[1] * b0.y; kr[2] += xk[2] * b0.z; kr[3] += xk[3] * b0.w; kr[4] += xk[4] * b1.x; kr[5] += xk[5] * b1.y; kr[6] += xk[6] * b1.z; kr[7] += xk[7] * b1.w;
            v[0] += __uint_as_float(R.s[kx] << 16) * c0.x; v[1] += __uint_as_float(R.s[kx] & 0xffff0000u) * c0.y;
        }
        float sq = 0.f, sk = 0.f;
#pragma unroll
        for (int i = 0; i < 8; ++i) { q[i] = silu(q[i]); kr[i] = silu(kr[i]); sq += q[i] * q[i]; sk += kr[i] * kr[i]; }
        v[0] = silu(v[0]); v[1] = silu(v[1]);
        sq = sum8(sq); sk = sum8(sk);
        const float iq = rsqrtf(sq + 1e-6f) * 0.125f, ik = rsqrtf(sk + 1e-6f);
        const float beta = sigm(R.w[0]);
        const float gg = -__expf(a.in[I_BAL][l * 4 + d.h]) * softplus_(R.w[1] + a.in[I_BDT][l * 4 + d.h]);
        const float dec = __expf(gg);
#pragma unroll
        for (int i = 0; i < 8; ++i) { const float kn = kr[i] * ik; r[i] = q[i] * iq; w[i] = dec; kk[i] = kn; k[i] = beta * kn; bb[i] = dec * beta * kn; }
    } else {
        const int ch = d.h * 64 + sub * 8, vcl = 512 + d.h * 64 + d.cg * 16 + sub * 2;
        float cur[8], pv[8], kx[8], av[8];
        const float* mu = a.in[I_CMU] + l * 1024;
        float m0[8], m1[8], kkw[8], kaw[8], rkw[8];
        float* cst = CST + sub * 80;
        if (d.first) {
            *(float4*)(cst) = *(const float4*)(mu + ch); *(float4*)(cst + 4) = *(const float4*)(mu + ch + 4);
            *(float4*)(cst + 8) = *(const float4*)(mu + 256 + ch); *(float4*)(cst + 12) = *(const float4*)(mu + 256 + ch + 4);
            const float* p1 = a.in[I_CKK] + l * 256 + ch; *(float4*)(cst + 16) = *(const float4*)p1; *(float4*)(cst + 20) = *(const float4*)(p1 + 4);
            const float* p2 = a.in[I_CKA] + l * 256 + ch; *(float4*)(cst + 24) = *(const float4*)p2; *(float4*)(cst + 28) = *(const float4*)(p2 + 4);
            const float* p3 = a.in[I_CRK] + l * 256 + ch; *(float4*)(cst + 32) = *(const float4*)p3; *(float4*)(cst + 36) = *(const float4*)(p3 + 4);
            *(float2*)(cst + 40) = *(const float2*)(mu + vcl);
        }
        ldf<8>(cst, m0); ldf<8>(cst + 8, m1); ldf<8>(cst + 16, kkw); ldf<8>(cst + 24, kaw); ldf<8>(cst + 32, rkw);
        const float mv0 = cst[40], mv1 = cst[41];
        unpack8(R.u[0], cur); unpack8(R.u[2], pv);
#pragma unroll
        for (int i = 0; i < 8; ++i) r[i] = cur[i] + (pv[i] - cur[i]) * m0[i];
        unpack8(R.u[1], cur); unpack8(R.u[3], pv);
#pragma unroll
        for (int i = 0; i < 8; ++i) kx[i] = cur[i] + (pv[i] - cur[i]) * m1[i];
        {
            const float c0 = __uint_as_float(R.s[0] << 16), c1 = __uint_as_float(R.s[0] & 0xffff0000u), p0 = __uint_as_float(R.s[1] << 16), p1 = __uint_as_float(R.s[1] & 0xffff0000u);
            v[0] = c0 + (p0 - c0) * mv0; v[1] = c1 + (p1 - c1) * mv1;
        }
        unpack8(R.u[4], av);
        float ss = 0.f;
#pragma unroll
        for (int i = 0; i < 8; ++i) { kk[i] = kx[i] * kkw[i]; ss += kk[i] * kk[i]; }
        w[0] = __uint_as_float(R.u[5].x); w[1] = __uint_as_float(R.u[5].y); w[2] = __uint_as_float(R.u[5].z); w[3] = __uint_as_float(R.u[5].w); w[4] = __uint_as_float(R.u[6].x); w[5] = __uint_as_float(R.u[6].y); w[6] = __uint_as_float(R.u[6].z); w[7] = __uint_as_float(R.u[6].w);
        ss = sum8(ss);
        const float inv = rsqrtf(ss + 1e-6f);
        float rk = 0.f;
#pragma unroll
        for (int i = 0; i < 8; ++i) { kk[i] *= inv; k[i] = kx[i] * (1.f + (av[i] - 1.f) * kaw[i]); bb[i] = kk[i] * av[i]; rk += r[i] * k[i] * rkw[i]; }
        rk = sum8(rk);
        if (sub == 0 && d.cg == 0) ((float*)(a.ws + WS_RK))[(size_t)row * 4 + d.h] = rk;
    }
    *(float4*)(Rp) = make_float4(r[0], r[1], r[2], r[3]); *(float4*)(Rp + 4) = make_float4(r[4], r[5], r[6], r[7]);
    *(float4*)(Rp + 2048) = make_float4(w[0], w[1], w[2], w[3]); *(float4*)(Rp + 2052) = make_float4(w[4], w[5], w[6], w[7]);
    *(float4*)(Rp + 4096) = make_float4(k[0], k[1], k[2], k[3]); *(float4*)(Rp + 4100) = make_float4(k[4], k[5], k[6], k[7]);
    *(float4*)(Rp + 6144) = make_float4(kk[0], kk[1], kk[2], kk[3]); *(float4*)(Rp + 6148) = make_float4(kk[4], kk[5], kk[6], kk[7]);
    *(float4*)(Rp + 8192) = make_float4(bb[0], bb[1], bb[2], bb[3]); *(float4*)(Rp + 8196) = make_float4(bb[4], bb[5], bb[6], bb[7]);
    V[0] = v[0]; V[1] = v[1];
}

__device__ __forceinline__ void flush_y(const Args& a, const ChunkD& d, const float* Yb, int ptid) {
    if (!d.valid) return;
    float* yraw = (float*)(a.ws + WS_XB) + (size_t)d.mixer * TT * 256;
    for (int e = ptid; e < d.n * 16; e += 256) {
        const float4* yp = (const float4*)(Yb + e * 16);
        const float4 a0 = yp[0], a1 = yp[1], a2 = yp[2], a3 = yp[3];
        const float y = ((a0.x + a0.y) + (a0.z + a0.w)) + ((a1.x + a1.y) + (a1.z + a1.w)) + ((a2.x + a2.y) + (a2.z + a2.w)) + ((a3.x + a3.y) + (a3.z + a3.w));
        const int st = e >> 4, c = e & 15; yraw[(size_t)(d.row0 + d.t0 + st) * 256 + d.h * 64 + d.cg * 16 + c] = y;
    }
}

typedef float f2 __attribute__((ext_vector_type(2)));
struct Ops { f32x4 r, w, k, q, b; float v; };
__device__ __forceinline__ void ops_load(Ops& o, const float* Rb, const float* Vb, int st) {
    o.r = *(const f32x4*)(Rb + st * 64); o.w = *(const f32x4*)(Rb + 2048 + st * 64); o.k = *(const f32x4*)(Rb + 4096 + st * 64);
    o.q = *(const f32x4*)(Rb + 6144 + st * 64); o.b = *(const f32x4*)(Rb + 8192 + st * 64); o.v = Vb[st * 16];
}
__device__ __forceinline__ void scan_step(const Ops& o, f2& S01, f2& S23, float* Yp) {
    const f2 p2 = o.q.xy * S01 + o.q.zw * S23;
    const float sk = dpp_sum16(p2.x + p2.y);
    const f2 vv = {o.v, o.v}, sk2 = {sk, sk};
    const f2 t01 = o.k.xy * vv - o.b.xy * sk2, t23 = o.k.zw * vv - o.b.zw * sk2;
    S01 = o.w.xy * S01 + t01; S23 = o.w.zw * S23 + t23;
    const f2 y2 = o.r.xy * S01 + o.r.zw * S23;
    *Yp = y2.x + y2.y;
}
__device__ __forceinline__ const float* state_in_ptr(const Args& a, int l, const ChunkD& d, int kg, int cc) {
    return a.in[d.mixer ? I_SCW : I_SBS] + ((((size_t)l * 128 + d.b) * 4 + d.h) * 64 + 4 * kg) * 64 + d.cg * 16 + cc;
}
__device__ __forceinline__ void consume_chunk(const Args& a, int l, const ChunkD& d, const ChunkD& nx, const float* ob, float* Yb, f2& S01, f2& S23, float (&Sn)[4], int wave, int lane) {
    const int kg = lane & 15, cc = wave * 4 + (lane >> 4);
    if (d.first) {
        if (d.sample) { S01.x = Sn[0]; S01.y = Sn[1]; S23.x = Sn[2]; S23.y = Sn[3]; }
        else { S01.x = 0.f; S01.y = 0.f; S23.x = 0.f; S23.y = 0.f; }
    }
    if (nx.valid && nx.first && nx.sample) { const float* sp = state_in_ptr(a, l, nx, kg, cc); Sn[0] = sp[0]; Sn[1] = sp[64]; Sn[2] = sp[128]; Sn[3] = sp[192]; }
    const float* Rb = ob + 4 * kg; const float* Vb = ob + 10240 + cc; float* Yp = Yb + cc * 16 + kg;
    Ops o0, o1, o2;
    ops_load(o0, Rb, Vb, 0); ops_load(o1, Rb, Vb, 1);
    for (int st = 0; st < d.n; st += 4) {
        ops_load(o2, Rb, Vb, st + 2); scan_step(o0, S01, S23, Yp + st * 256);
        ops_load(o0, Rb, Vb, st + 3); scan_step(o1, S01, S23, Yp + (st + 1) * 256);
        ops_load(o1, Rb, Vb, st + 4); scan_step(o2, S01, S23, Yp + (st + 2) * 256);
        ops_load(o2, Rb, Vb, st + 5); scan_step(o0, S01, S23, Yp + (st + 3) * 256);
        o0 = o1; o1 = o2;
    }
    if (d.last) {
        size_t off;
        if (d.sample) off = (d.mixer ? O_SCW : O_SBS) + ((((size_t)l * 128 + d.b) * 4 + d.h) * 64 + 4 * kg) * 64 + d.cg * 16 + cc;
        else off = (d.mixer ? O_PCW : O_PBS) + ((((size_t)l * 8 + d.b) * 4 + d.h) * 64 + 4 * kg) * 64 + d.cg * 16 + cc;
        float* sp = a.out + off;
        sp[0] = S01.x; sp[64] = S01.y; sp[128] = S23.x; sp[192] = S23.y;
    }
}

__device__ __forceinline__ void sample_item(const Args& a, int l, int it, float* wl  , int lane) {
    const int mixer = it & 1, h = (it >> 1) & 3, b = it >> 3;
    const bf16* P = (const bf16*)(a.ws + WS_P);
    const int row0 = T_P + b * 4;
    float S[64];
    {
        const float* sp = a.in[mixer ? I_SCW : I_SBS] + (((size_t)l * 128 + b) * 4 + h) * 4096 + lane;
#pragma unroll
        for (int k = 0; k < 64; ++k) S[k] = sp[k * 64];
    }
    float* yraw = (float*)(a.ws + WS_XB) + (size_t)mixer * TT * 256;
    const int ch = h * 64 + lane;
    float cq[4], ck[4], cv[4], mur = 0.f, muk = 0.f, muv = 0.f, kkw = 0.f, kaw = 0.f, rkw = 0.f, alog = 0.f, dtb = 0.f;
    if (mixer == 0) {
#pragma unroll
        for (int k = 0; k < 4; ++k) { const float* cw = a.in[I_BCW] + ((size_t)l * 4 + k) * 768; cq[k] = cw[ch]; ck[k] = cw[256 + ch]; cv[k] = cw[512 + ch]; }
        alog = a.in[I_BAL][l * 4 + h]; dtb = a.in[I_BDT][l * 4 + h];
    } else {
#pragma unroll
        for (int k = 0; k < 4; ++k) { cq[k] = 0.f; ck[k] = 0.f; cv[k] = 0.f; }
        const float* mu = a.in[I_CMU] + l * 1024; mur = mu[ch]; muk = mu[256 + ch]; muv = mu[512 + ch];
        kkw = a.in[I_CKK][l * 256 + ch]; kaw = a.in[I_CKA][l * 256 + ch]; rkw = a.in[I_CRK][l * 256 + ch];
    }
    float xq[7], xk[7], xv[7];
    if (mixer == 0) {
        const float* sb = a.in[I_SBC] + ((size_t)l * 128 + b) * 3 * 768;
#pragma unroll
        for (int j = 0; j < 3; ++j) { xq[j] = sb[j * 768 + ch]; xk[j] = sb[j * 768 + 256 + ch]; xv[j] = sb[j * 768 + 512 + ch]; }
#pragma unroll
        for (int j = 0; j < 4; ++j) { const bf16* pr = P + (size_t)(row0 + j) * PN + PC_BQ; xq[3 + j] = bf2f(pr[ch]); xk[3 + j] = bf2f(pr[256 + ch]); xv[3 + j] = bf2f(pr[512 + ch]); }
    } else {
        const float* sc = a.in[I_SCS] + ((size_t)l * 128 + b) * 1024;
        xq[0] = 0.f; xk[0] = 0.f; xv[0] = 0.f; xq[1] = 0.f; xk[1] = 0.f; xv[1] = 0.f;
        xq[2] = sc[ch]; xk[2] = sc[256 + ch]; xv[2] = sc[512 + ch];
#pragma unroll
        for (int j = 0; j < 4; ++j) { const bf16* pr = P + (size_t)(row0 + j) * PN + PC_C; xq[3 + j] = bf2f(pr[ch]); xk[3 + j] = bf2f(pr[256 + ch]); xv[3 + j] = bf2f(pr[512 + ch]); }
    }
#pragma unroll
    for (int t = 0; t < 4; ++t) {
        const int row = row0 + t;
        float r, w, k, kk, bb, v;
        if (mixer == 0) {
            const float q0 = silu(xq[t] * cq[0] + xq[t + 1] * cq[1] + xq[t + 2] * cq[2] + xq[t + 3] * cq[3]);
            const float k0 = silu(xk[t] * ck[0] + xk[t + 1] * ck[1] + xk[t + 2] * ck[2] + xk[t + 3] * ck[3]);
            v = silu(xv[t] * cv[0] + xv[t + 1] * cv[1] + xv[t + 2] * cv[2] + xv[t + 3] * cv[3]);
            const float iq = rsqrtf(wave_sum(q0 * q0) + 1e-6f) * 0.125f, ik = rsqrtf(wave_sum(k0 * k0) + 1e-6f);
            const float* ba = (const float*)(a.ws + WS_BA) + (size_t)row * 8;
            const float beta = sigm(ba[h]);
            const float dec = __expf(-__expf(alog) * softplus_(ba[4 + h] + dtb));
            const float kn = k0 * ik; r = q0 * iq; w = dec; kk = kn; k = beta * kn; bb = dec * beta * kn;
        } else {
            r = xq[3 + t] + (xq[2 + t] - xq[3 + t]) * mur;
            const float kx = xk[3 + t] + (xk[2 + t] - xk[3 + t]) * muk;
            v = xv[3 + t] + (xv[2 + t] - xv[3 + t]) * muv;
            w = ((const float*)(a.ws + WS_AUXW))[(size_t)row * 256 + ch];
            const float av = bf2f(((const bf16*)(a.ws + WS_AUXA))[(size_t)row * 256 + ch]);
            const float kr = kx * kkw;
            kk = kr * rsqrtf(wave_sum(kr * kr) + 1e-6f);
            k = kx * (1.f + (av - 1.f) * kaw); bb = kk * av;
            const float rk = wave_sum(r * k * rkw);
            if (lane == 0) ((float*)(a.ws + WS_RK))[(size_t)row * 4 + h] = rk;
        }
        wl[lane] = r; wl[64 + lane] = w; wl[128 + lane] = k; wl[192 + lane] = kk; wl[256 + lane] = bb;
        LDS_WAIT();
        float sk = 0.f;
#pragma unroll
        for (int k4 = 0; k4 < 16; ++k4) { const float4 x = *(const float4*)(wl + 192 + 4 * k4); sk += (x.x * S[4 * k4] + x.y * S[4 * k4 + 1]) + (x.z * S[4 * k4 + 2] + x.w * S[4 * k4 + 3]); }
        float y = 0.f;
#pragma unroll
        for (int k4 = 0; k4 < 16; ++k4) {
            const float4 ww = *(const float4*)(wl + 64 + 4 * k4), kx4 = *(const float4*)(wl + 128 + 4 * k4), b4 = *(const float4*)(wl + 256 + 4 * k4), r4 = *(const float4*)(wl + 4 * k4);
            S[4 * k4 + 0] = ww.x * S[4 * k4 + 0] + (kx4.x * v - b4.x * sk); S[4 * k4 + 1] = ww.y * S[4 * k4 + 1] + (kx4.y * v - b4.y * sk);
            S[4 * k4 + 2] = ww.z * S[4 * k4 + 2] + (kx4.z * v - b4.z * sk); S[4 * k4 + 3] = ww.w * S[4 * k4 + 3] + (kx4.w * v - b4.w * sk);
            y += (r4.x * S[4 * k4 + 0] + r4.y * S[4 * k4 + 1]) + (r4.z * S[4 * k4 + 2] + r4.w * S[4 * k4 + 3]);
        }
        yraw[(size_t)row * 256 + ch] = y;
        LDS_WAIT();
    }
    {
        float* sp = a.out + (mixer ? O_SCW : O_SBS) + (((size_t)l * 128 + b) * 4 + h) * 4096 + lane;
#pragma unroll
        for (int k = 0; k < 64; ++k) sp[k * 64] = S[k];
    }
}

__device__ __forceinline__ void phase_scan(const Args& a, int l, unsigned char* lds, int mode = 0) {
    const int tid = otid(), lane = tid & 63, wave = __builtin_amdgcn_readfirstlane(tid >> 6);
    const int G = gridDim.x, g = blockIdx.x;
    float* OB = (float*)lds;
    float* YB = OB + 2 * OPB_FLOATS + 512;
    float* CST = YB + 2 * 8192;
    const bool prod = wave >= 4; const int ptid = tid - 256;
    ChunkD cp = get_chunk(0, g, G, mode), c0 = cp, c1 = get_chunk(1, g, G, mode), c2 = get_chunk(2, g, G, mode);
    Raw RA, RB;
    f2 S01 = {0.f, 0.f}, S23 = {0.f, 0.f}; float Sn[4] = {0.f, 0.f, 0.f, 0.f};
    if (prod) { raw_load(a, l, c0, ptid, RA); prep_math(a, l, c0, RA, OB, CST, ptid); raw_load(a, l, c1, ptid, RA); }
    else if (c0.valid && c0.first && c0.sample) { const float* sp = state_in_ptr(a, l, c0, lane & 15, wave * 4 + (lane >> 4)); Sn[0] = sp[0]; Sn[1] = sp[64]; Sn[2] = sp[128]; Sn[3] = sp[192]; }
    __syncthreads();
    int idx = 0;
    while (c0.valid) {
        if (!prod) consume_chunk(a, l, c0, c1, OB + (idx & 1) * OPB_FLOATS, YB + (idx & 1) * 8192, S01, S23, Sn, wave, lane);
        else { raw_load(a, l, c2, ptid, RB); prep_math(a, l, c1, RA, OB + ((idx + 1) & 1) * OPB_FLOATS, CST, ptid); if (idx > 0) flush_y(a, cp, YB + ((idx - 1) & 1) * 8192, ptid); }
        __syncthreads();
        cp = c0; c0 = c1; c1 = c2; c2 = get_chunk(idx + 3, g, G, mode); ++idx;
        if (!c0.valid) break;
        if (!prod) consume_chunk(a, l, c0, c1, OB + (idx & 1) * OPB_FLOATS, YB + (idx & 1) * 8192, S01, S23, Sn, wave, lane);
        else { raw_load(a, l, c2, ptid, RA); prep_math(a, l, c1, RB, OB + ((idx + 1) & 1) * OPB_FLOATS, CST, ptid); flush_y(a, cp, YB + ((idx - 1) & 1) * 8192, ptid); }
        __syncthreads();
        cp = c0; c0 = c1; c1 = c2; c2 = get_chunk(idx + 3, g, G, mode); ++idx;
    }
    if (prod && idx > 0) flush_y(a, cp, YB + ((idx - 1) & 1) * 8192, ptid);
    __syncthreads();
    if (mode != 1) {
        float* wl = (float*)lds + wave * 320;
        if (G == 256) { const int v = (g & 7) * 32 + (g >> 3); if ((v >> 2) & 1) { const int rank = ((v >> 3) << 2) | (v & 3); for (int it = rank * 8 + wave; it < 1024; it += 128 * 8) sample_item(a, l, it, wl, lane); } }
        else for (int it = g * 8 + wave; it < 1024; it += G * 8) sample_item(a, l, it, wl, lane);
        __syncthreads();
    }
}

__device__ __forceinline__ void phase_post(const Args& a, int l) {
    const int tid = otid(), lane = tid & 63, wave = tid >> 6;
    const int gw = blockIdx.x * 8 + wave, NGW = gridDim.x * 8;
    const bf16* P = (const bf16*)(a.ws + WS_P);
    bf16* mixed = (bf16*)(a.ws + WS_MIXED);
    const float* yraw = (const float*)(a.ws + WS_XB);
    const int h = lane >> 4, col = lane * 4;
    for (int r = gw; r < TT; r += NGW) {
        const bf16* Prow = P + (size_t)r * PN;
        {
            const float4 o = *(const float4*)(yraw + (size_t)r * 256 + col);
            const float ss = sum16((o.x * o.x + o.y * o.y) + (o.z * o.z + o.w * o.w));
            const float rstd = rsqrtf(ss * (1.f / 64.f) + NORM_EPS);
            float gt[4]; ld4(Prow + PC_BG + col, gt);
            const float* on = a.in[I_BON] + l * 64 + (col & 63);
            uint2 w; w.x = pk2(o.x * rstd * on[0] * silu(gt[0]), o.y * rstd * on[1] * silu(gt[1])); w.y = pk2(o.z * rstd * on[2] * silu(gt[2]), o.w * rstd * on[3] * silu(gt[3]));
            *(uint2*)(mixed + (size_t)r * 1024 + 256 + col) = w;
        }
        {
            const float4 y = *(const float4*)(yraw + (size_t)TT * 256 + (size_t)r * 256 + col);
            const float mean = sum16((y.x + y.y) + (y.z + y.w)) * (1.f / 64.f);
            const float d0 = y.x - mean, d1 = y.y - mean, d2 = y.z - mean, d3 = y.w - mean;
            const float var = sum16((d0 * d0 + d1 * d1) + (d2 * d2 + d3 * d3)) * (1.f / 64.f);
            const float rstd = rsqrtf(var + 64e-5f);
            float vc[4], vp[4], gg[4]; ld4(Prow + PC_C + 512 + col, vc); prev_c<4>(a, l, r, 512 + col, vp);
            ld4((const bf16*)(a.ws + WS_AUXG) + (size_t)r * 256 + col, gg);
            const float* mu = a.in[I_CMU] + l * 1024 + 512 + col;
            const float* lg = a.in[I_CLG] + l * 256 + col; const float* lb = a.in[I_CLB] + l * 256 + col;
            const float rk = ((const float*)(a.ws + WS_RK))[(size_t)r * 4 + h];
            const float dd[4] = {d0, d1, d2, d3}; float o[4];
#pragma unroll
            for (int i = 0; i < 4; ++i) { const float v = vc[i] + (vp[i] - vc[i]) * mu[i]; o[i] = (dd[i] * rstd * lg[i] + lb[i] + rk * v) * gg[i]; }
            uint2 w; w.x = pk2(o[0], o[1]); w.y = pk2(o[2], o[3]);
            *(uint2*)(mixed + (size_t)r * 1024 + 512 + col) = w;
        }
    }
}

__device__ __forceinline__ void phase_final(const Args& a) {
    const int tid = otid(), lane = tid & 63, wave = tid >> 6;
    const int gw = blockIdx.x * 8 + wave, NGW = gridDim.x * 8;
    const float* rss = (const float*)(a.ws + WS_ROWSS) + 4 * TT;
    for (int r = gw; r < TT; r += NGW) {
        const float rs = rsqrtf(rss[r] * (1.f / 1024.f) + NORM_EPS);
        float4* xo = (float4*)(a.out + (size_t)r * 1024);
#pragma unroll
        for (int j = 0; j < 4; ++j) { float4 v = xo[lane + 64 * j]; const float4 g = ((const float4*)a.in[I_FG])[lane + 64 * j]; v.x *= rs * g.x; v.y *= rs * g.y; v.z *= rs * g.z; v.w *= rs * g.w; xo[lane + 64 * j] = v; }
    }
}

#ifndef MK_PER_PHASE
#define MK_PER_PHASE 0
#endif
#ifndef USE_SKINNY
#define USE_SKINNY 0
#endif
constexpr int GM = USE_SKINNY ? T_P : TT;
#ifndef SCAN_PROBE_MODE
#define SCAN_PROBE_MODE 0
#endif
#ifndef PRE_PROBE_MODE
#define PRE_PROBE_MODE 0
#endif
#ifndef REP_P0
#define REP_P0 1
#endif
#ifndef REP_GIN
#define REP_GIN 1
#endif
#ifndef REP_PRE
#define REP_PRE 1
#endif
#ifndef REP_SCAN
#define REP_SCAN 1
#endif
#ifndef REP_POST
#define REP_POST 1
#endif
#ifndef REP_GUP
#define REP_GUP 1
#endif
__global__ void __launch_bounds__(512, 2) mk_fwd(Args a) {
    extern __shared__ __attribute__((aligned(16))) unsigned char lds[];
    cg::grid_group grid = cg::this_grid();
    const int lo = a.ph_lo, hi = a.ph_hi, G = gridDim.x;
    volatile LAS unsigned* bst = (volatile LAS unsigned*)((LAS unsigned char*)lds + (LDS_BYTES - 16));
    if (threadIdx.x < 4) bst[threadIdx.x] = 0u;
    __syncthreads();
    XcdBarrier xbar; xbar.bar = (unsigned*)(a.ws + WS_BAR); xbar.x = 0; xbar.st = nullptr;
    if (!MK_PER_PHASE) xbar = xcd_barrier_post((unsigned*)(a.ws + WS_BAR), bst);
#define IN(k) (lo <= (k) && (k) < hi)
#define SEAM(k) do { if (lo <= (k) && (k) + 1 < hi) { if ((k) == 0) grid.sync(); else xcd_barrier(xbar); } } while (0)
#define REPEAT(n) for (int rep_ = 0; rep_ < (n); ++rep_, (rep_ < (n) ? xcd_barrier(xbar) : (void)0))
    float* rowss = (float*)(a.ws + WS_ROWSS);
    bf16* xb = (bf16*)(a.ws + WS_XB); bf16* P = (bf16*)(a.ws + WS_P); bf16* mixed = (bf16*)(a.ws + WS_MIXED); bf16* hid = (bf16*)(a.ws + WS_HID);
    if (IN(0)) REPEAT(REP_P0) phase0(a, lds);
    SEAM(0);
    for (int l = 0; l < 2; ++l) {
        const int pb = 1 + 7 * l;
        const bf16* wb = (const bf16*)(a.ws + WS_W) + (size_t)l * WL_ELEMS;
        if (IN(pb + 0)) REPEAT(REP_GIN) {
            pg8::Gemm g{xb, wb + WOFF_IN, GM, NIN, 1024}; pg8::StaticOrder S; S.init(GM, NIN, G, (int)blockIdx.x);
            EpiScale<false> E{P, PN, rowss + (2 * l) * TT};
            pg8::gemm_phase<EpiScale<false>, pg8::StaticOrder, true, true>((PG8_LAS unsigned char*)lds, g, S, E);
#if USE_SKINNY
            SkScale<false> E2{P, PN, rowss + (2 * l) * TT};
            skinny_gemm(xb + (size_t)T_P * 1024, wb + WOFF_IN, PN, 1024, E2);
#endif
        }
        SEAM(pb + 0);
        if (IN(pb + 1)) REPEAT(REP_PRE) phase_pre(a, l, lds, rep_ == 0 ? 0 : PRE_PROBE_MODE);
        SEAM(pb + 1);
        if (IN(pb + 2)) REPEAT(REP_SCAN) phase_scan(a, l, lds, rep_ == 0 ? 0 : SCAN_PROBE_MODE);
        SEAM(pb + 2);
        if (IN(pb + 3)) REPEAT(REP_POST) phase_post(a, l);
        SEAM(pb + 3);
        if (IN(pb + 4)) {
            pg8::Gemm g{mixed, wb + WOFF_OUT, GM, 1024, 1024};
            if (G == 256 && !USE_SKINNY && !MK_PER_PHASE) {
                DownOrder S; S.c = (int)blockIdx.x; S.snt = 2;
                EpiResSplit E{a.out, xb, rowss + (2 * l + 1) * TT, (float*)(a.ws + WS_AUXW), l == 0 ? a.in[I_XP] : nullptr, l == 0 ? a.in[I_XS] : nullptr};
                pg8::gemm_phase<EpiResSplit, DownOrder, true, true>((PG8_LAS unsigned char*)lds, g, S, E);
                xcd_barrier(xbar);
                sample_fix(a, rowss + (2 * l + 1) * TT, (const float*)(a.ws + WS_AUXW), l == 0 ? a.in[I_XS] : nullptr);
            } else {
                pg8::StaticOrder S; S.init(GM, 1024, G, (int)blockIdx.x);
                EpiRes E{a.out, xb, rowss + (2 * l + 1) * TT, l == 0 ? a.in[I_XP] : nullptr, l == 0 ? a.in[I_XS] : nullptr};
                pg8::gemm_phase<EpiRes, pg8::StaticOrder, true, true>((PG8_LAS unsigned char*)lds, g, S, E);
#if USE_SKINNY
                SkRes E2{a.out, xb, rowss + (2 * l + 1) * TT};
                skinny_gemm(mixed + (size_t)T_P * 1024, wb + WOFF_OUT, 1024, 1024, E2);
#endif
            }
        }
        SEAM(pb + 4);
        if (IN(pb + 5)) REPEAT(REP_GUP) {
            pg8::Gemm g{xb, wb + WOFF_UP, GM, FF, 1024}; pg8::StaticOrder S; S.init(GM, FF, G, (int)blockIdx.x);
            EpiScale<true> E{hid, FF, rowss + (2 * l + 1) * TT};
            pg8::gemm_phase<EpiScale<true>, pg8::StaticOrder, true, true>((PG8_LAS unsigned char*)lds, g, S, E);
            if (l == 0 && !MK_PER_PHASE && G == 256 && blockIdx.x >= 32) {
                const int tid_ = otid();
                convert_layer(a, 1, (float*)(lds + (tid_ >> 6) * 16384), ((int)blockIdx.x - 32) * 8 + (tid_ >> 6), (G - 32) * 8, tid_ & 63);
            }
#if USE_SKINNY
            SkScale<true> E2{hid, FF, rowss + (2 * l + 1) * TT};
            skinny_gemm(xb + (size_t)T_P * 1024, wb + WOFF_UP, FF, 1024, E2);
#endif
        }
        SEAM(pb + 5);
        if (IN(pb + 6)) {
            pg8::Gemm g{hid, wb + WOFF_DOWN, GM, 1024, FF};
            if (G == 256 && !USE_SKINNY && !MK_PER_PHASE) {
                DownOrder S; S.c = (int)blockIdx.x; S.snt = 8;
                EpiResSplit E{a.out, xb, rowss + (2 * l + 2) * TT, (float*)(a.ws + WS_AUXW), nullptr, nullptr};
                pg8::gemm_phase<EpiResSplit, DownOrder, true, true>((PG8_LAS unsigned char*)lds, g, S, E);
                xcd_barrier(xbar);
                sample_fix(a, rowss + (2 * l + 2) * TT, (const float*)(a.ws + WS_AUXW));
            } else {
                pg8::StaticOrder S; S.init(GM, 1024, G, (int)blockIdx.x);
                EpiRes E{a.out, xb, rowss + (2 * l + 2) * TT, nullptr, nullptr};
                pg8::gemm_phase<EpiRes, pg8::StaticOrder, true, true>((PG8_LAS unsigned char*)lds, g, S, E);
#if USE_SKINNY
                SkRes E2{a.out, xb, rowss + (2 * l + 2) * TT};
                skinny_gemm(hid + (size_t)T_P * FF, wb + WOFF_DOWN, 1024, FF, E2);
#endif
            }
        }
        SEAM(pb + 6);
    }
    if (IN(15)) phase_final(a);
#undef IN
#undef SEAM
}

extern "C" void kernel_launch(void* const* d_in, const int* in_sizes, int n_in, void* d_out, int out_size, void* d_ws, size_t ws_size, hipStream_t stream) {
    static int grid = 0;
    if (grid == 0) {
        int dev = 0, cus = 0, per_cu = 0;
        (void)hipGetDevice(&dev);
        (void)hipDeviceGetAttribute(&cus, hipDeviceAttributeMultiprocessorCount, dev);
        if (hipFuncSetAttribute((const void*)mk_fwd, hipFuncAttributeMaxDynamicSharedMemorySize, LDS_BYTES) != hipSuccess) { fprintf(stderr, "kernel_launch: hipFuncSetAttribute failed\n"); }
        if (hipOccupancyMaxActiveBlocksPerMultiprocessor(&per_cu, (const void*)mk_fwd, 512, LDS_BYTES) != hipSuccess || per_cu < 1) { fprintf(stderr, "kernel_launch: occupancy query reports %d\n", per_cu); per_cu = 1; }
        (void)hipGetLastError();
        if (per_cu > 1) per_cu = 1;
        if (cus <= 0) cus = 256;
        grid = cus * per_cu;
    }
    Args a{};
    for (int i = 0; i < 34; ++i) a.in[i] = (const float*)d_in[i];
    a.out = (float*)d_out; a.ws = (unsigned char*)d_ws;
    (void)hipMemsetAsync((unsigned char*)d_ws + WS_BAR, 0, XCD_BAR_WORDS * 4, stream);
#if MK_PER_PHASE
    for (int ph = 0; ph < NPHASE; ++ph) { a.ph_lo = ph; a.ph_hi = ph + 1; hipLaunchKernelGGL(mk_fwd, dim3(grid), dim3(512), LDS_BYTES, stream, a); }
#else
    a.ph_lo = 0; a.ph_hi = NPHASE;
    void* args[] = {&a};
    const hipError_t e = hipLaunchCooperativeKernel((const void*)mk_fwd, dim3(grid), dim3(512), args, LDS_BYTES, stream);
    if (e != hipSuccess) fprintf(stderr, "cooperative launch failed: %s (grid %d)\n", hipGetErrorString(e), grid);
#endif
}
```

```cpp
#include <hip/hip_runtime.h>
#include <hip/hip_cooperative_groups.h>
#include <cstdio>
#include <cstdint>
namespace cg = cooperative_groups;
#define MK_PER_PHASE 0
namespace pg8 {
#define PG8_LAS __attribute__((address_space(3)))
typedef unsigned short bf16_t;
typedef short bf16x8 __attribute__((ext_vector_type(8)));
typedef float f32x4 __attribute__((ext_vector_type(4)));
typedef unsigned u32x4 __attribute__((ext_vector_type(4)));
constexpr int BM = 256, BK = 64, HALF = 128, HTB = HALF * BK * 2  , STAGE_BYTES = 8 * HTB, NXCD = 8, WGM = 8;

__host__ __device__ __forceinline__ int lds_byte(int r, int c) { const int st = (r >> 4) * 2 + (c >> 5), rr = r & 15, cc = c & 31, ob = rr * 64 + cc * 2; return st * 1024 + (ob ^ (((ob >> 9) & 1) << 5)); }
__host__ __device__ __forceinline__ void stage_rc(int b, int& R, int& C) { const int st = b / 1024, sb = b % 1024, swz = sb ^ (((sb >> 9) & 1) << 5); R = (st >> 1) * 16 + swz / 64; C = (st & 1) * 32 + (swz % 64) / 2; }
__host__ __device__ __forceinline__ int perm32(int rho) { const int n = rho >> 4, i = rho & 15; return 8 * (i >> 2) + 4 * n + (i & 3); }

struct Unit { int pm, pn, kofs, nt, part; };
struct Gemm { const bf16_t* A; const bf16_t* Bt; int M, N, K; };

struct StaticOrder {
    int nM, nN, nwg, G, c;
    __host__ __device__ void init(int M, int N, int G_, int c_) { nM = M / BM; nN = N / BM; nwg = nM * nN; G = G_; c = c_; }
    __host__ __device__ bool next(int i, Unit& u) const {
        const long L = (long)i * G + c; if (L >= nwg) return false;
        int wgid = (int)L; { const int q = nwg / NXCD, r = nwg % NXCD, xcd = wgid % NXCD, off = wgid / NXCD; wgid = (xcd < r ? xcd * (q + 1) : r * (q + 1) + (xcd - r) * q) + off; }
        const int nig = WGM * nN, gid = wgid / nig, fm = gid * WGM, gsz = (nM - fm) < WGM ? (nM - fm) : WGM;
        u.pm = fm + ((wgid % nig) % gsz); u.pn = (wgid % nig) / gsz; u.kofs = 0; u.nt = 0; u.part = -1; return true;
    }
    __device__ __forceinline__ void a_ready(const Unit&) const {}
    __device__ __forceinline__ void done(const Unit&) const {}
};

__device__ __forceinline__ unsigned cvt_pk_bf16(float lo, float hi) { unsigned r; asm volatile("v_cvt_pk_bf16_f32 %0, %1, %2" : "=v"(r) : "v"(lo), "v"(hi)); return r; }
typedef float f32x2 __attribute__((ext_vector_type(2)));
template <class Epi, class Sched, bool ALIGN_EPI = false, bool SP2 = false>
__device__ __forceinline__ void gemm_phase(PG8_LAS unsigned char* lds, const Gemm g, const Sched& S, const Epi& E) {
    int tid_ = threadIdx.x; asm volatile("" : "+v"(tid_)); const int tid = tid_, wid = __builtin_amdgcn_readfirstlane(tid >> 6), lane = tid & 63, wr = wid >> 2, wc = wid & 3, fr = lane & 15, fq = lane >> 4;
    const int K = g.K, nt = K / BK;
    unsigned voffA[2], voffB[2];
#pragma unroll
    for (int i = 0; i < 2; ++i) { int R, C; stage_rc(tid * 16 + i * 8192, R, C); const int Rb = Epi::PERM ? ((R & ~31) + perm32(R & 31)) : R;
        voffA[i] = (unsigned)(R * K + C) * 2u; voffB[i] = (unsigned)(Rb * K + C) * 2u; }
    const size_t kstep = (size_t)(BK * 2);
    const size_t hstep = (size_t)HALF * K * 2;
    const size_t tstep = 2 * hstep;
    const unsigned ldsw = (unsigned)wid * 1024u;
    const int aoff = lds_byte(wr * 64 + fr, fq * 8), boff = lds_byte(wc * 32 + fr, fq * 8);
#define PG8_SA(b, h) (((b) * 2 + (h)) * HTB)
#define PG8_SB(b, h) ((4 + (b) * 2 + (h)) * HTB)
#define PG8_STAGE(bufoff, gbase, voff) do { _Pragma("unroll") for (int _i = 0; _i < 2; ++_i) \
        __builtin_amdgcn_global_load_lds((const unsigned*)((const char*)(gbase) + (voff)[_i]), (PG8_LAS unsigned*)(lds + (bufoff) + ldsw + _i * 8192), 16, 0, 0); } while (0)
#define PG8_LDA(dst, b, h) do { _Pragma("unroll") for (int m = 0; m < 4; ++m) _Pragma("unroll") for (int k = 0; k < 2; ++k) dst[m][k] = *(const PG8_LAS bf16x8*)(lds + PG8_SA(b, h) + aoff + m * 2048 + k * 1024); } while (0)
#define PG8_LDB(dst, b, h) do { _Pragma("unroll") for (int n = 0; n < 2; ++n) _Pragma("unroll") for (int k = 0; k < 2; ++k) dst[n][k] = *(const PG8_LAS bf16x8*)(lds + PG8_SB(b, h) + boff + n * 2048 + k * 1024); } while (0)
#define PG8_MMA(ai, bj, At, Bt) do { __builtin_amdgcn_s_setprio(1); _Pragma("unroll") for (int m = 0; m < 4; ++m) _Pragma("unroll") for (int n = 0; n < 2; ++n) _Pragma("unroll") for (int k = 0; k < 2; ++k) \
        acc[ai][bj][m][n] = __builtin_amdgcn_mfma_f32_16x16x32_bf16(Bt[n][k], At[m][k], acc[ai][bj][m][n], 0, 0, 0); __builtin_amdgcn_s_setprio(0); } while (0)
#define PG8_WAIT_V(n) asm volatile("s_waitcnt vmcnt(" #n ")" ::: "memory")
#define PG8_WAIT_L(n) asm volatile("s_waitcnt lgkmcnt(" #n ")" ::: "memory")
#define PG8_BAR __builtin_amdgcn_s_barrier()
#define PG8_SCHED __builtin_amdgcn_sched_barrier(0)
    Unit cur, nxt; int ui = 0;
    if (!S.next(0, cur)) return;
    f32x4 acc[2][2][4][2];
#pragma unroll
    for (int a = 0; a < 2; ++a)
#pragma unroll
        for (int b = 0; b < 2; ++b)
#pragma unroll
            for (int m = 0; m < 4; ++m)
#pragma unroll
                for (int n = 0; n < 2; ++n) acc[a][b][m][n] = (f32x4){0.f, 0.f, 0.f, 0.f};
    bf16x8 At[4][2], B0[2][2], B1[2][2];
    const char* cA = (const char*)g.A + (size_t)cur.pm * tstep + cur.kofs; const char* cB = (const char*)g.Bt + (size_t)cur.pn * tstep + cur.kofs;
    S.a_ready(cur);
    if constexpr (SP2) {
        PG8_STAGE(PG8_SB(0, 0), cB, voffB); PG8_STAGE(PG8_SB(0, 1), cB + hstep, voffB); PG8_STAGE(PG8_SA(0, 0), cA, voffA); PG8_STAGE(PG8_SA(0, 1), cA + hstep, voffA);
        if (wr == 1) PG8_BAR;
        PG8_WAIT_V(2); PG8_BAR;
        PG8_STAGE(PG8_SB(1, 0), cB + kstep, voffB); PG8_STAGE(PG8_SA(1, 0), cA + kstep, voffA); PG8_STAGE(PG8_SB(1, 1), cB + hstep + kstep, voffB);
        PG8_WAIT_V(6); PG8_BAR;
    } else {
        PG8_STAGE(PG8_SB(0, 0), cB, voffB); PG8_STAGE(PG8_SA(0, 0), cA, voffA); PG8_STAGE(PG8_SB(0, 1), cB + hstep, voffB); PG8_STAGE(PG8_SA(0, 1), cA + hstep, voffA);
        if (wr == 1) PG8_BAR;
        PG8_WAIT_V(4); PG8_BAR;
        PG8_STAGE(PG8_SB(1, 0), cB + kstep, voffB); PG8_STAGE(PG8_SA(1, 0), cA + kstep, voffA); PG8_STAGE(PG8_SB(1, 1), cB + hstep + kstep, voffB);
        PG8_WAIT_V(6); PG8_BAR;
    }
    for (;;) {
        const bool has_next = S.next(ui + 1, nxt);
        const char* nA = has_next ? (const char*)g.A + (size_t)nxt.pm * tstep + nxt.kofs : cA; const char* nB = has_next ? (const char*)g.Bt + (size_t)nxt.pn * tstep + nxt.kofs : cB;
        const int cnt = cur.nt ? cur.nt : nt;
        for (int t = 0; t < cnt; t += 2) {
            const bool last = (t == cnt - 2);
            const char* a1 = cA + (size_t)(t + 1) * kstep;
            const char* a2 = last ? nA : cA + (size_t)(t + 2) * kstep; const char* b2 = last ? nB : cB + (size_t)(t + 2) * kstep;
            const char* a3 = a2 + kstep; const char* b3 = b2 + kstep;
            if (last && has_next) S.a_ready(nxt);
            if constexpr (SP2) {
            PG8_LDB(B0, 0, 0); PG8_LDB(B1, 0, 1); PG8_SCHED; PG8_LDA(At, 0, 0); PG8_STAGE(PG8_SA(1, 1), a1 + hstep, voffA);
            PG8_WAIT_V(8); PG8_WAIT_L(0); PG8_BAR; PG8_MMA(0, 0, At, B0); PG8_MMA(0, 1, At, B1); PG8_BAR; PG8_SCHED;
            PG8_LDA(At, 0, 1); PG8_STAGE(PG8_SB(0, 0), b2, voffB); PG8_STAGE(PG8_SB(0, 1), b2 + hstep, voffB); PG8_STAGE(PG8_SA(0, 0), a2, voffA);
            PG8_WAIT_V(8); PG8_WAIT_L(0); PG8_BAR; PG8_MMA(1, 0, At, B0); PG8_MMA(1, 1, At, B1); PG8_BAR; PG8_SCHED;
            PG8_LDB(B0, 1, 0); PG8_LDB(B1, 1, 1); PG8_SCHED; PG8_LDA(At, 1, 0); PG8_STAGE(PG8_SA(0, 1), a2 + hstep, voffA);
            PG8_WAIT_V(8); PG8_WAIT_L(0); PG8_BAR; PG8_MMA(0, 0, At, B0); PG8_MMA(0, 1, At, B1); PG8_BAR; PG8_SCHED;
            PG8_LDA(At, 1, 1); PG8_STAGE(PG8_SB(1, 0), b3, voffB); PG8_STAGE(PG8_SB(1, 1), b3 + hstep, voffB); PG8_STAGE(PG8_SA(1, 0), a3, voffA);
            PG8_WAIT_V(8); PG8_WAIT_L(0); PG8_BAR; PG8_MMA(1, 0, At, B0); PG8_MMA(1, 1, At, B1); PG8_BAR; PG8_SCHED;
            } else {
            PG8_LDB(B0, 0, 0); PG8_SCHED; PG8_LDA(At, 0, 0); PG8_STAGE(PG8_SA(1, 1), a1 + hstep, voffA);
            PG8_WAIT_L(8); PG8_BAR; PG8_WAIT_L(0); PG8_MMA(0, 0, At, B0); PG8_BAR; PG8_SCHED;
            PG8_LDB(B1, 0, 1); PG8_STAGE(PG8_SB(0, 0), b2, voffB);
            PG8_BAR; PG8_WAIT_L(0); PG8_MMA(0, 1, At, B1); PG8_BAR;
            PG8_LDA(At, 0, 1); PG8_STAGE(PG8_SA(0, 0), a2, voffA);
            PG8_BAR; PG8_WAIT_L(0); PG8_MMA(1, 0, At, B0); PG8_BAR; PG8_SCHED;
            PG8_STAGE(PG8_SB(0, 1), b2 + hstep, voffB);
            PG8_WAIT_V(6); PG8_BAR; PG8_MMA(1, 1, At, B1); PG8_BAR;
            PG8_LDB(B0, 1, 0); PG8_SCHED; PG8_LDA(At, 1, 0); PG8_STAGE(PG8_SA(0, 1), a2 + hstep, voffA);
            PG8_WAIT_L(8); PG8_BAR; PG8_WAIT_L(0); PG8_MMA(0, 0, At, B0); PG8_BAR; PG8_SCHED;
            PG8_LDB(B1, 1, 1); PG8_STAGE(PG8_SB(1, 0), b3, voffB);
            PG8_BAR; PG8_WAIT_L(0); PG8_MMA(0, 1, At, B1); PG8_BAR;
            PG8_LDA(At, 1, 1); PG8_STAGE(PG8_SA(1, 0), a3, voffA);
            PG8_BAR; PG8_WAIT_L(0); PG8_MMA(1, 0, At, B0); PG8_BAR; PG8_SCHED;
            PG8_STAGE(PG8_SB(1, 1), b3 + hstep, voffB);
            PG8_WAIT_V(6); PG8_BAR; PG8_MMA(1, 1, At, B1); PG8_BAR;
            }
        }
        if constexpr (ALIGN_EPI) { if (wr == 0) PG8_BAR; }
        if constexpr (!Epi::AFTER_DRAIN) { E(acc, cur, wr, wc, fr, fq); S.done(cur); }
        if (!has_next) break;
#pragma unroll
        for (int a = 0; a < 2; ++a)
#pragma unroll
            for (int b = 0; b < 2; ++b)
#pragma unroll
                for (int m = 0; m < 4; ++m)
#pragma unroll
                    for (int n = 0; n < 2; ++n) acc[a][b][m][n] = (f32x4){0.f, 0.f, 0.f, 0.f};
        cur = nxt; cA = nA; cB = nB; ++ui;
        if constexpr (ALIGN_EPI) { if (wr == 1) PG8_BAR; }
    }
    PG8_WAIT_V(0);
    if constexpr (!ALIGN_EPI) { if (wr == 0) PG8_BAR; }
    PG8_BAR;
    if constexpr (Epi::AFTER_DRAIN) { E.fused(acc, cur, wr, wc, fr, fq, lds, wid, lane); S.done(cur); }
#undef PG8_SA
#undef PG8_SB
#undef PG8_STAGE
#undef PG8_LDA
#undef PG8_LDB
#undef PG8_MMA
#undef PG8_WAIT_V
#undef PG8_WAIT_L
#undef PG8_BAR
#undef PG8_SCHED
}
}

#define LAS __attribute__((address_space(3)))

#define XB_TMO      128
#define XB_XCNT(j)  (256  + 64 * (j))
#define XB_XSUB(j)  (1280 + 64 * (j))
#define XB_XGEN(j)  (2304 + 64 * (j))
#define XB_TOP      3328
#define XB_TOPGEN   3392
#define XCD_BAR_WORDS 3456
#define XB_SPIN_CAP (1u << 18)

__device__ __forceinline__ unsigned xb_ld(unsigned* p)              { return __hip_atomic_load(p, __ATOMIC_RELAXED, __HIP_MEMORY_SCOPE_AGENT); }
__device__ __forceinline__ unsigned xb_add(unsigned* p, unsigned v) { return __hip_atomic_fetch_add(p, v, __ATOMIC_RELAXED, __HIP_MEMORY_SCOPE_AGENT); }
__device__ __forceinline__ unsigned xb_xcc_id() { return (unsigned)__builtin_amdgcn_s_getreg((3 << 11) | 20) & 0xFu; }
#define XB_SPIN(cond, bar) do { unsigned _sp = 0; while (cond) { __builtin_amdgcn_s_sleep(1); \
    if ((++_sp & 255u) == 0u) { if (xb_ld(&(bar)[XB_TMO])) break; if (_sp > XB_SPIN_CAP) { atomicAdd(&(bar)[XB_TMO], 1u); break; } } } } while (0)

struct XcdBarrier {
    unsigned* bar; unsigned x;
    volatile LAS unsigned* st;
};

__device__ __forceinline__ XcdBarrier xcd_barrier_post(unsigned* bar, volatile LAS unsigned* st) {
    XcdBarrier b; b.bar = bar; b.x = xb_xcc_id(); b.st = st;
    if (threadIdx.x == 0) (void)xb_add(&bar[XB_XCNT(b.x)], 1u);
    return b;
}
__device__ __forceinline__ void xcd_barrier_complete(unsigned* bar, unsigned x, unsigned& nloc, unsigned& nx) {
    const unsigned G = gridDim.x * gridDim.y * gridDim.z;
    unsigned sum, cnt, mine, sp = 0u;
    for (;;) {
        sum = 0u; cnt = 0u; mine = 0u;
#pragma unroll
        for (unsigned j = 0; j < 16; ++j) { const unsigned c = xb_ld(&bar[XB_XCNT(j)]); sum += c; cnt += (c > 0u) ? 1u : 0u; mine = (j == x) ? c : mine; }
        if (sum == G) break;
        __builtin_amdgcn_s_sleep(1);
        if ((++sp & 255u) == 0u) { if (xb_ld(&bar[XB_TMO])) break; if (sp > XB_SPIN_CAP) { atomicAdd(&bar[XB_TMO], 1u); break; } }
    }
    nloc = mine > 0u ? mine : 1u; nx = cnt > 0u ? cnt : 1u;
}

__device__ __forceinline__ void xcd_barrier(const XcdBarrier& b) {
    asm volatile("s_waitcnt vmcnt(0)" ::: "memory");
    __syncthreads();
    if (threadIdx.x == 0) {
        unsigned* bar = b.bar;
        __builtin_amdgcn_s_waitcnt(0);
        unsigned nloc = b.st[0], nx = b.st[1];
        if (nloc == 0u) { xcd_barrier_complete(bar, b.x, nloc, nx); b.st[0] = nloc; b.st[1] = nx; }
        const unsigned old = xb_add(&bar[XB_XSUB(b.x)], 1u);
        const unsigned gen = old / nloc;
        if (old + 1u == (gen + 1u) * nloc) {
            __builtin_amdgcn_fence(__ATOMIC_RELEASE, "agent");
            asm volatile("s_waitcnt vmcnt(0)" ::: "memory");
            const unsigned og = xb_add(&bar[XB_TOP], 1u);
            const unsigned tg = og / nx;
            if (og + 1u == (tg + 1u) * nx) xb_add(&bar[XB_TOPGEN], 1u);
            else XB_SPIN(xb_ld(&bar[XB_TOPGEN]) == tg, bar);
            __builtin_amdgcn_fence(__ATOMIC_ACQUIRE, "agent");
            xb_add(&bar[XB_XGEN(b.x)], 1u);
            asm volatile("s_waitcnt vmcnt(0)" ::: "memory");
        } else {
            XB_SPIN(xb_ld(&bar[XB_XGEN(b.x)]) == gen, bar);
            __builtin_amdgcn_fence(__ATOMIC_ACQUIRE, "agent");
            asm volatile("s_waitcnt vmcnt(0)" ::: "memory");
        }
    }
    __syncthreads();
}

typedef unsigned short bf16;
typedef pg8::f32x4 f32x4;
typedef pg8::u32x4 u32x4;
constexpr int DM = 1024, T_P = 16384, T_S = 512, TT = 16896, PN = 3072, NIN = 2816, FF = 4096;
constexpr float NORM_EPS = 1e-6f;
constexpr int PC_A = 0, PC_BQ = 512, PC_BK = 768, PC_BV = 1024, PC_BG = 1280, PC_C = 1536, PC_D = 2560, PC_BA = 2816;
constexpr size_t MiB = 1u << 20;
constexpr size_t WS_ROWSS = 0;
constexpr size_t WS_RK = 512 * 1024;
constexpr size_t WS_BAR = 800 * 1024;
constexpr size_t WS_PCNT = WS_BAR + 14336;
constexpr size_t BAR_ZERO_BYTES = 14336 + 64 * 256;
constexpr size_t WS_W = 1 * MiB;
constexpr size_t WS_XB = 49 * MiB;
constexpr size_t WS_P = 82 * MiB;
constexpr size_t WS_MIXED = 181 * MiB;
constexpr size_t WS_HID = 82 * MiB;
constexpr size_t WS_AUXW = 214 * MiB;
constexpr size_t WS_AUXA = WS_AUXW + (size_t)TT * 256 * 4;
constexpr size_t WS_AUXG = WS_AUXA + (size_t)TT * 256 * 2;
constexpr size_t WS_LW = WS_AUXG + (size_t)TT * 256 * 2;
constexpr size_t WS_BAW = WS_LW + 2 * 81920 * 2;
constexpr size_t WS_BA = WS_BAW + 2 * 16 * 1024 * 2;
constexpr size_t WS_END = WS_BA + (size_t)TT * 8 * 4;
static_assert(WS_END <= 256 * MiB, "ws map");
constexpr size_t WOFF_IN = 0, WOFF_OUT = 3145728, WOFF_UP = 4194304, WOFF_DOWN = 8388608, WL_ELEMS = 12582912;
constexpr size_t O_YP = 0, O_YS = O_YP + (size_t)T_P * DM, O_PBC = O_YS + (size_t)T_S * DM, O_PBS = O_PBC + 2 * 8 * 3 * 768, O_PCS = O_PBS + 2 * 8 * 4 * 4096,
                 O_PCW = O_PCS + 2 * 8 * 1024, O_PDP = O_PCW + 2 * 8 * 4 * 4096, O_SAV = O_PDP + 2 * 8 * 15 * 256, O_SBC = O_SAV + 2 * 128 * 4 * 256,
                 O_SBS = O_SBC + 2 * 128 * 3 * 768, O_SCS = O_SBS + 2 * 128 * 4 * 4096, O_SCW = O_SCS + 2 * 128 * 1024, O_SDP = O_SCW + 2 * 128 * 4 * 4096,
                 O_END = O_SDP + 2 * 128 * 15 * 256;
static_assert(O_END == 28426240, "d_out map");
constexpr int LDS_BYTES = 163840;
constexpr int NPHASE = 16;

struct Args { const float* in[34]; float* out; unsigned char* ws; int ph_lo, ph_hi; };
enum { I_XP = 0, I_XS, I_SBC, I_SBS, I_SCS, I_SCW, I_SDP, I_N1G, I_WIN, I_AWS, I_ABS, I_AVG, I_BCW, I_BAL, I_BDT, I_BON, I_CMU, I_CW0, I_CW2, I_CA0, I_CA2, I_CG2,
       I_CKK, I_CKA, I_CRK, I_CLG, I_CLB, I_DW, I_DSC, I_WOUT, I_N2G, I_WUP, I_WDN, I_FG };

#define LDS_WAIT() asm volatile("s_waitcnt lgkmcnt(0)" ::: "memory")

__device__ __forceinline__ int otid() { int t = threadIdx.x; asm volatile("" : "+v"(t)); return t; }
__device__ __forceinline__ float bf2f(unsigned h) { return __uint_as_float(h << 16); }
__device__ __forceinline__ unsigned f2bf(float f) { unsigned u = __float_as_uint(f); return (u + 0x7fffu + ((u >> 16) & 1u)) >> 16; }
__device__ __forceinline__ unsigned pk2(float lo, float hi) { return f2bf(lo) | (f2bf(hi) << 16); }
__device__ __forceinline__ void ld8(const bf16* p, float (&o)[8]) {
    const uint4 u = *(const uint4*)p;
    o[0] = __uint_as_float(u.x << 16); o[1] = __uint_as_float(u.x & 0xffff0000u); o[2] = __uint_as_float(u.y << 16); o[3] = __uint_as_float(u.y & 0xffff0000u);
    o[4] = __uint_as_float(u.z << 16); o[5] = __uint_as_float(u.z & 0xffff0000u); o[6] = __uint_as_float(u.w << 16); o[7] = __uint_as_float(u.w & 0xffff0000u);
}
__device__ __forceinline__ void ld4(const bf16* p, float (&o)[4]) {
    const uint2 u = *(const uint2*)p;
    o[0] = __uint_as_float(u.x << 16); o[1] = __uint_as_float(u.x & 0xffff0000u); o[2] = __uint_as_float(u.y << 16); o[3] = __uint_as_float(u.y & 0xffff0000u);
}
__device__ __forceinline__ void ld2(const bf16* p, float (&o)[2]) { const unsigned u = *(const unsigned*)p; o[0] = __uint_as_float(u << 16); o[1] = __uint_as_float(u & 0xffff0000u); }
template <int N> __device__ __forceinline__ void ldbf(const bf16* p, float (&o)[N]);
template <> __device__ __forceinline__ void ldbf<8>(const bf16* p, float (&o)[8]) { ld8(p, o); }
template <> __device__ __forceinline__ void ldbf<4>(const bf16* p, float (&o)[4]) { ld4(p, o); }
template <> __device__ __forceinline__ void ldbf<2>(const bf16* p, float (&o)[2]) { ld2(p, o); }
template <> __device__ __forceinline__ void ldbf<1>(const bf16* p, float (&o)[1]) { o[0] = bf2f(*p); }
template <int N> __device__ __forceinline__ void ldf(const float* p, float (&o)[N]) {
#pragma unroll
    for (int i = 0; i < N; ++i) o[i] = p[i];
}
__device__ __forceinline__ float sigm(float x) { return __builtin_amdgcn_rcpf(1.f + __expf(-x)); }
__device__ __forceinline__ float silu(float x) { return x * sigm(x); }
__device__ __forceinline__ float tanh_(float y) { return 1.f - 2.f * __builtin_amdgcn_rcpf(1.f + __expf(2.f * y)); }
__device__ __forceinline__ float gelu_t(float x) { return 0.5f * x * (1.f + tanh_(0.7978845608028654f * (x + 0.044715f * x * x * x))); }
__device__ __forceinline__ float softplus_(float x) { const float u = __expf(-fabsf(x)); return fmaxf(x, 0.f) + (u < 1e-3f ? u * (1.f - 0.5f * u) : __logf(1.f + u)); }
__device__ __forceinline__ float wave_sum(float v) {
#pragma unroll
    for (int o = 1; o < 64; o <<= 1) v += __shfl_xor(v, o);
    return v;
}
__device__ __forceinline__ float sum8(float v) { v += __shfl_xor(v, 1); v += __shfl_xor(v, 2); v += __shfl_xor(v, 4); return v; }
__device__ __forceinline__ float sum16(float v) { v = sum8(v); v += __shfl_xor(v, 8); return v; }
__device__ __forceinline__ float dpp_sum16(float x) {
    x += __int_as_float(__builtin_amdgcn_update_dpp(0, __float_as_int(x), 0xB1, 0xF, 0xF, false));
    x += __int_as_float(__builtin_amdgcn_update_dpp(0, __float_as_int(x), 0x4E, 0xF, 0xF, false));
    x += __int_as_float(__builtin_amdgcn_update_dpp(0, __float_as_int(x), 0x141, 0xF, 0xF, false));
    x += __int_as_float(__builtin_amdgcn_update_dpp(0, __float_as_int(x), 0x140, 0xF, 0xF, false));
    return x;
}

template <bool RELU2> struct EpiScale {
    static constexpr bool PERM = true, AFTER_DRAIN = false;
    bf16* O; int ldc; const float* rss;
    __device__ __forceinline__ void operator()(const f32x4 (&acc)[2][2][4][2], const pg8::Unit& u, int wr, int wc, int fr, int fq) const {
        const int row0 = u.pm * 256 + wr * 64 + fr, col0 = u.pn * 256 + wc * 32 + 8 * fq;
#pragma unroll
        for (int ai = 0; ai < 2; ++ai)
#pragma unroll
            for (int m = 0; m < 4; ++m) {
                const int r = row0 + ai * 128 + m * 16;
                const float rs = rsqrtf(rss[r] * (1.f / 1024.f) + NORM_EPS);
                bf16* rowp = O + (size_t)r * ldc + col0;
#pragma unroll
                for (int bj = 0; bj < 2; ++bj) {
                    f32x4 v0 = acc[ai][bj][m][0] * rs, v1 = acc[ai][bj][m][1] * rs;
                    if (RELU2) {
#pragma unroll
                        for (int e = 0; e < 4; ++e) { const float p0 = fmaxf(v0[e], 0.f), p1 = fmaxf(v1[e], 0.f); v0[e] = p0 * p0; v1[e] = p1 * p1; }
                    }
                    u32x4 w; w.x = pg8::cvt_pk_bf16(v0[0], v0[1]); w.y = pg8::cvt_pk_bf16(v0[2], v0[3]); w.z = pg8::cvt_pk_bf16(v1[0], v1[1]); w.w = pg8::cvt_pk_bf16(v1[2], v1[3]);
                    *(u32x4*)(rowp + bj * 128) = w;
                }
            }
    }
};
struct EpiRes {
    static constexpr bool PERM = true, AFTER_DRAIN = false;
    float* X; bf16* XB; float* rss;
    __device__ __forceinline__ void operator()(const f32x4 (&acc)[2][2][4][2], const pg8::Unit& u, int wr, int wc, int fr, int fq) const {
        const int row0 = u.pm * 256 + wr * 64 + fr, col0 = u.pn * 256 + wc * 32 + 8 * fq;
#pragma unroll
        for (int ai = 0; ai < 2; ++ai)
#pragma unroll
            for (int m = 0; m < 4; ++m) {
                const int r = row0 + ai * 128 + m * 16;
                float ss = 0.f;
#pragma unroll
                for (int bj = 0; bj < 2; ++bj) {
                    float* xp = X + (size_t)r * 1024 + col0 + bj * 128;
                    const f32x4 x0 = *(const f32x4*)xp + acc[ai][bj][m][0], x1 = *(const f32x4*)(xp + 4) + acc[ai][bj][m][1];
                    *(f32x4*)xp = x0; *(f32x4*)(xp + 4) = x1;
                    u32x4 w; w.x = pg8::cvt_pk_bf16(x0[0], x0[1]); w.y = pg8::cvt_pk_bf16(x0[2], x0[3]); w.z = pg8::cvt_pk_bf16(x1[0], x1[1]); w.w = pg8::cvt_pk_bf16(x1[2], x1[3]);
                    *(u32x4*)(XB + (size_t)r * 1024 + col0 + bj * 128) = w;
                    ss += (x0[0] * x0[0] + x0[1] * x0[1]) + (x0[2] * x0[2] + x0[3] * x0[3]) + (x1[0] * x1[0] + x1[1] * x1[1]) + (x1[2] * x1[2] + x1[3] * x1[3]);
                }
                ss += __shfl_xor(ss, 16); ss += __shfl_xor(ss, 32);
                if (fq == 0) atomicAdd(rss + r, ss);
            }
    }
};

struct EpiResFinal {
    static constexpr bool PERM = true, AFTER_DRAIN = false;
    float* X; float* rss; float* part; const float* fg; unsigned* pcnt;
    __device__ __forceinline__ void operator()(const f32x4 (&acc)[2][2][4][2], const pg8::Unit& u, int wr, int wc, int fr, int fq) const {
        if (u.part >= 0) {
            const int row0 = (u.pm - 64) * 256 + wr * 64 + fr, col0 = u.pn * 256 + wc * 32 + 8 * fq;
            float* pp = part + (size_t)u.part * 512 * 1024;
#pragma unroll
            for (int ai = 0; ai < 2; ++ai)
#pragma unroll
                for (int m = 0; m < 4; ++m)
#pragma unroll
                    for (int bj = 0; bj < 2; ++bj) { float* xp = pp + (size_t)(row0 + ai * 128 + m * 16) * 1024 + col0 + bj * 128; *(f32x4*)xp = acc[ai][bj][m][0]; *(f32x4*)(xp + 4) = acc[ai][bj][m][1]; }
            return;
        }
        const int row0 = u.pm * 256 + wr * 64 + fr, col0 = u.pn * 256 + wc * 32 + 8 * fq;
        float dummy = 0.f;
#pragma unroll
        for (int ai = 0; ai < 2; ++ai)
#pragma unroll
            for (int m = 0; m < 4; ++m) {
                const int r = row0 + ai * 128 + m * 16;
                float ss = 0.f;
#pragma unroll
                for (int bj = 0; bj < 2; ++bj) {
                    const float* sp = X + (size_t)r * 1024 + col0 + bj * 128;
                    const f32x4 x0 = *(const f32x4*)sp + acc[ai][bj][m][0], x1 = *(const f32x4*)(sp + 4) + acc[ai][bj][m][1];
                    ss += (x0[0] * x0[0] + x0[1] * x0[1]) + (x0[2] * x0[2] + x0[3] * x0[3]) + (x1[0] * x1[0] + x1[1] * x1[1]) + (x1[2] * x1[2] + x1[3] * x1[3]);
                }
                ss += __shfl_xor(ss, 16); ss += __shfl_xor(ss, 32);
                if (fq == 0) dummy += atomicAdd(rss + r, ss);
            }
        asm volatile("s_waitcnt vmcnt(0)" :: "v"(dummy) : "memory");
        unsigned* cnt = pcnt + 64 * u.pm;
        if ((threadIdx.x & 63) == 0) __hip_atomic_fetch_add(cnt, 1u, __ATOMIC_RELAXED, __HIP_MEMORY_SCOPE_AGENT);
        { unsigned sp_ = 0; while (__hip_atomic_load(cnt, __ATOMIC_RELAXED, __HIP_MEMORY_SCOPE_AGENT) < 32u) { __builtin_amdgcn_s_sleep(2); if (++sp_ > (1u << 22)) break; } }
        asm volatile("" ::: "memory");
#pragma unroll
        for (int ai = 0; ai < 2; ++ai)
#pragma unroll
            for (int m = 0; m < 4; ++m) {
                const int r = row0 + ai * 128 + m * 16;
                const float rs = rsqrtf(__hip_atomic_load(rss + r, __ATOMIC_RELAXED, __HIP_MEMORY_SCOPE_AGENT) * (1.f / 1024.f) + NORM_EPS);
#pragma unroll
                for (int bj = 0; bj < 2; ++bj) {
                    float* xp = X + (size_t)r * 1024 + col0 + bj * 128;
                    const f32x4 g0 = *(const f32x4*)(fg + col0 + bj * 128), g1 = *(const f32x4*)(fg + col0 + bj * 128 + 4);
                    const f32x4 x0 = *(const f32x4*)xp + acc[ai][bj][m][0], x1 = *(const f32x4*)(xp + 4) + acc[ai][bj][m][1];
                    *(f32x4*)xp = x0 * rs * g0; *(f32x4*)(xp + 4) = x1 * rs * g1;
                }
            }
    }
};
__device__ __forceinline__ void sample_fix_final(const Args& a, const float* part) {
    const int tid = otid(), lane = tid & 63, wave = tid >> 6;
    for (int r = T_P + blockIdx.x * 8 + wave; r < TT; r += gridDim.x * 8) {
        float4* xi = (float4*)(a.out + (size_t)r * 1024);
        float4 v[4]; float ss = 0.f;
#pragma unroll
        for (int j = 0; j < 4; ++j) {
            v[j] = xi[lane + 64 * j];
#pragma unroll
            for (int s = 0; s < 8; ++s) { const float4 p = ((const float4*)(part + ((size_t)s * 512 + (r - T_P)) * 1024))[lane + 64 * j]; v[j].x += p.x; v[j].y += p.y; v[j].z += p.z; v[j].w += p.w; }
            ss += (v[j].x * v[j].x + v[j].y * v[j].y) + (v[j].z * v[j].z + v[j].w * v[j].w);
        }
        const float rs = rsqrtf(wave_sum(ss) * (1.f / 1024.f) + NORM_EPS);
#pragma unroll
        for (int j = 0; j < 4; ++j) { const float4 g = ((const float4*)a.in[I_FG])[lane + 64 * j]; float4 o = v[j]; o.x *= rs * g.x; o.y *= rs * g.y; o.z *= rs * g.z; o.w *= rs * g.w; xi[lane + 64 * j] = o; }
    }
}

struct DownOrder {
    int c, snt;
    __device__ __forceinline__ bool next(int i, pg8::Unit& u) const {
        if (i == 0) { const int v = (c & 7) * 32 + (c >> 3); u.pm = v >> 2; u.pn = v & 3; u.kofs = 0; u.nt = 0; u.part = -1; return true; }
        if (i == 1 && c < 64) { const int su = c >> 3, sl = c & 7; u.pm = 64 + (su >> 2); u.pn = su & 3; u.kofs = sl * snt * 64 * 2; u.nt = snt; u.part = sl; return true; }
        return false;
    }
    __device__ __forceinline__ void a_ready(const pg8::Unit&) const {}
    __device__ __forceinline__ void done(const pg8::Unit&) const {}
};
struct EpiResSplit {
    static constexpr bool PERM = true, AFTER_DRAIN = false;
    float* X; bf16* XB; float* rss; float* part;
    __device__ __forceinline__ void operator()(const f32x4 (&acc)[2][2][4][2], const pg8::Unit& u, int wr, int wc, int fr, int fq) const {
        if (u.part < 0) { EpiRes E{X, XB, rss}; E(acc, u, wr, wc, fr, fq); return; }
        const int row0 = (u.pm - 64) * 256 + wr * 64 + fr, col0 = u.pn * 256 + wc * 32 + 8 * fq;
        float* pp = part + (size_t)u.part * 512 * 1024;
#pragma unroll
        for (int ai = 0; ai < 2; ++ai)
#pragma unroll
            for (int m = 0; m < 4; ++m)
#pragma unroll
                for (int bj = 0; bj < 2; ++bj) {
                    float* xp = pp + (size_t)(row0 + ai * 128 + m * 16) * 1024 + col0 + bj * 128;
                    *(f32x4*)xp = acc[ai][bj][m][0]; *(f32x4*)(xp + 4) = acc[ai][bj][m][1];
                }
    }
};
__device__ __forceinline__ void sample_fix(const Args& a, float* rss, const float* part) {
    const int tid = otid(), lane = tid & 63, wave = tid >> 6;
    bf16* xb = (bf16*)(a.ws + WS_XB);
    for (int r = T_P + blockIdx.x * 8 + wave; r < TT; r += gridDim.x * 8) {
        float4* xi = (float4*)(a.out + (size_t)r * 1024);
        uint2* bo = (uint2*)(xb + (size_t)r * 1024);
        float ss = 0.f;
#pragma unroll
        for (int j = 0; j < 4; ++j) {
            float4 v = xi[lane + 64 * j];
#pragma unroll
            for (int s = 0; s < 8; ++s) { const float4 p = ((const float4*)(part + ((size_t)s * 512 + (r - T_P)) * 1024))[lane + 64 * j]; v.x += p.x; v.y += p.y; v.z += p.z; v.w += p.w; }
            xi[lane + 64 * j] = v;
            ss += (v.x * v.x + v.y * v.y) + (v.z * v.z + v.w * v.w); uint2 w; w.x = pk2(v.x, v.y); w.y = pk2(v.z, v.w); bo[lane + 64 * j] = w;
        }
        ss = wave_sum(ss);
        if (lane == 0) rss[r] = ss;
    }
}

template <class Epi> __device__ __forceinline__ void skinny_gemm(const bf16* __restrict__ A  , const bf16* __restrict__ Bt, int N, int K, const Epi& E) {
    const int tid = otid(), wave = tid >> 6, lane = tid & 63, fr = lane & 15, fq = lane >> 4;
    const int nN = N >> 7, nU = 8 * nN;
    for (int u = blockIdx.x; u < nU; u += gridDim.x) {
        const int mb = u / nN, nb = u - mb * nN, n0 = nb * 128 + wave * 16;
        const bf16* ap = A + (size_t)(mb * 64 + fr) * K + 8 * fq;
        const bf16* bp = Bt + (size_t)(n0 + fr) * K + 8 * fq;
        f32x4 acc[4];
#pragma unroll
        for (int m = 0; m < 4; ++m) acc[m] = (f32x4){0.f, 0.f, 0.f, 0.f};
#pragma unroll 4
        for (int k = 0; k < K; k += 32) {
            const pg8::bf16x8 bfr = *(const pg8::bf16x8*)(bp + k);
#pragma unroll
            for (int m = 0; m < 4; ++m) { const pg8::bf16x8 af = *(const pg8::bf16x8*)(ap + (size_t)m * 16 * K + k); acc[m] = __builtin_amdgcn_mfma_f32_16x16x32_bf16(bfr, af, acc[m], 0, 0, 0); }
        }
        E(acc, T_P + mb * 64 + fr, n0 + 4 * fq, fq);
    }
}
template <bool RELU2> struct SkScale {
    bf16* O; int ldc; const float* rss;
    __device__ __forceinline__ void operator()(const f32x4 (&acc)[4], int row, int col, int fq) const {
#pragma unroll
        for (int m = 0; m < 4; ++m) {
            const int r = row + 16 * m;
            const float rs = rsqrtf(rss[r] * (1.f / 1024.f) + NORM_EPS);
            f32x4 v = acc[m] * rs;
            if (RELU2) {
#pragma unroll
                for (int e = 0; e < 4; ++e) { const float p = fmaxf(v[e], 0.f); v[e] = p * p; }
            }
            uint2 w; w.x = pg8::cvt_pk_bf16(v[0], v[1]); w.y = pg8::cvt_pk_bf16(v[2], v[3]);
            *(uint2*)(O + (size_t)r * ldc + col) = w;
        }
    }
};
struct SkRes {
    float* X; bf16* XB; float* rss;
    __device__ __forceinline__ void operator()(const f32x4 (&acc)[4], int row, int col, int fq) const {
#pragma unroll
        for (int m = 0; m < 4; ++m) {
            const int r = row + 16 * m;
            float* xp = X + (size_t)r * 1024 + col;
            const f32x4 x = *(const f32x4*)xp + acc[m];
            *(f32x4*)xp = x;
            uint2 w; w.x = pg8::cvt_pk_bf16(x[0], x[1]); w.y = pg8::cvt_pk_bf16(x[2], x[3]);
            *(uint2*)(XB + (size_t)r * 1024 + col) = w;
            float ss = (x[0] * x[0] + x[1] * x[1]) + (x[2] * x[2] + x[3] * x[3]);
            ss += __shfl_xor(ss, 16); ss += __shfl_xor(ss, 32);
            if (fq == 0) atomicAdd(rss + r, ss);
        }
    }
};

__device__ __forceinline__ void tr_item(const float* __restrict__ W, int K, int Nsrc, bf16* __restrict__ WT, const float* __restrict__ gain, bool inmap, float* scr, int item, int nblk, int lane) {
    const int kb = item / nblk, nb = item - kb * nblk, k0 = 64 * kb, n0 = 32 * nb;
    const int n = n0 + (lane & 31);
    int ns = n;
    if (inmap) ns = n < 1536 ? n : n + 8;
    float tv[32];
    const int nsc = ns >= 0 ? ns : 0;
#pragma unroll
    for (int i = 0; i < 32; ++i) tv[i] = W[(size_t)(k0 + 2 * i + (lane >> 5)) * Nsrc + nsc];
#pragma unroll
    for (int i = 0; i < 32; ++i) {
        const int kk = 2 * i + (lane >> 5);
        float v = ns >= 0 ? tv[i] : 0.f;
        if (gain) v *= gain[k0 + kk];
        scr[kk * 33 + (lane & 31)] = v;
    }
    LDS_WAIT();
    const int c = lane & 7;
#pragma unroll
    for (int j = 0; j < 4; ++j) {
        const int nn = (lane >> 3) + 8 * j; const float* s = scr + (8 * c) * 33 + nn;
        uint4 o; o.x = pk2(s[0], s[33]); o.y = pk2(s[66], s[99]); o.z = pk2(s[132], s[165]); o.w = pk2(s[198], s[231]);
        *(uint4*)(WT + (size_t)(n0 + nn) * K + k0 + 8 * c) = o;
    }
    LDS_WAIT();
}

__device__ __forceinline__ void convert_layer(const Args& a, int l, float* scr, int gw, int NGW, int lane) {
    bf16* wb = (bf16*)(a.ws + WS_W) + (size_t)l * WL_ELEMS;
    for (int it = gw; it < 6016; it += NGW) {
        int r = it;
        if (r < 1408) tr_item(a.in[I_WIN] + (size_t)l * 1024 * 2824, 1024, 2824, wb + WOFF_IN, a.in[I_N1G] + l * 1024, true, scr, r, 88, lane);
        else if ((r -= 1408) < 512) tr_item(a.in[I_WOUT] + (size_t)l * 1024 * 1024, 1024, 1024, wb + WOFF_OUT, nullptr, false, scr, r, 32, lane);
        else if ((r -= 512) < 2048) tr_item(a.in[I_WUP] + (size_t)l * 1024 * 4096, 1024, 4096, wb + WOFF_UP, a.in[I_N2G] + l * 1024, false, scr, r, 128, lane);
        else { r -= 2048; tr_item(a.in[I_WDN] + (size_t)l * 4096 * 1024, 4096, 1024, wb + WOFF_DOWN, nullptr, false, scr, r, 32, lane); }
    }
}
__device__ __forceinline__ void phase0(const Args& a, unsigned char* lds) {
    const int tid = otid(), lane = tid & 63, wave = tid >> 6;
    const int gw = blockIdx.x * 8 + wave, NGW = gridDim.x * 8;
    float* scr = (float*)(lds + wave * 16384);
    convert_layer(a, 0, scr, gw, NGW, lane);
    if (MK_PER_PHASE || gridDim.x != 256) convert_layer(a, 1, scr, gw, NGW, lane);
    {
        bf16* BAW = (bf16*)(a.ws + WS_BAW);
        for (int i = blockIdx.x * 512 + tid; i < 2 * 16 * 1024; i += gridDim.x * 512) {
            const int l = i >> 14, n = (i >> 10) & 15, kk = i & 1023;
            const float v = n < 8 ? a.in[I_WIN][((size_t)l * 1024 + kk) * 2824 + 1536 + n] * a.in[I_N1G][l * 1024 + kk] : 0.f;
            BAW[i] = (bf16)f2bf(v);
        }
    }
    float* rowss = (float*)(a.ws + WS_ROWSS);
    bf16* xb = (bf16*)(a.ws + WS_XB);
    for (int r = gw; r < TT; r += NGW) {
        const float* src = r < T_P ? a.in[I_XP] + (size_t)r * 1024 : a.in[I_XS] + (size_t)(r - T_P) * 1024;
        float4 v[4]; float ss = 0.f;
#pragma unroll
        for (int j = 0; j < 4; ++j) { v[j] = ((const float4*)src)[lane + 64 * j]; ss += (v[j].x * v[j].x + v[j].y * v[j].y) + (v[j].z * v[j].z + v[j].w * v[j].w); }
        ss = wave_sum(ss);
        if (lane == 0) rowss[r] = ss;
        float4* xo = (float4*)(a.out + (size_t)r * 1024);
        uint2* bo = (uint2*)(xb + (size_t)r * 1024);
#pragma unroll
        for (int j = 0; j < 4; ++j) { xo[lane + 64 * j] = v[j]; uint2 w; w.x = pk2(v[j].x, v[j].y); w.y = pk2(v[j].z, v[j].w); bo[lane + 64 * j] = w; }
    }
    for (int i = blockIdx.x * 512 + tid; i < 4 * TT; i += gridDim.x * 512) rowss[TT + i] = 0.f;
    {
        bf16* LW = (bf16*)(a.ws + WS_LW);
        for (int i = blockIdx.x * 512 + tid; i < 2 * 81920; i += gridDim.x * 512) {
            const int l = i / 81920; int r = i - l * 81920; float v;
            if (r < 16384) { const int c = r >> 6, j = r & 63; v = a.in[I_CW2][((size_t)l * 64 + j) * 256 + c]; }
            else if (r < 32768) { r -= 16384; const int c = r >> 6, j = r & 63; v = a.in[I_CA2][((size_t)l * 64 + j) * 256 + c]; }
            else if (r < 65536) { r -= 32768; const int c = r >> 7, j = r & 127; v = a.in[I_CG2][((size_t)l * 128 + j) * 256 + c]; }
            else { r -= 65536; const int c = r >> 6, cin = r & 63; v = a.in[I_DW][(((size_t)l * 4 + (c >> 6)) * 64 + cin) * 64 + (c & 63)]; }
            LW[i] = (bf16)f2bf(v);
        }
    }
}

template <int N> __device__ __forceinline__ void prev_c(const Args& a, int l, int row, int ccol, float (&o)[N]) {
    const bf16* P = (const bf16*)(a.ws + WS_P);
    bool first, smp = row >= T_P; int b = 0;
    if (!smp) first = (row & 2047) == 0; else { const int rs = row - T_P; first = (rs & 3) == 0; b = rs >> 2; }
    const int pr = row > 0 ? row - 1 : 0;
    float pv[N], sv[N];
    ldbf<N>(P + (size_t)pr * PN + PC_C + ccol, pv);
    ldf<N>(a.in[I_SCS] + ((size_t)l * 128 + b) * 1024 + ccol, sv);
#pragma unroll
    for (int i = 0; i < N; ++i) o[i] = first ? (smp ? sv[i] : 0.f) : pv[i];
}

__device__ __forceinline__ int tile_row(int tile, int i) { return i < 64 ? tile * 64 + i : T_P + tile * 2 + (i - 64); }
constexpr int XS = 264;
template <int KSTEPS> __device__ __forceinline__ void lora_mfma(const bf16* X, int joff, const bf16* __restrict__ WT, int wave, int lane, f32x4 (&acc)[5][2]) {
    const int fr = lane & 15, fq = lane >> 4;
#pragma unroll
    for (int m = 0; m < 5; ++m) { acc[m][0] = (f32x4){0.f, 0.f, 0.f, 0.f}; acc[m][1] = (f32x4){0.f, 0.f, 0.f, 0.f}; }
#pragma unroll
    for (int k = 0; k < KSTEPS; ++k) {
        pg8::bf16x8 bf[2];
#pragma unroll
        for (int n = 0; n < 2; ++n) bf[n] = *(const pg8::bf16x8*)(WT + (size_t)(wave * 32 + n * 16 + fr) * (32 * KSTEPS) + k * 32 + 8 * fq);
#pragma unroll
        for (int m = 0; m < 5; ++m) {
            const pg8::bf16x8 af = *(const pg8::bf16x8*)(X + (m * 16 + fr) * XS + joff + k * 32 + 8 * fq);
#pragma unroll
            for (int n = 0; n < 2; ++n) acc[m][n] = __builtin_amdgcn_mfma_f32_16x16x32_bf16(bf[n], af, acc[m][n], 0, 0, 0);
        }
    }
}

__device__ __forceinline__ void aux_tile(const Args& a, int l, int tile, unsigned char* lds) {
    const int tid = otid(), c = tid & 255, half = tid >> 8;
    const bf16* P = (const bf16*)(a.ws + WS_P);
    bf16* X = (bf16*)lds;
    {
        const float mu = a.in[I_CMU][l * 1024 + 768 + c];
#pragma unroll
        for (int j = 0; j < 33; ++j) {
            const int i = half * 33 + j, row = tile_row(tile, i);
            const float cur = bf2f(P[(size_t)row * PN + PC_C + 768 + c]);
            float pv[1]; prev_c<1>(a, l, row, 768 + c, pv);
            float xm = cur + (pv[0] - cur) * mu;
            if (c < 64) xm = tanh_(xm); else if (c >= 128) xm = sigm(xm);
            X[i * XS + c] = (bf16)f2bf(xm);
        }
    }
    __syncthreads();
    const int wave = tid >> 6, lane = tid & 63, fr = lane & 15, fq = lane >> 4;
    const bf16* LW = (const bf16*)(a.ws + WS_LW) + (size_t)l * 81920;
    float* auxw = (float*)(a.ws + WS_AUXW); bf16* auxa = (bf16*)(a.ws + WS_AUXA); bf16* auxg = (bf16*)(a.ws + WS_AUXG);
    f32x4 acc[5][2];
    lora_mfma<2>(X, 0, LW, wave, lane, acc);
#pragma unroll
    for (int n = 0; n < 2; ++n) {
        const int cc = wave * 32 + n * 16 + 4 * fq;
        const float4 w0c = *(const float4*)(a.in[I_CW0] + l * 256 + cc);
#pragma unroll
        for (int m = 0; m < 5; ++m) {
            const int tok = m * 16 + fr;
            if (tok < 66) {
                float4 o;
                o.x = __expf(-__expf(-softplus_(-(w0c.x + acc[m][n][0])) - 0.5f)); o.y = __expf(-__expf(-softplus_(-(w0c.y + acc[m][n][1])) - 0.5f));
                o.z = __expf(-__expf(-softplus_(-(w0c.z + acc[m][n][2])) - 0.5f)); o.w = __expf(-__expf(-softplus_(-(w0c.w + acc[m][n][3])) - 0.5f));
                *(float4*)(auxw + (size_t)tile_row(tile, tok) * 256 + cc) = o;
            }
        }
    }
    lora_mfma<2>(X, 64, LW + 16384, wave, lane, acc);
#pragma unroll
    for (int n = 0; n < 2; ++n) {
        const int cc = wave * 32 + n * 16 + 4 * fq;
        const float4 a0c = *(const float4*)(a.in[I_CA0] + l * 256 + cc);
#pragma unroll
        for (int m = 0; m < 5; ++m) {
            const int tok = m * 16 + fr;
            if (tok < 66) { uint2 o; o.x = pk2(sigm(a0c.x + acc[m][n][0]), sigm(a0c.y + acc[m][n][1])); o.y = pk2(sigm(a0c.z + acc[m][n][2]), sigm(a0c.w + acc[m][n][3])); *(uint2*)(auxa + (size_t)tile_row(tile, tok) * 256 + cc) = o; }
        }
    }
    lora_mfma<4>(X, 128, LW + 32768, wave, lane, acc);
#pragma unroll
    for (int n = 0; n < 2; ++n) {
        const int cc = wave * 32 + n * 16 + 4 * fq;
#pragma unroll
        for (int m = 0; m < 5; ++m) {
            const int tok = m * 16 + fr;
            if (tok < 66) { uint2 o; o.x = pk2(acc[m][n][0], acc[m][n][1]); o.y = pk2(acc[m][n][2], acc[m][n][3]); *(uint2*)(auxg + (size_t)tile_row(tile, tok) * 256 + cc) = o; }
        }
    }
    __syncthreads();
}

__device__ __forceinline__ void pool_tile(const Args& a, int l, int tile, unsigned char* lds) {
    bf16* X = (bf16*)lds;
    const int tid = otid(), c = tid & 255, half = tid >> 8, r0 = tile * 64;
    const bf16* P = (const bf16*)(a.ws + WS_P);
    bf16* mixed = (bf16*)(a.ws + WS_MIXED);
    const int gi = c >> 6, w = 2 << gi;
    unsigned short* Sg = (unsigned short*)(lds + 43008);
#pragma unroll
    for (int j = 0; j < 40; ++j) {
        const int k = half * 40 + j;
        if (k < 79) { const int gr = r0 - 15 + k; unsigned short v = 0; if (gr >= 0) v = P[(size_t)gr * PN + PC_D + c]; Sg[k * 256 + c] = v; }
    }
    __syncthreads();
    for (int j = 0; j < 32; ++j) {
        const int i = half * 32 + j, row = r0 + i;
        const unsigned short* sp = Sg + (15 + i) * 256 + c;
        const float xc = bf2f(sp[0]);
        const int b = row >> 11, t = row & 2047;
        const int n = t + 1 < w ? t + 1 : w;
        float sum = xc;
#pragma unroll
        for (int q = 1; q < 16; ++q) { const float hv = bf2f(sp[-q * 256]); if (q < n) sum += hv; }
        if (t >= 2033) a.out[O_PDP + (((size_t)l * 8 + b) * 15 + (t - 2033)) * 256 + c] = xc;
        X[i * XS + c] = (bf16)f2bf(sum / (float)n - xc);
    }
    {
        const int i = 64 + half, rs = tile * 2 + half, row = T_P + rs, b = rs >> 2, t = rs & 3;
        const float* sb = a.in[I_SDP] + ((size_t)l * 128 + b) * 15 * 256 + c;
        const float xc = bf2f(P[(size_t)row * PN + PC_D + c]);
        float hv[15];
#pragma unroll
        for (int q = 1; q < 16; ++q) {
            const int tq = t - q;
            const float pv = bf2f(P[(size_t)(row - (tq >= 0 ? q : 0)) * PN + PC_D + c]);
            const float sv = sb[(tq >= 0 ? 0 : 15 + tq) * 256];
            hv[q - 1] = tq >= 0 ? pv : sv;
        }
        float sum = xc;
#pragma unroll
        for (int q = 1; q < 16; ++q) if (q < w) sum += hv[q - 1];
        float* so = a.out + O_SDP + ((size_t)l * 128 + b) * 15 * 256 + c;
        so[(11 + t) * 256] = xc;
        if (t == 0) {
            float tv[11];
#pragma unroll
            for (int jj = 0; jj < 11; ++jj) tv[jj] = sb[(jj + 4) * 256];
#pragma unroll
            for (int jj = 0; jj < 11; ++jj) so[jj * 256] = tv[jj];
        }
        X[i * XS + c] = (bf16)f2bf(sum / (float)w - xc);
    }
    __syncthreads();
    {
        const int wave = tid >> 6, lane = tid & 63, fr = lane & 15, fq = lane >> 4;
        const bf16* LW = (const bf16*)(a.ws + WS_LW) + (size_t)l * 81920 + 65536;
        f32x4 acc[5][2];
        lora_mfma<2>(X, (wave >> 1) * 64, LW, wave, lane, acc);
#pragma unroll
        for (int n = 0; n < 2; ++n) {
            const int cc = wave * 32 + n * 16 + 4 * fq;
            const float4 sc = *(const float4*)(a.in[I_DSC] + l * 256 + cc);
#pragma unroll
            for (int m = 0; m < 5; ++m) {
                const int tok = m * 16 + fr;
                if (tok < 66) { uint2 o; o.x = pk2(acc[m][n][0] * sc.x, acc[m][n][1] * sc.y); o.y = pk2(acc[m][n][2] * sc.z, acc[m][n][3] * sc.w); *(uint2*)(mixed + (size_t)tile_row(tile, tok) * 1024 + 768 + cc) = o; }
            }
        }
    }
    for (int i = 0; i < 66; ++i) {
        const int row = tile_row(tile, i); int b, t, tl; bool smp;
        if (row < T_P) { b = row >> 11; t = row & 2047; tl = 2047; smp = false; } else { const int rs = row - T_P; b = rs >> 2; t = rs & 3; tl = 3; smp = true; }
        if (t == tl) {
            float* o = a.out + (smp ? O_SCS + ((size_t)l * 128 + b) * 1024 : O_PCS + ((size_t)l * 8 + b) * 1024);
            const float v0 = bf2f(P[(size_t)row * PN + PC_C + tid]), v1 = bf2f(P[(size_t)row * PN + PC_C + 512 + tid]);
            o[tid] = v0; o[512 + tid] = v1;
        }
        if (t >= tl - 2) {
            const int j = t - (tl - 2);
            float* o = a.out + (smp ? O_SBC + (((size_t)l * 128 + b) * 3 + j) * 768 : O_PBC + (((size_t)l * 8 + b) * 3 + j) * 768);
            const float v0 = bf2f(P[(size_t)row * PN + PC_BQ + tid]);
            o[tid] = v0;
            if (tid < 256) o[512 + tid] = bf2f(P[(size_t)row * PN + PC_BQ + 512 + tid]);
        }
    }
    __syncthreads();
}

__device__ __forceinline__ void gmlp_prompt_item(const Args& a, int l, int it, unsigned char* lds) {
    const int tid = otid(), t = tid >> 2, q = tid & 3;
    const int b = it >> 6, nc = (it >> 2) & 15, h = it & 3;
    const int row = b * 2048 + nc * 128 + t;
    const bf16* Pb = (const bf16*)(a.ws + WS_P);
    const bf16* Prow = Pb + (size_t)row * PN;
    bf16* mixed = (bf16*)(a.ws + WS_MIXED);
    bf16* wsb = (bf16*)lds;
    bf16* vT = (bf16*)(lds + 34816);
    float ss = 0.f;
#pragma unroll
    for (int k = 0; k < 8; ++k) { float x[8]; ld8(Prow + 256 + q * 64 + k * 8, x);
#pragma unroll
        for (int e = 0; e < 8; ++e) { const float g = gelu_t(x[e]); ss += g * g; } }
    ss += __shfl_xor(ss, 1); ss += __shfl_xor(ss, 2);
    const float rstd = rsqrtf(ss * (1.f / 256.f) + NORM_EPS);
    {
        const float* vg = a.in[I_AVG] + l * 256 + h * 64 + q * 16;
#pragma unroll
        for (int k = 0; k < 2; ++k) { float x[8]; ld8(Prow + 256 + h * 64 + q * 16 + k * 8, x);
#pragma unroll
            for (int e = 0; e < 8; ++e) vT[(q * 16 + k * 8 + e) * 136 + t] = (bf16)f2bf(gelu_t(x[e]) * rstd * vg[k * 8 + e]); }
    }
    {
        const float* wsrc = a.in[I_AWS] + ((size_t)l * 4 + h) * 16384;
        float4 wv[8];
#pragma unroll
        for (int j = 0; j < 8; ++j) { const int idx = tid + 512 * j; wv[j] = *(const float4*)(wsrc + (idx >> 5) * 128 + (idx & 31) * 4); }
#pragma unroll
        for (int j = 0; j < 8; ++j) {
            const int idx = tid + 512 * j, rr = idx >> 5, s0 = (idx & 31) * 4;
            uint2 o; o.x = pk2(s0 <= rr ? wv[j].x : 0.f, s0 + 1 <= rr ? wv[j].y : 0.f); o.y = pk2(s0 + 2 <= rr ? wv[j].z : 0.f, s0 + 3 <= rr ? wv[j].w : 0.f);
            *(uint2*)(wsb + rr * 136 + s0) = o;
        }
    }
    __syncthreads();
    const int wave = tid >> 6, lane = tid & 63, fr = lane & 15, fq = lane >> 4;
    f32x4 acc[4];
#pragma unroll
    for (int n = 0; n < 4; ++n) acc[n] = (f32x4){0.f, 0.f, 0.f, 0.f};
    const int nk = (wave >> 1) + 1;
#pragma unroll
    for (int k = 0; k < 4; ++k) {
        if (k < nk) {
            const pg8::bf16x8 af = *(const pg8::bf16x8*)(wsb + (wave * 16 + fr) * 136 + k * 32 + 8 * fq);
#pragma unroll
            for (int n = 0; n < 4; ++n) { const pg8::bf16x8 bfr = *(const pg8::bf16x8*)(vT + (n * 16 + fr) * 136 + k * 32 + 8 * fq); acc[n] = __builtin_amdgcn_mfma_f32_16x16x32_bf16(bfr, af, acc[n], 0, 0, 0); }
        }
    }
    {
        const int tt = wave * 16 + fr, ro = b * 2048 + nc * 128 + tt;
        const float bs = a.in[I_ABS][((size_t)l * 4 + h) * 128 + tt];
#pragma unroll
        for (int n = 0; n < 4; ++n) {
            const int cc = h * 64 + n * 16 + 4 * fq;
            float u[4]; ld4(Pb + (size_t)ro * PN + cc, u);
            uint2 o; o.x = pk2(gelu_t(u[0]) * (acc[n][0] + bs), gelu_t(u[1]) * (acc[n][1] + bs)); o.y = pk2(gelu_t(u[2]) * (acc[n][2] + bs), gelu_t(u[3]) * (acc[n][3] + bs));
            *(uint2*)(mixed + (size_t)ro * 1024 + cc) = o;
        }
    }
    __syncthreads();
}
__device__ __forceinline__ void gmlp_sample_item(const Args& a, int l, int b, float* Ls  ) {
    const int tid = otid(), lane = tid & 63, wave = tid >> 6, t = tid >> 7, c0 = (tid & 127) * 2;
    const int row = T_P + b * 4 + t;
    const bf16* Prow = (const bf16*)(a.ws + WS_P) + (size_t)row * PN;
    bf16* mixed = (bf16*)(a.ws + WS_MIXED);
    float* red = Ls + 1024;
    float x[2]; ld2(Prow + 256 + c0, x);
    const float g0 = gelu_t(x[0]), g1 = gelu_t(x[1]);
    const float ss = wave_sum(g0 * g0 + g1 * g1);
    if (lane == 0) red[wave] = ss;
    __syncthreads();
    const float rstd = rsqrtf((red[2 * t] + red[2 * t + 1]) * (1.f / 256.f) + NORM_EPS);
    const float v0 = g0 * rstd * a.in[I_AVG][l * 256 + c0], v1 = g1 * rstd * a.in[I_AVG][l * 256 + c0 + 1];
    Ls[t * 256 + c0] = v0; Ls[t * 256 + c0 + 1] = v1;
    float* sav = a.out + O_SAV + (((size_t)l * 128 + b) * 4 + t) * 256 + c0;
    sav[0] = v0; sav[1] = v1;
    __syncthreads();
    const int h = c0 >> 6;
    const float* wrow = a.in[I_AWS] + (((size_t)l * 4 + h) * 128 + t) * 128;
    const float bs = a.in[I_ABS][((size_t)l * 4 + h) * 128 + t];
    float m0 = bs, m1 = bs;
    for (int s = 0; s <= t; ++s) { const float ww = wrow[s]; m0 += ww * Ls[s * 256 + c0]; m1 += ww * Ls[s * 256 + c0 + 1]; }
    float u[2]; ld2(Prow + c0, u);
    *(unsigned*)(mixed + (size_t)row * 1024 + c0) = pk2(gelu_t(u[0]) * m0, gelu_t(u[1]) * m1);
    __syncthreads();
}

__device__ __forceinline__ void ba_tile(const Args& a, int l, int tile, unsigned char* lds) {
    const int tid = otid(), wave = tid >> 6, lane = tid & 63, fr = lane & 15, fq = lane >> 4;
    const bf16* xb = (const bf16*)(a.ws + WS_XB);
    const bf16* BAW = (const bf16*)(a.ws + WS_BAW) + (size_t)l * 16384;
    float* red = (float*)lds;
    f32x4 acc[5];
#pragma unroll
    for (int m = 0; m < 5; ++m) acc[m] = (f32x4){0.f, 0.f, 0.f, 0.f};
#pragma unroll
    for (int k = 0; k < 4; ++k) {
        const int kk = wave * 128 + k * 32 + 8 * fq;
        const pg8::bf16x8 bfr = *(const pg8::bf16x8*)(BAW + fr * 1024 + kk);
#pragma unroll
        for (int m = 0; m < 5; ++m) {
            const int tok = m * 16 + fr, row = tile_row(tile, tok < 66 ? tok : 65);
            const pg8::bf16x8 af = *(const pg8::bf16x8*)(xb + (size_t)row * 1024 + kk);
            acc[m] = __builtin_amdgcn_mfma_f32_16x16x32_bf16(bfr, af, acc[m], 0, 0, 0);
        }
    }
#pragma unroll
    for (int m = 0; m < 5; ++m) *(f32x4*)(red + ((wave * 80) + m * 16 + fr) * 16 + 4 * fq) = acc[m];
    __syncthreads();
    const float* rss = (const float*)(a.ws + WS_ROWSS) + (size_t)(2 * l) * TT;
    float* BA = (float*)(a.ws + WS_BA);
    for (int e = tid; e < 66 * 8; e += 512) {
        const int tok = e >> 3, n = e & 7, row = tile_row(tile, tok);
        float s = 0.f;
#pragma unroll
        for (int w = 0; w < 8; ++w) s += red[(w * 80 + tok) * 16 + n];
        BA[(size_t)row * 8 + n] = s * rsqrtf(rss[row] * (1.f / 1024.f) + NORM_EPS);
    }
    __syncthreads();
}

__device__ __forceinline__ void phase_pre(const Args& a, int l, unsigned char* lds, int mode = 0) {
    float* L = (float*)lds;
    const int G = gridDim.x, g = blockIdx.x;
    if (mode != 2) for (int tile = g; tile < 256; tile += G) { aux_tile(a, l, tile, lds); pool_tile(a, l, tile, lds); ba_tile(a, l, tile, lds); }
    if (mode != 1) for (int it = g; it < 512; it += G) gmlp_prompt_item(a, l, it, lds);
    for (int it = g; it < 128; it += G) gmlp_sample_item(a, l, it, L);
}

struct ChunkD { int valid, mixer, h, cg, b, sample, row0, t0, n, first, last; };
__device__ __forceinline__ ChunkD get_chunk(int idx, int g, int G, int mode = 0) {
    ChunkD d; d.valid = 0; d.mixer = 0; d.h = 0; d.cg = 0; d.b = 0; d.sample = 0; d.row0 = 0; d.t0 = 0; d.n = 0; d.first = 0; d.last = 0;
    int nP = g < 256 ? (256 - g + G - 1) / G : 0;
    int nS = g < 4096 ? (4096 - g + G - 1) / G : 0;
    nS = 0;
    if (mode == 2) nP = 0;
    if (idx < nP * 64) {
        const int it = g + (idx >> 6) * G, ch = idx & 63;
        d.valid = 1; d.mixer = it & 1; d.cg = (it >> 1) & 3; d.h = (it >> 3) & 3; d.b = it >> 5; d.sample = 0; d.row0 = d.b * 2048; d.t0 = ch * 32; d.n = 32; d.first = ch == 0; d.last = ch == 63;
    } else {
        const int j = idx - nP * 64;
        if (j < nS) { const int it = g + j * G; d.valid = 1; d.mixer = it & 1; d.cg = (it >> 1) & 3; d.h = (it >> 3) & 3; d.b = it >> 5; d.sample = 1; d.row0 = T_P + d.b * 4; d.t0 = 0; d.n = 4; d.first = 1; d.last = 1; }
    }
    return d;
}
constexpr int OPB_FLOATS = 10752;

struct Raw { uint4 u[8]; unsigned s[4]; float w[2]; };
__device__ __forceinline__ void unpack8(const uint4 u, float (&o)[8]) {
    o[0] = __uint_as_float(u.x << 16); o[1] = __uint_as_float(u.x & 0xffff0000u); o[2] = __uint_as_float(u.y << 16); o[3] = __uint_as_float(u.y & 0xffff0000u);
    o[4] = __uint_as_float(u.z << 16); o[5] = __uint_as_float(u.z & 0xffff0000u); o[6] = __uint_as_float(u.w << 16); o[7] = __uint_as_float(u.w & 0xffff0000u);
}
__device__ __forceinline__ uint4 pack8f(const float* p) {
    const float4 x = *(const float4*)p, y = *(const float4*)(p + 4);
    uint4 o; o.x = pk2(x.x, x.y); o.y = pk2(x.z, x.w); o.z = pk2(y.x, y.y); o.w = pk2(y.z, y.w); return o;
}
__device__ __forceinline__ void raw_load(const Args& a, int l, const ChunkD& d, int ptid, Raw& R) {
    const int tok = ptid >> 3, sub = ptid & 7;
    if (!d.valid || tok >= d.n) return;
    const int t = d.t0 + tok, row = d.row0 + t;
    const bf16* P = (const bf16*)(a.ws + WS_P);
    const uint4 z4 = make_uint4(0u, 0u, 0u, 0u);
    if (d.mixer == 0) {
        const int cq = d.h * 64 + sub * 8, cv = 512 + d.h * 64 + d.cg * 16 + sub * 2;
#pragma unroll
        for (int k = 0; k < 4; ++k) {
            const int tt = t - 3 + k;
            if (tt >= 0) { const bf16* pr = P + (size_t)(d.row0 + tt) * PN + PC_BQ; R.u[k] = *(const uint4*)(pr + cq); R.u[4 + k] = *(const uint4*)(pr + 256 + cq); R.s[k] = *(const unsigned*)(pr + cv); }
            else if (d.sample) { const float* sp = a.in[I_SBC] + (((size_t)l * 128 + d.b) * 3 + (tt + 3)) * 768; R.u[k] = pack8f(sp + cq); R.u[4 + k] = pack8f(sp + 256 + cq); R.s[k] = pk2(sp[cv], sp[cv + 1]); }
            else { R.u[k] = z4; R.u[4 + k] = z4; R.s[k] = 0u; }
        }
        { const float* ba = (const float*)(a.ws + WS_BA) + (size_t)row * 8; R.w[0] = ba[d.h]; R.w[1] = ba[4 + d.h]; }
    } else {
        const int ch = d.h * 64 + sub * 8, vcl = 512 + d.h * 64 + d.cg * 16 + sub * 2;
        const bf16* pc = P + (size_t)row * PN + PC_C;
        R.u[0] = *(const uint4*)(pc + ch); R.u[1] = *(const uint4*)(pc + 256 + ch); R.s[0] = *(const unsigned*)(pc + vcl);
        if (t > 0) { const bf16* pp = pc - PN; R.u[2] = *(const uint4*)(pp + ch); R.u[3] = *(const uint4*)(pp + 256 + ch); R.s[1] = *(const unsigned*)(pp + vcl); }
        else if (d.sample) { const float* sp = a.in[I_SCS] + ((size_t)l * 128 + d.b) * 1024; R.u[2] = pack8f(sp + ch); R.u[3] = pack8f(sp + 256 + ch); R.s[1] = pk2(sp[vcl], sp[vcl + 1]); }
        else { R.u[2] = z4; R.u[3] = z4; R.s[1] = 0u; }
        R.u[4] = *(const uint4*)((const bf16*)(a.ws + WS_AUXA) + (size_t)row * 256 + ch);
        const float* wp = (const float*)(a.ws + WS_AUXW) + (size_t)row * 256 + ch;
        R.u[5] = *(const uint4*)wp; R.u[6] = *(const uint4*)(wp + 4);
    }
}
__device__ __forceinline__ void prep_math(const Args& a, int l, const ChunkD& d, const Raw& R, float* ob, float* CST, int ptid) {
    const int tok = ptid >> 3, sub = ptid & 7;
    if (!d.valid || tok >= d.n) return;
    const int row = d.row0 + d.t0 + tok;
    float* Rp = ob + tok * 64 + sub * 8;
    float* V = ob + 10240 + tok * 16 + sub * 2;
    float r[8], w[8], k[8], kk[8], bb[8], v[2];
    if (d.mixer == 0) {
        const int cq = d.h * 64 + sub * 8, cv = 512 + d.h * 64 + d.cg * 16 + sub * 2;
        float q[8], kr[8];
#pragma unroll
        for (int i = 0; i < 8; ++i) { q[i] = 0.f; kr[i] = 0.f; }
        v[0] = 0.f; v[1] = 0.f;
        float* cst = CST + sub * 80;
        if (d.first) {
#pragma unroll
            for (int kx = 0; kx < 4; ++kx) {
                const float* cw = a.in[I_BCW] + ((size_t)l * 4 + kx) * 768;
                *(float4*)(cst + kx * 20) = *(const float4*)(cw + cq); *(float4*)(cst + kx * 20 + 4) = *(const float4*)(cw + cq + 4);
                *(float4*)(cst + kx * 20 + 8) = *(const float4*)(cw + 256 + cq); *(float4*)(cst + kx * 20 + 12) = *(const float4*)(cw + 256 + cq + 4);
                *(float2*)(cst + kx * 20 + 16) = *(const float2*)(cw + cv);
            }
        }
#pragma unroll
        for (int kx = 0; kx < 4; ++kx) {
            float xq[8], xk[8]; unpack8(R.u[kx], xq); unpack8(R.u[4 + kx], xk);
            const float4 a0 = *(const float4*)(cst + kx * 20), a1 = *(const float4*)(cst + kx * 20 + 4), b0 = *(const float4*)(cst + kx * 20 + 8), b1 = *(const float4*)(cst + kx * 20 + 12);
            const float2 c0 = *(const float2*)(cst + kx * 20 + 16);
            q[0] += xq[0] * a0.x; q[1] += xq[1] * a0.y; q[2] += xq[2] * a0.z; q[3] += xq[3] * a0.w; q[4] += xq[4] * a1.x; q[5] += xq[5] * a1.y; q[6] += xq[6] * a1.z; q[7] += xq[7] * a1.w;
            kr[0] += xk[0] * b0.x; kr[1] += xk[1] * b0.y; kr[2] += xk[2] * b0.z; kr[3] += xk[3] * b0.w; kr[4] += xk[4] * b1.x; kr[5] += xk[5] * b1.y; kr[6] += xk[6] * b1.z; kr[7] += xk[7] * b1.w;
            v[0] += __uint_as_float(R.s[kx] << 16) * c0.x; v[1] += __uint_as_float(R.s[kx] & 0xffff0000u) * c0.y;
        }
        float sq = 0.f, sk = 0.f;
#pragma unroll
        for (int i = 0; i < 8; ++i) { q[i] = silu(q[i]); kr[i] = silu(kr[i]); sq += q[i] * q[i]; sk += kr[i] * kr[i]; }
        v[0] = silu(v[0]); v[1] = silu(v[1]);
        sq = sum8(sq); sk = sum8(sk);
        const float iq = rsqrtf(sq + 1e-6f) * 0.125f, ik = rsqrtf(sk + 1e-6f);
        const float beta = sigm(R.w[0]);
        const float gg = -__expf(a.in[I_BAL][l * 4 + d.h]) * softplus_(R.w[1] + a.in[I_BDT][l * 4 + d.h]);
        const float dec = __expf(gg);
#pragma unroll
        for (int i = 0; i < 8; ++i) { const float kn = kr[i] * ik; r[i] = q[i] * iq; w[i] = dec; kk[i] = kn; k[i] = beta * kn; bb[i] = dec * beta * kn; }
    } else {
        const int ch = d.h * 64 + sub * 8, vcl = 512 + d.h * 64 + d.cg * 16 + sub * 2;
        float cur[8], pv[8], kx[8], av[8];
        const float* mu = a.in[I_CMU] + l * 1024;
        float m0[8], m1[8], kkw[8], kaw[8], rkw[8];
        float* cst = CST + sub * 80;
        if (d.first) {
            *(float4*)(cst) = *(const float4*)(mu + ch); *(float4*)(cst + 4) = *(const float4*)(mu + ch + 4);
            *(float4*)(cst + 8) = *(const float4*)(mu + 256 + ch); *(float4*)(cst + 12) = *(const float4*)(mu + 256 + ch + 4);
            const float* p1 = a.in[I_CKK] + l * 256 + ch; *(float4*)(cst + 16) = *(const float4*)p1; *(float4*)(cst + 20) = *(const float4*)(p1 + 4);
            const float* p2 = a.in[I_CKA] + l * 256 + ch; *(float4*)(cst + 24) = *(const float4*)p2; *(float4*)(cst + 28) = *(const float4*)(p2 + 4);
            const float* p3 = a.in[I_CRK] + l * 256 + ch; *(float4*)(cst + 32) = *(const float4*)p3; *(float4*)(cst + 36) = *(const float4*)(p3 + 4);
            *(float2*)(cst + 40) = *(const float2*)(mu + vcl);
        }
        ldf<8>(cst, m0); ldf<8>(cst + 8, m1); ldf<8>(cst + 16, kkw); ldf<8>(cst + 24, kaw); ldf<8>(cst + 32, rkw);
        const float mv0 = cst[40], mv1 = cst[41];
        unpack8(R.u[0], cur); unpack8(R.u[2], pv);
#pragma unroll
        for (int i = 0; i < 8; ++i) r[i] = cur[i] + (pv[i] - cur[i]) * m0[i];
        unpack8(R.u[1], cur); unpack8(R.u[3], pv);
#pragma unroll
        for (int i = 0; i < 8; ++i) kx[i] = cur[i] + (pv[i] - cur[i]) * m1[i];
        {
            const float c0 = __uint_as_float(R.s[0] << 16), c1 = __uint_as_float(R.s[0] & 0xffff0000u), p0 = __uint_as_float(R.s[1] << 16), p1 = __uint_as_float(R.s[1] & 0xffff0000u);
            v[0] = c0 + (p0 - c0) * mv0; v[1] = c1 + (p1 - c1) * mv1;
        }
        unpack8(R.u[4], av);
        float ss = 0.f;
#pragma unroll
        for (int i = 0; i < 8; ++i) { kk[i] = kx[i] * kkw[i]; ss += kk[i] * kk[i]; }
        w[0] = __uint_as_float(R.u[5].x); w[1] = __uint_as_float(R.u[5].y); w[2] = __uint_as_float(R.u[5].z); w[3] = __uint_as_float(R.u[5].w); w[4] = __uint_as_float(R.u[6].x); w[5] = __uint_as_float(R.u[6].y); w[6] = __uint_as_float(R.u[6].z); w[7] = __uint_as_float(R.u[6].w);
        ss = sum8(ss);
        const float inv = rsqrtf(ss + 1e-6f);
        float rk = 0.f;
#pragma unroll
        for (int i = 0; i < 8; ++i) { kk[i] *= inv; k[i] = kx[i] * (1.f + (av[i] - 1.f) * kaw[i]); bb[i] = kk[i] * av[i]; rk += r[i] * k[i] * rkw[i]; }
        rk = sum8(rk);
        if (sub == 0 && d.cg == 0) ((float*)(a.ws + WS_RK))[(size_t)row * 4 + d.h] = rk;
    }
    *(float4*)(Rp) = make_float4(r[0], r[1], r[2], r[3]); *(float4*)(Rp + 4) = make_float4(r[4], r[5], r[6], r[7]);
    *(float4*)(Rp + 2048) = make_float4(w[0], w[1], w[2], w[3]); *(float4*)(Rp + 2052) = make_float4(w[4], w[5], w[6], w[7]);
    *(float4*)(Rp + 4096) = make_float4(k[0], k[1], k[2], k[3]); *(float4*)(Rp + 4100) = make_float4(k[4], k[5], k[6], k[7]);
    *(float4*)(Rp + 6144) = make_float4(kk[0], kk[1], kk[2], kk[3]); *(float4*)(Rp + 6148) = make_float4(kk[4], kk[5], kk[6], kk[7]);
    *(float4*)(Rp + 8192) = make_float4(bb[0], bb[1], bb[2], bb[3]); *(float4*)(Rp + 8196) = make_float4(bb[4], bb[5], bb[6], bb[7]);
    V[0] = v[0]; V[1] = v[1];
}

__device__ __forceinline__ void flush_y(const Args& a, const ChunkD& d, const float* Yb, int ptid) {
    if (!d.valid) return;
    float* yraw = (float*)(a.ws + WS_XB) + (size_t)d.mixer * TT * 256;
    for (int e = ptid; e < d.n * 16; e += 256) {
        const float4* yp = (const float4*)(Yb + e * 16);
        const float4 a0 = yp[0], a1 = yp[1], a2 = yp[2], a3 = yp[3];
        const float y = ((a0.x + a0.y) + (a0.z + a0.w)) + ((a1.x + a1.y) + (a1.z + a1.w)) + ((a2.x + a2.y) + (a2.z + a2.w)) + ((a3.x + a3.y) + (a3.z + a3.w));
        const int st = e >> 4, c = e & 15; yraw[(size_t)(d.row0 + d.t0 + st) * 256 + d.h * 64 + d.cg * 16 + c] = y;
    }
}

typedef float f2 __attribute__((ext_vector_type(2)));
struct Ops { f32x4 r, w, k, q, b; float v; };
__device__ __forceinline__ void ops_load(Ops& o, const float* Rb, const float* Vb, int st) {
    o.r = *(const f32x4*)(Rb + st * 64); o.w = *(const f32x4*)(Rb + 2048 + st * 64); o.k = *(const f32x4*)(Rb + 4096 + st * 64);
    o.q = *(const f32x4*)(Rb + 6144 + st * 64); o.b = *(const f32x4*)(Rb + 8192 + st * 64); o.v = Vb[st * 16];
}
__device__ __forceinline__ void scan_step(const Ops& o, f2& S01, f2& S23, float* Yp) {
    const f2 p2 = o.q.xy * S01 + o.q.zw * S23;
    const float sk = dpp_sum16(p2.x + p2.y);
    const f2 vv = {o.v, o.v}, sk2 = {sk, sk};
    const f2 t01 = o.k.xy * vv - o.b.xy * sk2, t23 = o.k.zw * vv - o.b.zw * sk2;
    S01 = o.w.xy * S01 + t01; S23 = o.w.zw * S23 + t23;
    const f2 y2 = o.r.xy * S01 + o.r.zw * S23;
    *Yp = y2.x + y2.y;
}
__device__ __forceinline__ const float* state_in_ptr(const Args& a, int l, const ChunkD& d, int kg, int cc) {
    return a.in[d.mixer ? I_SCW : I_SBS] + ((((size_t)l * 128 + d.b) * 4 + d.h) * 64 + 4 * kg) * 64 + d.cg * 16 + cc;
}
__device__ __forceinline__ void consume_chunk(const Args& a, int l, const ChunkD& d, const ChunkD& nx, const float* ob, float* Yb, f2& S01, f2& S23, float (&Sn)[4], int wave, int lane) {
    const int kg = lane & 15, cc = wave * 4 + (lane >> 4);
    if (d.first) {
        if (d.sample) { S01.x = Sn[0]; S01.y = Sn[1]; S23.x = Sn[2]; S23.y = Sn[3]; }
        else { S01.x = 0.f; S01.y = 0.f; S23.x = 0.f; S23.y = 0.f; }
    }
    if (nx.valid && nx.first && nx.sample) { const float* sp = state_in_ptr(a, l, nx, kg, cc); Sn[0] = sp[0]; Sn[1] = sp[64]; Sn[2] = sp[128]; Sn[3] = sp[192]; }
    const float* Rb = ob + 4 * kg; const float* Vb = ob + 10240 + cc; float* Yp = Yb + cc * 16 + kg;
    Ops o0, o1, o2;
    ops_load(o0, Rb, Vb, 0); ops_load(o1, Rb, Vb, 1);
    for (int st = 0; st < d.n; st += 4) {
        ops_load(o2, Rb, Vb, st + 2); scan_step(o0, S01, S23, Yp + st * 256);
        ops_load(o0, Rb, Vb, st + 3); scan_step(o1, S01, S23, Yp + (st + 1) * 256);
        ops_load(o1, Rb, Vb, st + 4); scan_step(o2, S01, S23, Yp + (st + 2) * 256);
        ops_load(o2, Rb, Vb, st + 5); scan_step(o0, S01, S23, Yp + (st + 3) * 256);
        o0 = o1; o1 = o2;
    }
    if (d.last) {
        size_t off;
        if (d.sample) off = (d.mixer ? O_SCW : O_SBS) + ((((size_t)l * 128 + d.b) * 4 + d.h) * 64 + 4 * kg) * 64 + d.cg * 16 + cc;
        else off = (d.mixer ? O_PCW : O_PBS) + ((((size_t)l * 8 + d.b) * 4 + d.h) * 64 + 4 * kg) * 64 + d.cg * 16 + cc;
        float* sp = a.out + off;
        sp[0] = S01.x; sp[64] = S01.y; sp[128] = S23.x; sp[192] = S23.y;
    }
}

__device__ __forceinline__ void sample_item(const Args& a, int l, int it, float* wl  , int lane) {
    const int mixer = it & 1, h = (it >> 1) & 3, b = it >> 3;
    const bf16* P = (const bf16*)(a.ws + WS_P);
    const int row0 = T_P + b * 4;
    float S[64];
    {
        const float* sp = a.in[mixer ? I_SCW : I_SBS] + (((size_t)l * 128 + b) * 4 + h) * 4096 + lane;
#pragma unroll
        for (int k = 0; k < 64; ++k) S[k] = sp[k * 64];
    }
    float* yraw = (float*)(a.ws + WS_XB) + (size_t)mixer * TT * 256;
    const int ch = h * 64 + lane;
    float cq[4], ck[4], cv[4], mur = 0.f, muk = 0.f, muv = 0.f, kkw = 0.f, kaw = 0.f, rkw = 0.f, alog = 0.f, dtb = 0.f;
    if (mixer == 0) {
#pragma unroll
        for (int k = 0; k < 4; ++k) { const float* cw = a.in[I_BCW] + ((size_t)l * 4 + k) * 768; cq[k] = cw[ch]; ck[k] = cw[256 + ch]; cv[k] = cw[512 + ch]; }
        alog = a.in[I_BAL][l * 4 + h]; dtb = a.in[I_BDT][l * 4 + h];
    } else {
#pragma unroll
        for (int k = 0; k < 4; ++k) { cq[k] = 0.f; ck[k] = 0.f; cv[k] = 0.f; }
        const float* mu = a.in[I_CMU] + l * 1024; mur = mu[ch]; muk = mu[256 + ch]; muv = mu[512 + ch];
        kkw = a.in[I_CKK][l * 256 + ch]; kaw = a.in[I_CKA][l * 256 + ch]; rkw = a.in[I_CRK][l * 256 + ch];
    }
    float xq[7], xk[7], xv[7];
    if (mixer == 0) {
        const float* sb = a.in[I_SBC] + ((size_t)l * 128 + b) * 3 * 768;
#pragma unroll
        for (int j = 0; j < 3; ++j) { xq[j] = sb[j * 768 + ch]; xk[j] = sb[j * 768 + 256 + ch]; xv[j] = sb[j * 768 + 512 + ch]; }
#pragma unroll
        for (int j = 0; j < 4; ++j) { const bf16* pr = P + (size_t)(row0 + j) * PN + PC_BQ; xq[3 + j] = bf2f(pr[ch]); xk[3 + j] = bf2f(pr[256 + ch]); xv[3 + j] = bf2f(pr[512 + ch]); }
    } else {
        const float* sc = a.in[I_SCS] + ((size_t)l * 128 + b) * 1024;
        xq[0] = 0.f; xk[0] = 0.f; xv[0] = 0.f; xq[1] = 0.f; xk[1] = 0.f; xv[1] = 0.f;
        xq[2] = sc[ch]; xk[2] = sc[256 + ch]; xv[2] = sc[512 + ch];
#pragma unroll
        for (int j = 0; j < 4; ++j) { const bf16* pr = P + (size_t)(row0 + j) * PN + PC_C; xq[3 + j] = bf2f(pr[ch]); xk[3 + j] = bf2f(pr[256 + ch]); xv[3 + j] = bf2f(pr[512 + ch]); }
    }
#pragma unroll
    for (int t = 0; t < 4; ++t) {
        const int row = row0 + t;
        float r, w, k, kk, bb, v;
        if (mixer == 0) {
            const float q0 = silu(xq[t] * cq[0] + xq[t + 1] * cq[1] + xq[t + 2] * cq[2] + xq[t + 3] * cq[3]);
            const float k0 = silu(xk[t] * ck[0] + xk[t + 1] * ck[1] + xk[t + 2] * ck[2] + xk[t + 3] * ck[3]);
            v = silu(xv[t] * cv[0] + xv[t + 1] * cv[1] + xv[t + 2] * cv[2] + xv[t + 3] * cv[3]);
            const float iq = rsqrtf(wave_sum(q0 * q0) + 1e-6f) * 0.125f, ik = rsqrtf(wave_sum(k0 * k0) + 1e-6f);
            const float* ba = (const float*)(a.ws + WS_BA) + (size_t)row * 8;
            const float beta = sigm(ba[h]);
            const float dec = __expf(-__expf(alog) * softplus_(ba[4 + h] + dtb));
            const float kn = k0 * ik; r = q0 * iq; w = dec; kk = kn; k = beta * kn; bb = dec * beta * kn;
        } else {
            r = xq[3 + t] + (xq[2 + t] - xq[3 + t]) * mur;
            const float kx = xk[3 + t] + (xk[2 + t] - xk[3 + t]) * muk;
            v = xv[3 + t] + (xv[2 + t] - xv[3 + t]) * muv;
            w = ((const float*)(a.ws + WS_AUXW))[(size_t)row * 256 + ch];
            const float av = bf2f(((const bf16*)(a.ws + WS_AUXA))[(size_t)row * 256 + ch]);
            const float kr = kx * kkw;
            kk = kr * rsqrtf(wave_sum(kr * kr) + 1e-6f);
            k = kx * (1.f + (av - 1.f) * kaw); bb = kk * av;
            const float rk = wave_sum(r * k * rkw);
            if (lane == 0) ((float*)(a.ws + WS_RK))[(size_t)row * 4 + h] = rk;
        }
        wl[lane] = r; wl[64 + lane] = w; wl[128 + lane] = k; wl[192 + lane] = kk; wl[256 + lane] = bb;
        LDS_WAIT();
        float sk = 0.f;
#pragma unroll
        for (int k4 = 0; k4 < 16; ++k4) { const float4 x = *(const float4*)(wl + 192 + 4 * k4); sk += (x.x * S[4 * k4] + x.y * S[4 * k4 + 1]) + (x.z * S[4 * k4 + 2] + x.w * S[4 * k4 + 3]); }
        float y = 0.f;
#pragma unroll
        for (int k4 = 0; k4 < 16; ++k4) {
            const float4 ww = *(const float4*)(wl + 64 + 4 * k4), kx4 = *(const float4*)(wl + 128 + 4 * k4), b4 = *(const float4*)(wl + 256 + 4 * k4), r4 = *(const float4*)(wl + 4 * k4);
            S[4 * k4 + 0] = ww.x * S[4 * k4 + 0] + (kx4.x * v - b4.x * sk); S[4 * k4 + 1] = ww.y * S[4 * k4 + 1] + (kx4.y * v - b4.y * sk);
            S[4 * k4 + 2] = ww.z * S[4 * k4 + 2] + (kx4.z * v - b4.z * sk); S[4 * k4 + 3] = ww.w * S[4 * k4 + 3] + (kx4.w * v - b4.w * sk);
            y += (r4.x * S[4 * k4 + 0] + r4.y * S[4 * k4 + 1]) + (r4.z * S[4 * k4 + 2] + r4.w * S[4 * k4 + 3]);
        }
        yraw[(size_t)row * 256 + ch] = y;
        LDS_WAIT();
    }
    {
        float* sp = a.out + (mixer ? O_SCW : O_SBS) + (((size_t)l * 128 + b) * 4 + h) * 4096 + lane;
#pragma unroll
        for (int k = 0; k < 64; ++k) sp[k * 64] = S[k];
    }
}

__device__ __forceinline__ void phase_scan(const Args& a, int l, unsigned char* lds, int mode = 0) {
    const int tid = otid(), lane = tid & 63, wave = __builtin_amdgcn_readfirstlane(tid >> 6);
    const int G = gridDim.x, g = blockIdx.x;
    float* OB = (float*)lds;
    float* YB = OB + 2 * OPB_FLOATS + 512;
    float* CST = YB + 2 * 8192;
    const bool prod = wave >= 4; const int ptid = tid - 256;
    ChunkD cp = get_chunk(0, g, G, mode), c0 = cp, c1 = get_chunk(1, g, G, mode), c2 = get_chunk(2, g, G, mode);
    Raw RA, RB;
    f2 S01 = {0.f, 0.f}, S23 = {0.f, 0.f}; float Sn[4] = {0.f, 0.f, 0.f, 0.f};
    if (prod) { raw_load(a, l, c0, ptid, RA); prep_math(a, l, c0, RA, OB, CST, ptid); raw_load(a, l, c1, ptid, RA); }
    else if (c0.valid && c0.first && c0.sample) { const float* sp = state_in_ptr(a, l, c0, lane & 15, wave * 4 + (lane >> 4)); Sn[0] = sp[0]; Sn[1] = sp[64]; Sn[2] = sp[128]; Sn[3] = sp[192]; }
    __syncthreads();
    int idx = 0;
    while (c0.valid) {
        if (!prod) consume_chunk(a, l, c0, c1, OB + (idx & 1) * OPB_FLOATS, YB + (idx & 1) * 8192, S01, S23, Sn, wave, lane);
        else { raw_load(a, l, c2, ptid, RB); prep_math(a, l, c1, RA, OB + ((idx + 1) & 1) * OPB_FLOATS, CST, ptid); if (idx > 0) flush_y(a, cp, YB + ((idx - 1) & 1) * 8192, ptid); }
        __syncthreads();
        cp = c0; c0 = c1; c1 = c2; c2 = get_chunk(idx + 3, g, G, mode); ++idx;
        if (!c0.valid) break;
        if (!prod) consume_chunk(a, l, c0, c1, OB + (idx & 1) * OPB_FLOATS, YB + (idx & 1) * 8192, S01, S23, Sn, wave, lane);
        else { raw_load(a, l, c2, ptid, RA); prep_math(a, l, c1, RB, OB + ((idx + 1) & 1) * OPB_FLOATS, CST, ptid); flush_y(a, cp, YB + ((idx - 1) & 1) * 8192, ptid); }
        __syncthreads();
        cp = c0; c0 = c1; c1 = c2; c2 = get_chunk(idx + 3, g, G, mode); ++idx;
    }
    if (prod && idx > 0) flush_y(a, cp, YB + ((idx - 1) & 1) * 8192, ptid);
    __syncthreads();
    if (mode != 1) {
        float* wl = (float*)lds + wave * 320;
        if ((G & 1) == 0) { if (g & 1) for (int it = (g >> 1) * 8 + wave; it < 1024; it += (G >> 1) * 8) sample_item(a, l, it, wl, lane); }
        else for (int it = g * 8 + wave; it < 1024; it += G * 8) sample_item(a, l, it, wl, lane);
        __syncthreads();
    }
}

__device__ __forceinline__ void phase_post(const Args& a, int l) {
    const int tid = otid(), lane = tid & 63, wave = tid >> 6;
    const int gw = blockIdx.x * 8 + wave, NGW = gridDim.x * 8;
    const bf16* P = (const bf16*)(a.ws + WS_P);
    bf16* mixed = (bf16*)(a.ws + WS_MIXED);
    const float* yraw = (const float*)(a.ws + WS_XB);
    const int h = lane >> 4, col = lane * 4;
    for (int r = gw; r < TT; r += NGW) {
        const bf16* Prow = P + (size_t)r * PN;
        {
            const float4 o = *(const float4*)(yraw + (size_t)r * 256 + col);
            const float ss = sum16((o.x * o.x + o.y * o.y) + (o.z * o.z + o.w * o.w));
            const float rstd = rsqrtf(ss * (1.f / 64.f) + NORM_EPS);
            float gt[4]; ld4(Prow + PC_BG + col, gt);
            const float* on = a.in[I_BON] + l * 64 + (col & 63);
            uint2 w; w.x = pk2(o.x * rstd * on[0] * silu(gt[0]), o.y * rstd * on[1] * silu(gt[1])); w.y = pk2(o.z * rstd * on[2] * silu(gt[2]), o.w * rstd * on[3] * silu(gt[3]));
            *(uint2*)(mixed + (size_t)r * 1024 + 256 + col) = w;
        }
        {
            const float4 y = *(const float4*)(yraw + (size_t)TT * 256 + (size_t)r * 256 + col);
            const float mean = sum16((y.x + y.y) + (y.z + y.w)) * (1.f / 64.f);
            const float d0 = y.x - mean, d1 = y.y - mean, d2 = y.z - mean, d3 = y.w - mean;
            const float var = sum16((d0 * d0 + d1 * d1) + (d2 * d2 + d3 * d3)) * (1.f / 64.f);
            const float rstd = rsqrtf(var + 64e-5f);
            float vc[4], vp[4], gg[4]; ld4(Prow + PC_C + 512 + col, vc); prev_c<4>(a, l, r, 512 + col, vp);
            ld4((const bf16*)(a.ws + WS_AUXG) + (size_t)r * 256 + col, gg);
            const float* mu = a.in[I_CMU] + l * 1024 + 512 + col;
            const float* lg = a.in[I_CLG] + l * 256 + col; const float* lb = a.in[I_CLB] + l * 256 + col;
            const float rk = ((const float*)(a.ws + WS_RK))[(size_t)r * 4 + h];
            const float dd[4] = {d0, d1, d2, d3}; float o[4];
#pragma unroll
            for (int i = 0; i < 4; ++i) { const float v = vc[i] + (vp[i] - vc[i]) * mu[i]; o[i] = (dd[i] * rstd * lg[i] + lb[i] + rk * v) * gg[i]; }
            uint2 w; w.x = pk2(o[0], o[1]); w.y = pk2(o[2], o[3]);
            *(uint2*)(mixed + (size_t)r * 1024 + 512 + col) = w;
        }
    }
}

__device__ __forceinline__ void phase_final(const Args& a) {
    const int tid = otid(), lane = tid & 63, wave = tid >> 6;
    const int gw = blockIdx.x * 8 + wave, NGW = gridDim.x * 8;
    const float* rss = (const float*)(a.ws + WS_ROWSS) + 4 * TT;
    for (int r = gw; r < TT; r += NGW) {
        const float rs = rsqrtf(rss[r] * (1.f / 1024.f) + NORM_EPS);
        float4* xo = (float4*)(a.out + (size_t)r * 1024);
#pragma unroll
        for (int j = 0; j < 4; ++j) { float4 v = xo[lane + 64 * j]; const float4 g = ((const float4*)a.in[I_FG])[lane + 64 * j]; v.x *= rs * g.x; v.y *= rs * g.y; v.z *= rs * g.z; v.w *= rs * g.w; xo[lane + 64 * j] = v; }
    }
}

#ifndef MK_PER_PHASE
#define MK_PER_PHASE 0
#endif
#ifndef USE_SKINNY
#define USE_SKINNY 0
#endif
constexpr int GM = USE_SKINNY ? T_P : TT;
#ifndef SCAN_PROBE_MODE
#define SCAN_PROBE_MODE 0
#endif
#ifndef PRE_PROBE_MODE
#define PRE_PROBE_MODE 0
#endif
#ifndef REP_P0
#define REP_P0 1
#endif
#ifndef REP_GIN
#define REP_GIN 1
#endif
#ifndef REP_PRE
#define REP_PRE 1
#endif
#ifndef REP_SCAN
#define REP_SCAN 1
#endif
#ifndef REP_POST
#define REP_POST 1
#endif
#ifndef REP_GUP
#define REP_GUP 1
#endif
__global__ void __launch_bounds__(512, 2) mk_fwd(Args a) {
    extern __shared__ __attribute__((aligned(16))) unsigned char lds[];
    cg::grid_group grid = cg::this_grid();
    const int lo = a.ph_lo, hi = a.ph_hi, G = gridDim.x;
    volatile LAS unsigned* bst = (volatile LAS unsigned*)((LAS unsigned char*)lds + (LDS_BYTES - 16));
    if (threadIdx.x < 4) bst[threadIdx.x] = 0u;
    __syncthreads();
    XcdBarrier xbar; xbar.bar = (unsigned*)(a.ws + WS_BAR); xbar.x = 0; xbar.st = nullptr;
    if (!MK_PER_PHASE) xbar = xcd_barrier_post((unsigned*)(a.ws + WS_BAR), bst);
#define IN(k) (lo <= (k) && (k) < hi)
#define SEAM(k) do { if (lo <= (k) && (k) + 1 < hi) { if ((k) == 0) grid.sync(); else xcd_barrier(xbar); } } while (0)
#define REPEAT(n) for (int rep_ = 0; rep_ < (n); ++rep_, (rep_ < (n) ? xcd_barrier(xbar) : (void)0))
    float* rowss = (float*)(a.ws + WS_ROWSS);
    bf16* xb = (bf16*)(a.ws + WS_XB); bf16* P = (bf16*)(a.ws + WS_P); bf16* mixed = (bf16*)(a.ws + WS_MIXED); bf16* hid = (bf16*)(a.ws + WS_HID);
    if (IN(0)) REPEAT(REP_P0) phase0(a, lds);
    SEAM(0);
    for (int l = 0; l < 2; ++l) {
        const int pb = 1 + 7 * l;
        const bf16* wb = (const bf16*)(a.ws + WS_W) + (size_t)l * WL_ELEMS;
        if (IN(pb + 0)) REPEAT(REP_GIN) {
            pg8::Gemm g{xb, wb + WOFF_IN, GM, NIN, 1024}; pg8::StaticOrder S; S.init(GM, NIN, G, (int)blockIdx.x);
            EpiScale<false> E{P, PN, rowss + (2 * l) * TT};
            pg8::gemm_phase<EpiScale<false>, pg8::StaticOrder, true, true>((PG8_LAS unsigned char*)lds, g, S, E);
#if USE_SKINNY
            SkScale<false> E2{P, PN, rowss + (2 * l) * TT};
            skinny_gemm(xb + (size_t)T_P * 1024, wb + WOFF_IN, PN, 1024, E2);
#endif
        }
        SEAM(pb + 0);
        if (IN(pb + 1)) REPEAT(REP_PRE) phase_pre(a, l, lds, rep_ == 0 ? 0 : PRE_PROBE_MODE);
        SEAM(pb + 1);
        if (IN(pb + 2)) REPEAT(REP_SCAN) phase_scan(a, l, lds, rep_ == 0 ? 0 : SCAN_PROBE_MODE);
        SEAM(pb + 2);
        if (IN(pb + 3)) REPEAT(REP_POST) phase_post(a, l);
        SEAM(pb + 3);
        if (IN(pb + 4)) {
            pg8::Gemm g{mixed, wb + WOFF_OUT, GM, 1024, 1024};
            if (G == 256 && !USE_SKINNY && !MK_PER_PHASE) {
                DownOrder S; S.c = (int)blockIdx.x; S.snt = 2;
                EpiResSplit E{a.out, xb, rowss + (2 * l + 1) * TT, (float*)(a.ws + WS_AUXW)};
                pg8::gemm_phase<EpiResSplit, DownOrder, true, true>((PG8_LAS unsigned char*)lds, g, S, E);
                xcd_barrier(xbar);
                sample_fix(a, rowss + (2 * l + 1) * TT, (const float*)(a.ws + WS_AUXW));
            } else {
                pg8::StaticOrder S; S.init(GM, 1024, G, (int)blockIdx.x);
                EpiRes E{a.out, xb, rowss + (2 * l + 1) * TT};
                pg8::gemm_phase<EpiRes, pg8::StaticOrder, true, true>((PG8_LAS unsigned char*)lds, g, S, E);
#if USE_SKINNY
                SkRes E2{a.out, xb, rowss + (2 * l + 1) * TT};
                skinny_gemm(mixed + (size_t)T_P * 1024, wb + WOFF_OUT, 1024, 1024, E2);
#endif
            }
        }
        SEAM(pb + 4);
        if (IN(pb + 5)) REPEAT(REP_GUP) {
            pg8::Gemm g{xb, wb + WOFF_UP, GM, FF, 1024}; pg8::StaticOrder S; S.init(GM, FF, G, (int)blockIdx.x);
            EpiScale<true> E{hid, FF, rowss + (2 * l + 1) * TT};
            pg8::gemm_phase<EpiScale<true>, pg8::StaticOrder, true, true>((PG8_LAS unsigned char*)lds, g, S, E);
            if (l == 0 && !MK_PER_PHASE && G == 256 && blockIdx.x >= 32) {
                const int tid_ = otid();
                convert_layer(a, 1, (float*)(lds + (tid_ >> 6) * 16384), ((int)blockIdx.x - 32) * 8 + (tid_ >> 6), (G - 32) * 8, tid_ & 63);
            }
#if USE_SKINNY
            SkScale<true> E2{hid, FF, rowss + (2 * l + 1) * TT};
            skinny_gemm(xb + (size_t)T_P * 1024, wb + WOFF_UP, FF, 1024, E2);
#endif
        }
        SEAM(pb + 5);
        if (IN(pb + 6)) {
            pg8::Gemm g{hid, wb + WOFF_DOWN, GM, 1024, FF};
            if (G == 256 && !USE_SKINNY && !MK_PER_PHASE) {
                DownOrder S; S.c = (int)blockIdx.x; S.snt = 8;
                if (l == 1) {
                    EpiResFinal E{a.out, rowss + 4 * TT, (float*)(a.ws + WS_AUXW), a.in[I_FG], (unsigned*)(a.ws + WS_PCNT)};
                    pg8::gemm_phase<EpiResFinal, DownOrder, true, true>((PG8_LAS unsigned char*)lds, g, S, E);
                    xcd_barrier(xbar);
                    sample_fix_final(a, (const float*)(a.ws + WS_AUXW));
                } else {
                EpiResSplit E{a.out, xb, rowss + (2 * l + 2) * TT, (float*)(a.ws + WS_AUXW)};
                pg8::gemm_phase<EpiResSplit, DownOrder, true, true>((PG8_LAS unsigned char*)lds, g, S, E);
                xcd_barrier(xbar);
                sample_fix(a, rowss + (2 * l + 2) * TT, (const float*)(a.ws + WS_AUXW));
                }
            } else {
                pg8::StaticOrder S; S.init(GM, 1024, G, (int)blockIdx.x);
                EpiRes E{a.out, xb, rowss + (2 * l + 2) * TT};
                pg8::gemm_phase<EpiRes, pg8::StaticOrder, true, true>((PG8_LAS unsigned char*)lds, g, S, E);
#if USE_SKINNY
                SkRes E2{a.out, xb, rowss + (2 * l + 2) * TT};
                skinny_gemm(hid + (size_t)T_P * FF, wb + WOFF_DOWN, 1024, FF, E2);
#endif
            }
        }
        if (!(l == 1 && G == 256 && !USE_SKINNY && !MK_PER_PHASE)) SEAM(pb + 6);
    }
    if (IN(15) && !(G == 256 && !USE_SKINNY && !MK_PER_PHASE)) phase_final(a);
#undef IN
#undef SEAM
}

extern "C" void kernel_launch(void* const* d_in, const int* in_sizes, int n_in, void* d_out, int out_size, void* d_ws, size_t ws_size, hipStream_t stream) {
    static int grid = 0;
    if (grid == 0) {
        int dev = 0, cus = 0, per_cu = 0;
        (void)hipGetDevice(&dev);
        (void)hipDeviceGetAttribute(&cus, hipDeviceAttributeMultiprocessorCount, dev);
        if (hipFuncSetAttribute((const void*)mk_fwd, hipFuncAttributeMaxDynamicSharedMemorySize, LDS_BYTES) != hipSuccess) { fprintf(stderr, "kernel_launch: hipFuncSetAttribute failed\n"); }
        if (hipOccupancyMaxActiveBlocksPerMultiprocessor(&per_cu, (const void*)mk_fwd, 512, LDS_BYTES) != hipSuccess || per_cu < 1) { fprintf(stderr, "kernel_launch: occupancy query reports %d\n", per_cu); per_cu = 1; }
        (void)hipGetLastError();
        if (per_cu > 1) per_cu = 1;
        if (cus <= 0) cus = 256;
        grid = cus * per_cu;
    }
    Args a{};
    for (int i = 0; i < 34; ++i) a.in[i] = (const float*)d_in[i];
    a.out = (float*)d_out; a.ws = (unsigned char*)d_ws;
    (void)hipMemsetAsync((unsigned char*)d_ws + WS_BAR, 0, BAR_ZERO_BYTES, stream);
#if MK_PER_PHASE
    for (int ph = 0; ph < NPHASE; ++ph) { a.ph_lo = ph; a.ph_hi = ph + 1; hipLaunchKernelGGL(mk_fwd, dim3(grid), dim3(512), LDS_BYTES, stream, a); }
#else
    a.ph_lo = 0; a.ph_hi = NPHASE;
    void* args[] = {&a};
    const hipError_t e = hipLaunchCooperativeKernel((const void*)mk_fwd, dim3(grid), dim3(512), args, LDS_BYTES, stream);
    if (e != hipSuccess) fprintf(stderr, "cooperative launch failed: %s (grid %d)\n", hipGetErrorString(e), grid);
#endif
}
```

```cpp
#include <hip/hip_runtime.h>
#include <hip/hip_cooperative_groups.h>
#include <cstdio>
#include <cstdint>
namespace cg = cooperative_groups;
#define MK_PER_PHASE 0
namespace pg8 {
#define PG8_LAS __attribute__((address_space(3)))
typedef unsigned short bf16_t;
typedef short bf16x8 __attribute__((ext_vector_type(8)));
typedef float f32x4 __attribute__((ext_vector_type(4)));
typedef unsigned u32x4 __attribute__((ext_vector_type(4)));
constexpr int BM = 256, BK = 64, HALF = 128, HTB = HALF * BK * 2  , STAGE_BYTES = 8 * HTB, NXCD = 8, WGM = 8;

__host__ __device__ __forceinline__ int lds_byte(int r, int c) { const int st = (r >> 4) * 2 + (c >> 5), rr = r & 15, cc = c & 31, ob = rr * 64 + cc * 2; return st * 1024 + (ob ^ (((ob >> 9) & 1) << 5)); }
__host__ __device__ __forceinline__ void stage_rc(int b, int& R, int& C) { const int st = b / 1024, sb = b % 1024, swz = sb ^ (((sb >> 9) & 1) << 5); R = (st >> 1) * 16 + swz / 64; C = (st & 1) * 32 + (swz % 64) / 2; }
__host__ __device__ __forceinline__ int perm32(int rho) { const int n = rho >> 4, i = rho & 15; return 8 * (i >> 2) + 4 * n + (i & 3); }

struct Unit { int pm, pn, kofs, nt, part; };
struct Gemm { const bf16_t* A; const bf16_t* Bt; int M, N, K; };

struct StaticOrder {
    int nM, nN, nwg, G, c;
    __host__ __device__ void init(int M, int N, int G_, int c_) { nM = M / BM; nN = N / BM; nwg = nM * nN; G = G_; c = c_; }
    __host__ __device__ bool next(int i, Unit& u) const {
        const long L = (long)i * G + c; if (L >= nwg) return false;
        int wgid = (int)L; { const int q = nwg / NXCD, r = nwg % NXCD, xcd = wgid % NXCD, off = wgid / NXCD; wgid = (xcd < r ? xcd * (q + 1) : r * (q + 1) + (xcd - r) * q) + off; }
        const int nig = WGM * nN, gid = wgid / nig, fm = gid * WGM, gsz = (nM - fm) < WGM ? (nM - fm) : WGM;
        u.pm = fm + ((wgid % nig) % gsz); u.pn = (wgid % nig) / gsz; u.kofs = 0; u.nt = 0; u.part = -1; return true;
    }
    __device__ __forceinline__ void a_ready(const Unit&) const {}
    __device__ __forceinline__ void done(const Unit&) const {}
};

__device__ __forceinline__ unsigned cvt_pk_bf16(float lo, float hi) { unsigned r; asm volatile("v_cvt_pk_bf16_f32 %0, %1, %2" : "=v"(r) : "v"(lo), "v"(hi)); return r; }
typedef float f32x2 __attribute__((ext_vector_type(2)));
template <class Epi, class Sched, bool ALIGN_EPI = false, bool SP2 = false>
__device__ __forceinline__ void gemm_phase(PG8_LAS unsigned char* lds, const Gemm g, const Sched& S, const Epi& E) {
    int tid_ = threadIdx.x; asm volatile("" : "+v"(tid_)); const int tid = tid_, wid = __builtin_amdgcn_readfirstlane(tid >> 6), lane = tid & 63, wr = wid >> 2, wc = wid & 3, fr = lane & 15, fq = lane >> 4;
    const int K = g.K, nt = K / BK;
    unsigned voffA[2], voffB[2];
#pragma unroll
    for (int i = 0; i < 2; ++i) { int R, C; stage_rc(tid * 16 + i * 8192, R, C); const int Rb = Epi::PERM ? ((R & ~31) + perm32(R & 31)) : R;
        voffA[i] = (unsigned)(R * K + C) * 2u; voffB[i] = (unsigned)(Rb * K + C) * 2u; }
    const size_t kstep = (size_t)(BK * 2);
    const size_t hstep = (size_t)HALF * K * 2;
    const size_t tstep = 2 * hstep;
    const unsigned ldsw = (unsigned)wid * 1024u;
    const int aoff = lds_byte(wr * 64 + fr, fq * 8), boff = lds_byte(wc * 32 + fr, fq * 8);
#define PG8_SA(b, h) (((b) * 2 + (h)) * HTB)
#define PG8_SB(b, h) ((4 + (b) * 2 + (h)) * HTB)
#define PG8_STAGE(bufoff, gbase, voff) do { _Pragma("unroll") for (int _i = 0; _i < 2; ++_i) \
        __builtin_amdgcn_global_load_lds((const unsigned*)((const char*)(gbase) + (voff)[_i]), (PG8_LAS unsigned*)(lds + (bufoff) + ldsw + _i * 8192), 16, 0, 0); } while (0)
#define PG8_LDA(dst, b, h) do { _Pragma("unroll") for (int m = 0; m < 4; ++m) _Pragma("unroll") for (int k = 0; k < 2; ++k) dst[m][k] = *(const PG8_LAS bf16x8*)(lds + PG8_SA(b, h) + aoff + m * 2048 + k * 1024); } while (0)
#define PG8_LDB(dst, b, h) do { _Pragma("unroll") for (int n = 0; n < 2; ++n) _Pragma("unroll") for (int k = 0; k < 2; ++k) dst[n][k] = *(const PG8_LAS bf16x8*)(lds + PG8_SB(b, h) + boff + n * 2048 + k * 1024); } while (0)
#define PG8_MMA(ai, bj, At, Bt) do { __builtin_amdgcn_s_setprio(1); _Pragma("unroll") for (int m = 0; m < 4; ++m) _Pragma("unroll") for (int n = 0; n < 2; ++n) _Pragma("unroll") for (int k = 0; k < 2; ++k) \
        acc[ai][bj][m][n] = __builtin_amdgcn_mfma_f32_16x16x32_bf16(Bt[n][k], At[m][k], acc[ai][bj][m][n], 0, 0, 0); __builtin_amdgcn_s_setprio(0); } while (0)
#define PG8_WAIT_V(n) asm volatile("s_waitcnt vmcnt(" #n ")" ::: "memory")
#define PG8_WAIT_L(n) asm volatile("s_waitcnt lgkmcnt(" #n ")" ::: "memory")
#define PG8_BAR __builtin_amdgcn_s_barrier()
#define PG8_SCHED __builtin_amdgcn_sched_barrier(0)
    Unit cur, nxt; int ui = 0;
    if (!S.next(0, cur)) return;
    f32x4 acc[2][2][4][2];
#pragma unroll
    for (int a = 0; a < 2; ++a)
#pragma unroll
        for (int b = 0; b < 2; ++b)
#pragma unroll
            for (int m = 0; m < 4; ++m)
#pragma unroll
                for (int n = 0; n < 2; ++n) acc[a][b][m][n] = (f32x4){0.f, 0.f, 0.f, 0.f};
    bf16x8 At[4][2], B0[2][2], B1[2][2];
    const char* cA = (const char*)g.A + (size_t)cur.pm * tstep + cur.kofs; const char* cB = (const char*)g.Bt + (size_t)cur.pn * tstep + cur.kofs;
    S.a_ready(cur);
    if constexpr (SP2) {
        PG8_STAGE(PG8_SB(0, 0), cB, voffB); PG8_STAGE(PG8_SB(0, 1), cB + hstep, voffB); PG8_STAGE(PG8_SA(0, 0), cA, voffA); PG8_STAGE(PG8_SA(0, 1), cA + hstep, voffA);
        if (wr == 1) PG8_BAR;
        PG8_WAIT_V(2); PG8_BAR;
        PG8_STAGE(PG8_SB(1, 0), cB + kstep, voffB); PG8_STAGE(PG8_SA(1, 0), cA + kstep, voffA); PG8_STAGE(PG8_SB(1, 1), cB + hstep + kstep, voffB);
        PG8_WAIT_V(6); PG8_BAR;
    } else {
        PG8_STAGE(PG8_SB(0, 0), cB, voffB); PG8_STAGE(PG8_SA(0, 0), cA, voffA); PG8_STAGE(PG8_SB(0, 1), cB + hstep, voffB); PG8_STAGE(PG8_SA(0, 1), cA + hstep, voffA);
        if (wr == 1) PG8_BAR;
        PG8_WAIT_V(4); PG8_BAR;
        PG8_STAGE(PG8_SB(1, 0), cB + kstep, voffB); PG8_STAGE(PG8_SA(1, 0), cA + kstep, voffA); PG8_STAGE(PG8_SB(1, 1), cB + hstep + kstep, voffB);
        PG8_WAIT_V(6); PG8_BAR;
    }
    for (;;) {
        const bool has_next = S.next(ui + 1, nxt);
        const char* nA = has_next ? (const char*)g.A + (size_t)nxt.pm * tstep + nxt.kofs : cA; const char* nB = has_next ? (const char*)g.Bt + (size_t)nxt.pn * tstep + nxt.kofs : cB;
        const int cnt = cur.nt ? cur.nt : nt;
        for (int t = 0; t < cnt; t += 2) {
            const bool last = (t == cnt - 2);
            const char* a1 = cA + (size_t)(t + 1) * kstep;
            const char* a2 = last ? nA : cA + (size_t)(t + 2) * kstep; const char* b2 = last ? nB : cB + (size_t)(t + 2) * kstep;
            const char* a3 = a2 + kstep; const char* b3 = b2 + kstep;
            if (last && has_next) S.a_ready(nxt);
            if constexpr (SP2) {
            PG8_LDB(B0, 0, 0); PG8_LDB(B1, 0, 1); PG8_SCHED; PG8_LDA(At, 0, 0); PG8_STAGE(PG8_SA(1, 1), a1 + hstep, voffA);
            PG8_WAIT_V(8); PG8_WAIT_L(0); PG8_BAR; PG8_MMA(0, 0, At, B0); PG8_MMA(0, 1, At, B1); PG8_BAR; PG8_SCHED;
            PG8_LDA(At, 0, 1); PG8_STAGE(PG8_SB(0, 0), b2, voffB); PG8_STAGE(PG8_SB(0, 1), b2 + hstep, voffB); PG8_STAGE(PG8_SA(0, 0), a2, voffA);
            PG8_WAIT_V(8); PG8_WAIT_L(0); PG8_BAR; PG8_MMA(1, 0, At, B0); PG8_MMA(1, 1, At, B1); PG8_BAR; PG8_SCHED;
            PG8_LDB(B0, 1, 0); PG8_LDB(B1, 1, 1); PG8_SCHED; PG8_LDA(At, 1, 0); PG8_STAGE(PG8_SA(0, 1), a2 + hstep, voffA);
            PG8_WAIT_V(8); PG8_WAIT_L(0); PG8_BAR; PG8_MMA(0, 0, At, B0); PG8_MMA(0, 1, At, B1); PG8_BAR; PG8_SCHED;
            PG8_LDA(At, 1, 1); PG8_STAGE(PG8_SB(1, 0), b3, voffB); PG8_STAGE(PG8_SB(1, 1), b3 + hstep, voffB); PG8_STAGE(PG8_SA(1, 0), a3, voffA);
            PG8_WAIT_V(8); PG8_WAIT_L(0); PG8_BAR; PG8_MMA(1, 0, At, B0); PG8_MMA(1, 1, At, B1); PG8_BAR; PG8_SCHED;
            } else {
            PG8_LDB(B0, 0, 0); PG8_SCHED; PG8_LDA(At, 0, 0); PG8_STAGE(PG8_SA(1, 1), a1 + hstep, voffA);
            PG8_WAIT_L(8); PG8_BAR; PG8_WAIT_L(0); PG8_MMA(0, 0, At, B0); PG8_BAR; PG8_SCHED;
            PG8_LDB(B1, 0, 1); PG8_STAGE(PG8_SB(0, 0), b2, voffB);
            PG8_BAR; PG8_WAIT_L(0); PG8_MMA(0, 1, At, B1); PG8_BAR;
            PG8_LDA(At, 0, 1); PG8_STAGE(PG8_SA(0, 0), a2, voffA);
            PG8_BAR; PG8_WAIT_L(0); PG8_MMA(1, 0, At, B0); PG8_BAR; PG8_SCHED;
            PG8_STAGE(PG8_SB(0, 1), b2 + hstep, voffB);
            PG8_WAIT_V(6); PG8_BAR; PG8_MMA(1, 1, At, B1); PG8_BAR;
            PG8_LDB(B0, 1, 0); PG8_SCHED; PG8_LDA(At, 1, 0); PG8_STAGE(PG8_SA(0, 1), a2 + hstep, voffA);
            PG8_WAIT_L(8); PG8_BAR; PG8_WAIT_L(0); PG8_MMA(0, 0, At, B0); PG8_BAR; PG8_SCHED;
            PG8_LDB(B1, 1, 1); PG8_STAGE(PG8_SB(1, 0), b3, voffB);
            PG8_BAR; PG8_WAIT_L(0); PG8_MMA(0, 1, At, B1); PG8_BAR;
            PG8_LDA(At, 1, 1); PG8_STAGE(PG8_SA(1, 0), a3, voffA);
            PG8_BAR; PG8_WAIT_L(0); PG8_MMA(1, 0, At, B0); PG8_BAR; PG8_SCHED;
            PG8_STAGE(PG8_SB(1, 1), b3 + hstep, voffB);
            PG8_WAIT_V(6); PG8_BAR; PG8_MMA(1, 1, At, B1); PG8_BAR;
            }
        }
        if constexpr (ALIGN_EPI) { if (wr == 0) PG8_BAR; }
        if constexpr (!Epi::AFTER_DRAIN) { E(acc, cur, wr, wc, fr, fq); S.done(cur); }
        if (!has_next) break;
#pragma unroll
        for (int a = 0; a < 2; ++a)
#pragma unroll
            for (int b = 0; b < 2; ++b)
#pragma unroll
                for (int m = 0; m < 4; ++m)
#pragma unroll
                    for (int n = 0; n < 2; ++n) acc[a][b][m][n] = (f32x4){0.f, 0.f, 0.f, 0.f};
        cur = nxt; cA = nA; cB = nB; ++ui;
        if constexpr (ALIGN_EPI) { if (wr == 1) PG8_BAR; }
    }
    PG8_WAIT_V(0);
    if constexpr (!ALIGN_EPI) { if (wr == 0) PG8_BAR; }
    PG8_BAR;
    if constexpr (Epi::AFTER_DRAIN) { E.fused(acc, cur, wr, wc, fr, fq, lds, wid, lane); S.done(cur); }
#undef PG8_SA
#undef PG8_SB
#undef PG8_STAGE
#undef PG8_LDA
#undef PG8_LDB
#undef PG8_MMA
#undef PG8_WAIT_V
#undef PG8_WAIT_L
#undef PG8_BAR
#undef PG8_SCHED
}
}

#define LAS __attribute__((address_space(3)))

#define XB_TMO      128
#define XB_XCNT(j)  (256  + 64 * (j))
#define XB_XSUB(j)  (1280 + 64 * (j))
#define XB_XGEN(j)  (2304 + 64 * (j))
#define XB_TOP      3328
#define XB_TOPGEN   3392
#define XCD_BAR_WORDS 3456
#define XB_SPIN_CAP (1u << 18)

__device__ __forceinline__ unsigned xb_ld(unsigned* p)              { return __hip_atomic_load(p, __ATOMIC_RELAXED, __HIP_MEMORY_SCOPE_AGENT); }
__device__ __forceinline__ unsigned xb_add(unsigned* p, unsigned v) { return __hip_atomic_fetch_add(p, v, __ATOMIC_RELAXED, __HIP_MEMORY_SCOPE_AGENT); }
__device__ __forceinline__ unsigned xb_xcc_id() { return (unsigned)__builtin_amdgcn_s_getreg((3 << 11) | 20) & 0xFu; }
#define XB_SPIN(cond, bar) do { unsigned _sp = 0; while (cond) { __builtin_amdgcn_s_sleep(1); \
    if ((++_sp & 255u) == 0u) { if (xb_ld(&(bar)[XB_TMO])) break; if (_sp > XB_SPIN_CAP) { atomicAdd(&(bar)[XB_TMO], 1u); break; } } } } while (0)

struct XcdBarrier {
    unsigned* bar; unsigned x;
    volatile LAS unsigned* st;
};

__device__ __forceinline__ XcdBarrier xcd_barrier_post(unsigned* bar, volatile LAS unsigned* st) {
    XcdBarrier b; b.bar = bar; b.x = xb_xcc_id(); b.st = st;
    if (threadIdx.x == 0) (void)xb_add(&bar[XB_XCNT(b.x)], 1u);
    return b;
}
__device__ __forceinline__ void xcd_barrier_complete(unsigned* bar, unsigned x, unsigned& nloc, unsigned& nx) {
    const unsigned G = gridDim.x * gridDim.y * gridDim.z;
    unsigned sum, cnt, mine, sp = 0u;
    for (;;) {
        sum = 0u; cnt = 0u; mine = 0u;
#pragma unroll
        for (unsigned j = 0; j < 16; ++j) { const unsigned c = xb_ld(&bar[XB_XCNT(j)]); sum += c; cnt += (c > 0u) ? 1u : 0u; mine = (j == x) ? c : mine; }
        if (sum == G) break;
        __builtin_amdgcn_s_sleep(1);
        if ((++sp & 255u) == 0u) { if (xb_ld(&bar[XB_TMO])) break; if (sp > XB_SPIN_CAP) { atomicAdd(&bar[XB_TMO], 1u); break; } }
    }
    nloc = mine > 0u ? mine : 1u; nx = cnt > 0u ? cnt : 1u;
}

__device__ __forceinline__ void xcd_barrier(const XcdBarrier& b) {
    asm volatile("s_waitcnt vmcnt(0)" ::: "memory");
    __syncthreads();
    if (threadIdx.x == 0) {
        unsigned* bar = b.bar;
        __builtin_amdgcn_s_waitcnt(0);
        unsigned nloc = b.st[0], nx = b.st[1];
        if (nloc == 0u) { xcd_barrier_complete(bar, b.x, nloc, nx); b.st[0] = nloc; b.st[1] = nx; }
        const unsigned old = xb_add(&bar[XB_XSUB(b.x)], 1u);
        const unsigned gen = old / nloc;
        if (old + 1u == (gen + 1u) * nloc) {
            __builtin_amdgcn_fence(__ATOMIC_RELEASE, "agent");
            asm volatile("s_waitcnt vmcnt(0)" ::: "memory");
            const unsigned og = xb_add(&bar[XB_TOP], 1u);
            const unsigned tg = og / nx;
            if (og + 1u == (tg + 1u) * nx) xb_add(&bar[XB_TOPGEN], 1u);
            else XB_SPIN(xb_ld(&bar[XB_TOPGEN]) == tg, bar);
            __builtin_amdgcn_fence(__ATOMIC_ACQUIRE, "agent");
            xb_add(&bar[XB_XGEN(b.x)], 1u);
            asm volatile("s_waitcnt vmcnt(0)" ::: "memory");
        } else {
            XB_SPIN(xb_ld(&bar[XB_XGEN(b.x)]) == gen, bar);
            __builtin_amdgcn_fence(__ATOMIC_ACQUIRE, "agent");
            asm volatile("s_waitcnt vmcnt(0)" ::: "memory");
        }
    }
    __syncthreads();
}

typedef unsigned short bf16;
typedef pg8::f32x4 f32x4;
typedef pg8::u32x4 u32x4;
constexpr int DM = 1024, T_P = 16384, T_S = 512, TT = 16896, PN = 3072, NIN = 2816, FF = 4096;
constexpr float NORM_EPS = 1e-6f;
constexpr int PC_A = 0, PC_BQ = 512, PC_BK = 768, PC_BV = 1024, PC_BG = 1280, PC_C = 1536, PC_D = 2560, PC_BA = 2816;
constexpr size_t MiB = 1u << 20;
constexpr size_t WS_ROWSS = 0;
constexpr size_t WS_RK = 512 * 1024;
constexpr size_t WS_BAR = 800 * 1024;
constexpr size_t WS_PCNT = WS_BAR + 14336;
constexpr size_t BAR_ZERO_BYTES = 14336 + 64 * 256;
constexpr size_t WS_W = 1 * MiB;
constexpr size_t WS_XB = 49 * MiB;
constexpr size_t WS_P = 82 * MiB;
constexpr size_t WS_MIXED = 181 * MiB;
constexpr size_t WS_HID = 82 * MiB;
constexpr size_t WS_AUXW = 214 * MiB;
constexpr size_t WS_AUXA = WS_AUXW + (size_t)TT * 256 * 4;
constexpr size_t WS_AUXG = WS_AUXA + (size_t)TT * 256 * 2;
constexpr size_t WS_LW = WS_AUXG + (size_t)TT * 256 * 2;
constexpr size_t WS_BAW = WS_LW + 2 * 81920 * 2;
constexpr size_t WS_BA = WS_BAW + 2 * 16 * 1024 * 2;
constexpr size_t WS_END = WS_BA + (size_t)TT * 8 * 4;
static_assert(WS_END <= 256 * MiB, "ws map");
constexpr size_t WOFF_IN = 0, WOFF_OUT = 3145728, WOFF_UP = 4194304, WOFF_DOWN = 8388608, WL_ELEMS = 12582912;
constexpr size_t O_YP = 0, O_YS = O_YP + (size_t)T_P * DM, O_PBC = O_YS + (size_t)T_S * DM, O_PBS = O_PBC + 2 * 8 * 3 * 768, O_PCS = O_PBS + 2 * 8 * 4 * 4096,
                 O_PCW = O_PCS + 2 * 8 * 1024, O_PDP = O_PCW + 2 * 8 * 4 * 4096, O_SAV = O_PDP + 2 * 8 * 15 * 256, O_SBC = O_SAV + 2 * 128 * 4 * 256,
                 O_SBS = O_SBC + 2 * 128 * 3 * 768, O_SCS = O_SBS + 2 * 128 * 4 * 4096, O_SCW = O_SCS + 2 * 128 * 1024, O_SDP = O_SCW + 2 * 128 * 4 * 4096,
                 O_END = O_SDP + 2 * 128 * 15 * 256;
static_assert(O_END == 28426240, "d_out map");
constexpr int LDS_BYTES = 163840;
constexpr int NPHASE = 16;

struct Args { const float* in[34]; float* out; unsigned char* ws; int ph_lo, ph_hi; };
enum { I_XP = 0, I_XS, I_SBC, I_SBS, I_SCS, I_SCW, I_SDP, I_N1G, I_WIN, I_AWS, I_ABS, I_AVG, I_BCW, I_BAL, I_BDT, I_BON, I_CMU, I_CW0, I_CW2, I_CA0, I_CA2, I_CG2,
       I_CKK, I_CKA, I_CRK, I_CLG, I_CLB, I_DW, I_DSC, I_WOUT, I_N2G, I_WUP, I_WDN, I_FG };

#define LDS_WAIT() asm volatile("s_waitcnt lgkmcnt(0)" ::: "memory")

__device__ __forceinline__ int otid() { int t = threadIdx.x; asm volatile("" : "+v"(t)); return t; }
__device__ __forceinline__ float bf2f(unsigned h) { return __uint_as_float(h << 16); }
__device__ __forceinline__ unsigned f2bf(float f) { unsigned u = __float_as_uint(f); return (u + 0x7fffu + ((u >> 16) & 1u)) >> 16; }
__device__ __forceinline__ unsigned pk2(float lo, float hi) { return f2bf(lo) | (f2bf(hi) << 16); }
__device__ __forceinline__ void ld8(const bf16* p, float (&o)[8]) {
    const uint4 u = *(const uint4*)p;
    o[0] = __uint_as_float(u.x << 16); o[1] = __uint_as_float(u.x & 0xffff0000u); o[2] = __uint_as_float(u.y << 16); o[3] = __uint_as_float(u.y & 0xffff0000u);
    o[4] = __uint_as_float(u.z << 16); o[5] = __uint_as_float(u.z & 0xffff0000u); o[6] = __uint_as_float(u.w << 16); o[7] = __uint_as_float(u.w & 0xffff0000u);
}
__device__ __forceinline__ void ld4(const bf16* p, float (&o)[4]) {
    const uint2 u = *(const uint2*)p;
    o[0] = __uint_as_float(u.x << 16); o[1] = __uint_as_float(u.x & 0xffff0000u); o[2] = __uint_as_float(u.y << 16); o[3] = __uint_as_float(u.y & 0xffff0000u);
}
__device__ __forceinline__ void ld2(const bf16* p, float (&o)[2]) { const unsigned u = *(const unsigned*)p; o[0] = __uint_as_float(u << 16); o[1] = __uint_as_float(u & 0xffff0000u); }
template <int N> __device__ __forceinline__ void ldbf(const bf16* p, float (&o)[N]);
template <> __device__ __forceinline__ void ldbf<8>(const bf16* p, float (&o)[8]) { ld8(p, o); }
template <> __device__ __forceinline__ void ldbf<4>(const bf16* p, float (&o)[4]) { ld4(p, o); }
template <> __device__ __forceinline__ void ldbf<2>(const bf16* p, float (&o)[2]) { ld2(p, o); }
template <> __device__ __forceinline__ void ldbf<1>(const bf16* p, float (&o)[1]) { o[0] = bf2f(*p); }
template <int N> __device__ __forceinline__ void ldf(const float* p, float (&o)[N]) {
#pragma unroll
    for (int i = 0; i < N; ++i) o[i] = p[i];
}
__device__ __forceinline__ float sigm(float x) { return __builtin_amdgcn_rcpf(1.f + __expf(-x)); }
__device__ __forceinline__ float silu(float x) { return x * sigm(x); }
__device__ __forceinline__ float tanh_(float y) { return 1.f - 2.f * __builtin_amdgcn_rcpf(1.f + __expf(2.f * y)); }
__device__ __forceinline__ float gelu_t(float x) { return 0.5f * x * (1.f + tanh_(0.7978845608028654f * (x + 0.044715f * x * x * x))); }
__device__ __forceinline__ float softplus_(float x) { const float u = __expf(-fabsf(x)); return fmaxf(x, 0.f) + (u < 1e-3f ? u * (1.f - 0.5f * u) : __logf(1.f + u)); }
__device__ __forceinline__ float wave_sum(float v) {
#pragma unroll
    for (int o = 1; o < 64; o <<= 1) v += __shfl_xor(v, o);
    return v;
}
__device__ __forceinline__ float sum8(float v) { v += __shfl_xor(v, 1); v += __shfl_xor(v, 2); v += __shfl_xor(v, 4); return v; }
__device__ __forceinline__ float sum16(float v) { v = sum8(v); v += __shfl_xor(v, 8); return v; }
__device__ __forceinline__ float dpp_sum16(float x) {
    x += __int_as_float(__builtin_amdgcn_update_dpp(0, __float_as_int(x), 0xB1, 0xF, 0xF, false));
    x += __int_as_float(__builtin_amdgcn_update_dpp(0, __float_as_int(x), 0x4E, 0xF, 0xF, false));
    x += __int_as_float(__builtin_amdgcn_update_dpp(0, __float_as_int(x), 0x141, 0xF, 0xF, false));
    x += __int_as_float(__builtin_amdgcn_update_dpp(0, __float_as_int(x), 0x140, 0xF, 0xF, false));
    return x;
}

template <bool RELU2> struct EpiScale {
    static constexpr bool PERM = true, AFTER_DRAIN = false;
    bf16* O; int ldc; const float* rss;
    __device__ __forceinline__ void operator()(const f32x4 (&acc)[2][2][4][2], const pg8::Unit& u, int wr, int wc, int fr, int fq) const {
        const int row0 = u.pm * 256 + wr * 64 + fr, col0 = u.pn * 256 + wc * 32 + 8 * fq;
#pragma unroll
        for (int ai = 0; ai < 2; ++ai)
#pragma unroll
            for (int m = 0; m < 4; ++m) {
                const int r = row0 + ai * 128 + m * 16;
                const float rs = rsqrtf(rss[r] * (1.f / 1024.f) + NORM_EPS);
                bf16* rowp = O + (size_t)r * ldc + col0;
#pragma unroll
                for (int bj = 0; bj < 2; ++bj) {
                    f32x4 v0 = acc[ai][bj][m][0] * rs, v1 = acc[ai][bj][m][1] * rs;
                    if (RELU2) {
#pragma unroll
                        for (int e = 0; e < 4; ++e) { const float p0 = fmaxf(v0[e], 0.f), p1 = fmaxf(v1[e], 0.f); v0[e] = p0 * p0; v1[e] = p1 * p1; }
                    }
                    u32x4 w; w.x = pg8::cvt_pk_bf16(v0[0], v0[1]); w.y = pg8::cvt_pk_bf16(v0[2], v0[3]); w.z = pg8::cvt_pk_bf16(v1[0], v1[1]); w.w = pg8::cvt_pk_bf16(v1[2], v1[3]);
                    *(u32x4*)(rowp + bj * 128) = w;
                }
            }
    }
};
struct EpiRes {
    static constexpr bool PERM = true, AFTER_DRAIN = false;
    float* X; bf16* XB; float* rss; const float* Sp; const float* Ss;
    __device__ __forceinline__ void operator()(const f32x4 (&acc)[2][2][4][2], const pg8::Unit& u, int wr, int wc, int fr, int fq) const {
        const int row0 = u.pm * 256 + wr * 64 + fr, col0 = u.pn * 256 + wc * 32 + 8 * fq;
#pragma unroll
        for (int ai = 0; ai < 2; ++ai)
#pragma unroll
            for (int m = 0; m < 4; ++m) {
                const int r = row0 + ai * 128 + m * 16;
                const float* srow = Sp ? (r < T_P ? Sp + (size_t)r * 1024 : Ss + (size_t)(r - T_P) * 1024) : X + (size_t)r * 1024;
                float ss = 0.f;
#pragma unroll
                for (int bj = 0; bj < 2; ++bj) {
                    float* xp = X + (size_t)r * 1024 + col0 + bj * 128;
                    const float* sp = srow + col0 + bj * 128;
                    const f32x4 x0 = *(const f32x4*)sp + acc[ai][bj][m][0], x1 = *(const f32x4*)(sp + 4) + acc[ai][bj][m][1];
                    *(f32x4*)xp = x0; *(f32x4*)(xp + 4) = x1;
                    u32x4 w; w.x = pg8::cvt_pk_bf16(x0[0], x0[1]); w.y = pg8::cvt_pk_bf16(x0[2], x0[3]); w.z = pg8::cvt_pk_bf16(x1[0], x1[1]); w.w = pg8::cvt_pk_bf16(x1[2], x1[3]);
                    *(u32x4*)(XB + (size_t)r * 1024 + col0 + bj * 128) = w;
                    ss += (x0[0] * x0[0] + x0[1] * x0[1]) + (x0[2] * x0[2] + x0[3] * x0[3]) + (x1[0] * x1[0] + x1[1] * x1[1]) + (x1[2] * x1[2] + x1[3] * x1[3]);
                }
                ss += __shfl_xor(ss, 16); ss += __shfl_xor(ss, 32);
                if (fq == 0) atomicAdd(rss + r, ss);
            }
    }
};

struct EpiResFinal {
    static constexpr bool PERM = true, AFTER_DRAIN = false;
    float* X; float* rss; float* part; const float* fg; unsigned* pcnt;
    __device__ __forceinline__ void operator()(const f32x4 (&acc)[2][2][4][2], const pg8::Unit& u, int wr, int wc, int fr, int fq) const {
        if (u.part >= 0) {
            const int row0 = (u.pm - 64) * 256 + wr * 64 + fr, col0 = u.pn * 256 + wc * 32 + 8 * fq;
            float* pp = part + (size_t)u.part * 512 * 1024;
#pragma unroll
            for (int ai = 0; ai < 2; ++ai)
#pragma unroll
                for (int m = 0; m < 4; ++m)
#pragma unroll
                    for (int bj = 0; bj < 2; ++bj) { float* xp = pp + (size_t)(row0 + ai * 128 + m * 16) * 1024 + col0 + bj * 128; *(f32x4*)xp = acc[ai][bj][m][0]; *(f32x4*)(xp + 4) = acc[ai][bj][m][1]; }
            return;
        }
        const int row0 = u.pm * 256 + wr * 64 + fr, col0 = u.pn * 256 + wc * 32 + 8 * fq;
        float dummy = 0.f;
#pragma unroll
        for (int ai = 0; ai < 2; ++ai)
#pragma unroll
            for (int m = 0; m < 4; ++m) {
                const int r = row0 + ai * 128 + m * 16;
                float ss = 0.f;
#pragma unroll
                for (int bj = 0; bj < 2; ++bj) {
                    const float* sp = X + (size_t)r * 1024 + col0 + bj * 128;
                    const f32x4 x0 = *(const f32x4*)sp + acc[ai][bj][m][0], x1 = *(const f32x4*)(sp + 4) + acc[ai][bj][m][1];
                    ss += (x0[0] * x0[0] + x0[1] * x0[1]) + (x0[2] * x0[2] + x0[3] * x0[3]) + (x1[0] * x1[0] + x1[1] * x1[1]) + (x1[2] * x1[2] + x1[3] * x1[3]);
                }
                ss += __shfl_xor(ss, 16); ss += __shfl_xor(ss, 32);
                if (fq == 0) dummy += atomicAdd(rss + r, ss);
            }
        asm volatile("s_waitcnt vmcnt(0)" :: "v"(dummy) : "memory");
        unsigned* cnt = pcnt + 64 * u.pm;
        if ((threadIdx.x & 63) == 0) __hip_atomic_fetch_add(cnt, 1u, __ATOMIC_RELAXED, __HIP_MEMORY_SCOPE_AGENT);
        { unsigned sp_ = 0; while (__hip_atomic_load(cnt, __ATOMIC_RELAXED, __HIP_MEMORY_SCOPE_AGENT) < 32u) { __builtin_amdgcn_s_sleep(2); if (++sp_ > (1u << 22)) break; } }
        asm volatile("" ::: "memory");
#pragma unroll
        for (int ai = 0; ai < 2; ++ai)
#pragma unroll
            for (int m = 0; m < 4; ++m) {
                const int r = row0 + ai * 128 + m * 16;
                const float rs = rsqrtf(__hip_atomic_load(rss + r, __ATOMIC_RELAXED, __HIP_MEMORY_SCOPE_AGENT) * (1.f / 1024.f) + NORM_EPS);
#pragma unroll
                for (int bj = 0; bj < 2; ++bj) {
                    float* xp = X + (size_t)r * 1024 + col0 + bj * 128;
                    const f32x4 g0 = *(const f32x4*)(fg + col0 + bj * 128), g1 = *(const f32x4*)(fg + col0 + bj * 128 + 4);
                    const f32x4 x0 = *(const f32x4*)xp + acc[ai][bj][m][0], x1 = *(const f32x4*)(xp + 4) + acc[ai][bj][m][1];
                    *(f32x4*)xp = x0 * rs * g0; *(f32x4*)(xp + 4) = x1 * rs * g1;
                }
            }
    }
};
__device__ __forceinline__ void sample_fix_final(const Args& a, const float* part) {
    const int tid = otid(), lane = tid & 63, wave = tid >> 6;
    for (int r = T_P + blockIdx.x * 8 + wave; r < TT; r += gridDim.x * 8) {
        float4* xi = (float4*)(a.out + (size_t)r * 1024);
        float4 v[4]; float ss = 0.f;
#pragma unroll
        for (int j = 0; j < 4; ++j) {
            v[j] = xi[lane + 64 * j];
#pragma unroll
            for (int s = 0; s < 8; ++s) { const float4 p = ((const float4*)(part + ((size_t)s * 512 + (r - T_P)) * 1024))[lane + 64 * j]; v[j].x += p.x; v[j].y += p.y; v[j].z += p.z; v[j].w += p.w; }
            ss += (v[j].x * v[j].x + v[j].y * v[j].y) + (v[j].z * v[j].z + v[j].w * v[j].w);
        }
        const float rs = rsqrtf(wave_sum(ss) * (1.f / 1024.f) + NORM_EPS);
#pragma unroll
        for (int j = 0; j < 4; ++j) { const float4 g = ((const float4*)a.in[I_FG])[lane + 64 * j]; float4 o = v[j]; o.x *= rs * g.x; o.y *= rs * g.y; o.z *= rs * g.z; o.w *= rs * g.w; xi[lane + 64 * j] = o; }
    }
}

struct DownOrder {
    int c, snt;
    __device__ __forceinline__ bool next(int i, pg8::Unit& u) const {
        if (i == 0) { const int v = (c & 7) * 32 + (c >> 3); u.pm = v >> 2; u.pn = v & 3; u.kofs = 0; u.nt = 0; u.part = -1; return true; }
        if (i == 1 && c < 64) { const int su = c >> 3, sl = c & 7; u.pm = 64 + (su >> 2); u.pn = su & 3; u.kofs = sl * snt * 64 * 2; u.nt = snt; u.part = sl; return true; }
        return false;
    }
    __device__ __forceinline__ void a_ready(const pg8::Unit&) const {}
    __device__ __forceinline__ void done(const pg8::Unit&) const {}
};
struct EpiResSplit {
    static constexpr bool PERM = true, AFTER_DRAIN = false;
    float* X; bf16* XB; float* rss; float* part; const float* Sp; const float* Ss;
    __device__ __forceinline__ void operator()(const f32x4 (&acc)[2][2][4][2], const pg8::Unit& u, int wr, int wc, int fr, int fq) const {
        if (u.part < 0) { EpiRes E{X, XB, rss, Sp, Ss}; E(acc, u, wr, wc, fr, fq); return; }
        const int row0 = (u.pm - 64) * 256 + wr * 64 + fr, col0 = u.pn * 256 + wc * 32 + 8 * fq;
        float* pp = part + (size_t)u.part * 512 * 1024;
#pragma unroll
        for (int ai = 0; ai < 2; ++ai)
#pragma unroll
            for (int m = 0; m < 4; ++m)
#pragma unroll
                for (int bj = 0; bj < 2; ++bj) {
                    float* xp = pp + (size_t)(row0 + ai * 128 + m * 16) * 1024 + col0 + bj * 128;
                    *(f32x4*)xp = acc[ai][bj][m][0]; *(f32x4*)(xp + 4) = acc[ai][bj][m][1];
                }
    }
};
__device__ __forceinline__ void sample_fix(const Args& a, float* rss, const float* part, const float* Ss = nullptr) {
    const int tid = otid(), lane = tid & 63, wave = tid >> 6;
    bf16* xb = (bf16*)(a.ws + WS_XB);
    for (int r = T_P + blockIdx.x * 8 + wave; r < TT; r += gridDim.x * 8) {
        float4* xi = (float4*)(a.out + (size_t)r * 1024);
        const float4* xs = Ss ? (const float4*)(Ss + (size_t)(r - T_P) * 1024) : (const float4*)xi;
        uint2* bo = (uint2*)(xb + (size_t)r * 1024);
        float ss = 0.f;
#pragma unroll
        for (int j = 0; j < 4; ++j) {
            float4 v = xs[lane + 64 * j];
#pragma unroll
            for (int s = 0; s < 8; ++s) { const float4 p = ((const float4*)(part + ((size_t)s * 512 + (r - T_P)) * 1024))[lane + 64 * j]; v.x += p.x; v.y += p.y; v.z += p.z; v.w += p.w; }
            xi[lane + 64 * j] = v;
            ss += (v.x * v.x + v.y * v.y) + (v.z * v.z + v.w * v.w); uint2 w; w.x = pk2(v.x, v.y); w.y = pk2(v.z, v.w); bo[lane + 64 * j] = w;
        }
        ss = wave_sum(ss);
        if (lane == 0) rss[r] = ss;
    }
}

template <class Epi> __device__ __forceinline__ void skinny_gemm(const bf16* __restrict__ A  , const bf16* __restrict__ Bt, int N, int K, const Epi& E) {
    const int tid = otid(), wave = tid >> 6, lane = tid & 63, fr = lane & 15, fq = lane >> 4;
    const int nN = N >> 7, nU = 8 * nN;
    for (int u = blockIdx.x; u < nU; u += gridDim.x) {
        const int mb = u / nN, nb = u - mb * nN, n0 = nb * 128 + wave * 16;
        const bf16* ap = A + (size_t)(mb * 64 + fr) * K + 8 * fq;
        const bf16* bp = Bt + (size_t)(n0 + fr) * K + 8 * fq;
        f32x4 acc[4];
#pragma unroll
        for (int m = 0; m < 4; ++m) acc[m] = (f32x4){0.f, 0.f, 0.f, 0.f};
#pragma unroll 4
        for (int k = 0; k < K; k += 32) {
            const pg8::bf16x8 bfr = *(const pg8::bf16x8*)(bp + k);
#pragma unroll
            for (int m = 0; m < 4; ++m) { const pg8::bf16x8 af = *(const pg8::bf16x8*)(ap + (size_t)m * 16 * K + k); acc[m] = __builtin_amdgcn_mfma_f32_16x16x32_bf16(bfr, af, acc[m], 0, 0, 0); }
        }
        E(acc, T_P + mb * 64 + fr, n0 + 4 * fq, fq);
    }
}
template <bool RELU2> struct SkScale {
    bf16* O; int ldc; const float* rss;
    __device__ __forceinline__ void operator()(const f32x4 (&acc)[4], int row, int col, int fq) const {
#pragma unroll
        for (int m = 0; m < 4; ++m) {
            const int r = row + 16 * m;
            const float rs = rsqrtf(rss[r] * (1.f / 1024.f) + NORM_EPS);
            f32x4 v = acc[m] * rs;
            if (RELU2) {
#pragma unroll
                for (int e = 0; e < 4; ++e) { const float p = fmaxf(v[e], 0.f); v[e] = p * p; }
            }
            uint2 w; w.x = pg8::cvt_pk_bf16(v[0], v[1]); w.y = pg8::cvt_pk_bf16(v[2], v[3]);
            *(uint2*)(O + (size_t)r * ldc + col) = w;
        }
    }
};
struct SkRes {
    float* X; bf16* XB; float* rss;
    __device__ __forceinline__ void operator()(const f32x4 (&acc)[4], int row, int col, int fq) const {
#pragma unroll
        for (int m = 0; m < 4; ++m) {
            const int r = row + 16 * m;
            float* xp = X + (size_t)r * 1024 + col;
            const f32x4 x = *(const f32x4*)xp + acc[m];
            *(f32x4*)xp = x;
            uint2 w; w.x = pg8::cvt_pk_bf16(x[0], x[1]); w.y = pg8::cvt_pk_bf16(x[2], x[3]);
            *(uint2*)(XB + (size_t)r * 1024 + col) = w;
            float ss = (x[0] * x[0] + x[1] * x[1]) + (x[2] * x[2] + x[3] * x[3]);
            ss += __shfl_xor(ss, 16); ss += __shfl_xor(ss, 32);
            if (fq == 0) atomicAdd(rss + r, ss);
        }
    }
};

__device__ __forceinline__ void tr_item(const float* __restrict__ W, int K, int Nsrc, bf16* __restrict__ WT, const float* __restrict__ gain, bool inmap, float* scr, int item, int nblk, int lane) {
    const int kb = item / nblk, nb = item - kb * nblk, k0 = 64 * kb, n0 = 32 * nb;
    const int n = n0 + (lane & 31);
    int ns = n;
    if (inmap) ns = n < 1536 ? n : n + 8;
    float tv[32];
    const int nsc = ns >= 0 ? ns : 0;
#pragma unroll
    for (int i = 0; i < 32; ++i) tv[i] = W[(size_t)(k0 + 2 * i + (lane >> 5)) * Nsrc + nsc];
#pragma unroll
    for (int i = 0; i < 32; ++i) {
        const int kk = 2 * i + (lane >> 5);
        float v = ns >= 0 ? tv[i] : 0.f;
        if (gain) v *= gain[k0 + kk];
        scr[kk * 33 + (lane & 31)] = v;
    }
    LDS_WAIT();
    const int c = lane & 7;
#pragma unroll
    for (int j = 0; j < 4; ++j) {
        const int nn = (lane >> 3) + 8 * j; const float* s = scr + (8 * c) * 33 + nn;
        uint4 o; o.x = pk2(s[0], s[33]); o.y = pk2(s[66], s[99]); o.z = pk2(s[132], s[165]); o.w = pk2(s[198], s[231]);
        *(uint4*)(WT + (size_t)(n0 + nn) * K + k0 + 8 * c) = o;
    }
    LDS_WAIT();
}

__device__ __forceinline__ void convert_layer(const Args& a, int l, float* scr, int gw, int NGW, int lane) {
    bf16* wb = (bf16*)(a.ws + WS_W) + (size_t)l * WL_ELEMS;
    for (int it = gw; it < 6016; it += NGW) {
        int r = it;
        if (r < 1408) tr_item(a.in[I_WIN] + (size_t)l * 1024 * 2824, 1024, 2824, wb + WOFF_IN, a.in[I_N1G] + l * 1024, true, scr, r, 88, lane);
        else if ((r -= 1408) < 512) tr_item(a.in[I_WOUT] + (size_t)l * 1024 * 1024, 1024, 1024, wb + WOFF_OUT, nullptr, false, scr, r, 32, lane);
        else if ((r -= 512) < 2048) tr_item(a.in[I_WUP] + (size_t)l * 1024 * 4096, 1024, 4096, wb + WOFF_UP, a.in[I_N2G] + l * 1024, false, scr, r, 128, lane);
        else { r -= 2048; tr_item(a.in[I_WDN] + (size_t)l * 4096 * 1024, 4096, 1024, wb + WOFF_DOWN, nullptr, false, scr, r, 32, lane); }
    }
}
__device__ __forceinline__ void phase0(const Args& a, unsigned char* lds) {
    const int tid = otid(), lane = tid & 63, wave = tid >> 6;
    const int gw = blockIdx.x * 8 + wave, NGW = gridDim.x * 8;
    float* scr = (float*)(lds + wave * 16384);
    convert_layer(a, 0, scr, gw, NGW, lane);
    if (MK_PER_PHASE || gridDim.x != 256) convert_layer(a, 1, scr, gw, NGW, lane);
    {
        bf16* BAW = (bf16*)(a.ws + WS_BAW);
        for (int i = blockIdx.x * 512 + tid; i < 2 * 16 * 1024; i += gridDim.x * 512) {
            const int l = i >> 14, n = (i >> 10) & 15, kk = i & 1023;
            const float v = n < 8 ? a.in[I_WIN][((size_t)l * 1024 + kk) * 2824 + 1536 + n] * a.in[I_N1G][l * 1024 + kk] : 0.f;
            BAW[i] = (bf16)f2bf(v);
        }
    }
    float* rowss = (float*)(a.ws + WS_ROWSS);
    bf16* xb = (bf16*)(a.ws + WS_XB);
    for (int r = gw; r < TT; r += NGW) {
        const float* src = r < T_P ? a.in[I_XP] + (size_t)r * 1024 : a.in[I_XS] + (size_t)(r - T_P) * 1024;
        float4 v[4]; float ss = 0.f;
#pragma unroll
        for (int j = 0; j < 4; ++j) { v[j] = ((const float4*)src)[lane + 64 * j]; ss += (v[j].x * v[j].x + v[j].y * v[j].y) + (v[j].z * v[j].z + v[j].w * v[j].w); }
        ss = wave_sum(ss);
        if (lane == 0) rowss[r] = ss;
        uint2* bo = (uint2*)(xb + (size_t)r * 1024);
#pragma unroll
        for (int j = 0; j < 4; ++j) { uint2 w; w.x = pk2(v[j].x, v[j].y); w.y = pk2(v[j].z, v[j].w); bo[lane + 64 * j] = w; }
    }
    for (int i = blockIdx.x * 512 + tid; i < 4 * TT; i += gridDim.x * 512) rowss[TT + i] = 0.f;
    {
        bf16* LW = (bf16*)(a.ws + WS_LW);
        for (int i = blockIdx.x * 512 + tid; i < 2 * 81920; i += gridDim.x * 512) {
            const int l = i / 81920; int r = i - l * 81920; float v;
            if (r < 16384) { const int c = r >> 6, j = r & 63; v = a.in[I_CW2][((size_t)l * 64 + j) * 256 + c]; }
            else if (r < 32768) { r -= 16384; const int c = r >> 6, j = r & 63; v = a.in[I_CA2][((size_t)l * 64 + j) * 256 + c]; }
            else if (r < 65536) { r -= 32768; const int c = r >> 7, j = r & 127; v = a.in[I_CG2][((size_t)l * 128 + j) * 256 + c]; }
            else { r -= 65536; const int c = r >> 6, cin = r & 63; v = a.in[I_DW][(((size_t)l * 4 + (c >> 6)) * 64 + cin) * 64 + (c & 63)]; }
            LW[i] = (bf16)f2bf(v);
        }
    }
}

template <int N> __device__ __forceinline__ void prev_c(const Args& a, int l, int row, int ccol, float (&o)[N]) {
    const bf16* P = (const bf16*)(a.ws + WS_P);
    bool first, smp = row >= T_P; int b = 0;
    if (!smp) first = (row & 2047) == 0; else { const int rs = row - T_P; first = (rs & 3) == 0; b = rs >> 2; }
    const int pr = row > 0 ? row - 1 : 0;
    float pv[N], sv[N];
    ldbf<N>(P + (size_t)pr * PN + PC_C + ccol, pv);
    ldf<N>(a.in[I_SCS] + ((size_t)l * 128 + b) * 1024 + ccol, sv);
#pragma unroll
    for (int i = 0; i < N; ++i) o[i] = first ? (smp ? sv[i] : 0.f) : pv[i];
}

__device__ __forceinline__ int tile_row(int tile, int i) { return i < 64 ? tile * 64 + i : T_P + tile * 2 + (i - 64); }
constexpr int XS = 264;
template <int KSTEPS> __device__ __forceinline__ void lora_mfma(const bf16* X, int joff, const bf16* __restrict__ WT, int wave, int lane, f32x4 (&acc)[5][2]) {
    const int fr = lane & 15, fq = lane >> 4;
#pragma unroll
    for (int m = 0; m < 5; ++m) { acc[m][0] = (f32x4){0.f, 0.f, 0.f, 0.f}; acc[m][1] = (f32x4){0.f, 0.f, 0.f, 0.f}; }
#pragma unroll
    for (int k = 0; k < KSTEPS; ++k) {
        pg8::bf16x8 bf[2];
#pragma unroll
        for (int n = 0; n < 2; ++n) bf[n] = *(const pg8::bf16x8*)(WT + (size_t)(wave * 32 + n * 16 + fr) * (32 * KSTEPS) + k * 32 + 8 * fq);
#pragma unroll
        for (int m = 0; m < 5; ++m) {
            const pg8::bf16x8 af = *(const pg8::bf16x8*)(X + (m * 16 + fr) * XS + joff + k * 32 + 8 * fq);
#pragma unroll
            for (int n = 0; n < 2; ++n) acc[m][n] = __builtin_amdgcn_mfma_f32_16x16x32_bf16(bf[n], af, acc[m][n], 0, 0, 0);
        }
    }
}

__device__ __forceinline__ void aux_tile(const Args& a, int l, int tile, unsigned char* lds) {
    const int tid = otid(), c = tid & 255, half = tid >> 8;
    const bf16* P = (const bf16*)(a.ws + WS_P);
    bf16* X = (bf16*)lds;
    {
        const float mu = a.in[I_CMU][l * 1024 + 768 + c];
#pragma unroll
        for (int j = 0; j < 33; ++j) {
            const int i = half * 33 + j, row = tile_row(tile, i);
            const float cur = bf2f(P[(size_t)row * PN + PC_C + 768 + c]);
            float pv[1]; prev_c<1>(a, l, row, 768 + c, pv);
            float xm = cur + (pv[0] - cur) * mu;
            if (c < 64) xm = tanh_(xm); else if (c >= 128) xm = sigm(xm);
            X[i * XS + c] = (bf16)f2bf(xm);
        }
    }
    __syncthreads();
    const int wave = tid >> 6, lane = tid & 63, fr = lane & 15, fq = lane >> 4;
    const bf16* LW = (const bf16*)(a.ws + WS_LW) + (size_t)l * 81920;
    float* auxw = (float*)(a.ws + WS_AUXW); bf16* auxa = (bf16*)(a.ws + WS_AUXA); bf16* auxg = (bf16*)(a.ws + WS_AUXG);
    f32x4 acc[5][2];
    lora_mfma<2>(X, 0, LW, wave, lane, acc);
#pragma unroll
    for (int n = 0; n < 2; ++n) {
        const int cc = wave * 32 + n * 16 + 4 * fq;
        const float4 w0c = *(const float4*)(a.in[I_CW0] + l * 256 + cc);
#pragma unroll
        for (int m = 0; m < 5; ++m) {
            const int tok = m * 16 + fr;
            if (tok < 66) {
                float4 o;
                o.x = __expf(-__expf(-softplus_(-(w0c.x + acc[m][n][0])) - 0.5f)); o.y = __expf(-__expf(-softplus_(-(w0c.y + acc[m][n][1])) - 0.5f));
                o.z = __expf(-__expf(-softplus_(-(w0c.z + acc[m][n][2])) - 0.5f)); o.w = __expf(-__expf(-softplus_(-(w0c.w + acc[m][n][3])) - 0.5f));
                *(float4*)(auxw + (size_t)tile_row(tile, tok) * 256 + cc) = o;
            }
        }
    }
    lora_mfma<2>(X, 64, LW + 16384, wave, lane, acc);
#pragma unroll
    for (int n = 0; n < 2; ++n) {
        const int cc = wave * 32 + n * 16 + 4 * fq;
        const float4 a0c = *(const float4*)(a.in[I_CA0] + l * 256 + cc);
#pragma unroll
        for (int m = 0; m < 5; ++m) {
            const int tok = m * 16 + fr;
            if (tok < 66) { uint2 o; o.x = pk2(sigm(a0c.x + acc[m][n][0]), sigm(a0c.y + acc[m][n][1])); o.y = pk2(sigm(a0c.z + acc[m][n][2]), sigm(a0c.w + acc[m][n][3])); *(uint2*)(auxa + (size_t)tile_row(tile, tok) * 256 + cc) = o; }
        }
    }
    lora_mfma<4>(X, 128, LW + 32768, wave, lane, acc);
#pragma unroll
    for (int n = 0; n < 2; ++n) {
        const int cc = wave * 32 + n * 16 + 4 * fq;
#pragma unroll
        for (int m = 0; m < 5; ++m) {
            const int tok = m * 16 + fr;
            if (tok < 66) { uint2 o; o.x = pk2(acc[m][n][0], acc[m][n][1]); o.y = pk2(acc[m][n][2], acc[m][n][3]); *(uint2*)(auxg + (size_t)tile_row(tile, tok) * 256 + cc) = o; }
        }
    }
    __syncthreads();
}

__device__ __forceinline__ void pool_tile(const Args& a, int l, int tile, unsigned char* lds) {
    bf16* X = (bf16*)lds;
    const int tid = otid(), c = tid & 255, half = tid >> 8, r0 = tile * 64;
    const bf16* P = (const bf16*)(a.ws + WS_P);
    bf16* mixed = (bf16*)(a.ws + WS_MIXED);
    const int gi = c >> 6, w = 2 << gi;
    unsigned short* Sg = (unsigned short*)(lds + 43008);
#pragma unroll
    for (int j = 0; j < 40; ++j) {
        const int k = half * 40 + j;
        if (k < 79) { const int gr = r0 - 15 + k; unsigned short v = 0; if (gr >= 0) v = P[(size_t)gr * PN + PC_D + c]; Sg[k * 256 + c] = v; }
    }
    __syncthreads();
    for (int j = 0; j < 32; ++j) {
        const int i = half * 32 + j, row = r0 + i;
        const unsigned short* sp = Sg + (15 + i) * 256 + c;
        const float xc = bf2f(sp[0]);
        const int b = row >> 11, t = row & 2047;
        const int n = t + 1 < w ? t + 1 : w;
        float sum = xc;
#pragma unroll
        for (int q = 1; q < 16; ++q) { const float hv = bf2f(sp[-q * 256]); if (q < n) sum += hv; }
        if (t >= 2033) a.out[O_PDP + (((size_t)l * 8 + b) * 15 + (t - 2033)) * 256 + c] = xc;
        X[i * XS + c] = (bf16)f2bf(sum / (float)n - xc);
    }
    {
        const int i = 64 + half, rs = tile * 2 + half, row = T_P + rs, b = rs >> 2, t = rs & 3;
        const float* sb = a.in[I_SDP] + ((size_t)l * 128 + b) * 15 * 256 + c;
        const float xc = bf2f(P[(size_t)row * PN + PC_D + c]);
        float hv[15];
#pragma unroll
        for (int q = 1; q < 16; ++q) {
            const int tq = t - q;
            const float pv = bf2f(P[(size_t)(row - (tq >= 0 ? q : 0)) * PN + PC_D + c]);
            const float sv = sb[(tq >= 0 ? 0 : 15 + tq) * 256];
            hv[q - 1] = tq >= 0 ? pv : sv;
        }
        float sum = xc;
#pragma unroll
        for (int q = 1; q < 16; ++q) if (q < w) sum += hv[q - 1];
        float* so = a.out + O_SDP + ((size_t)l * 128 + b) * 15 * 256 + c;
        so[(11 + t) * 256] = xc;
        if (t == 0) {
            float tv[11];
#pragma unroll
            for (int jj = 0; jj < 11; ++jj) tv[jj] = sb[(jj + 4) * 256];
#pragma unroll
            for (int jj = 0; jj < 11; ++jj) so[jj * 256] = tv[jj];
        }
        X[i * XS + c] = (bf16)f2bf(sum / (float)w - xc);
    }
    __syncthreads();
    {
        const int wave = tid >> 6, lane = tid & 63, fr = lane & 15, fq = lane >> 4;
        const bf16* LW = (const bf16*)(a.ws + WS_LW) + (size_t)l * 81920 + 65536;
        f32x4 acc[5][2];
        lora_mfma<2>(X, (wave >> 1) * 64, LW, wave, lane, acc);
#pragma unroll
        for (int n = 0; n < 2; ++n) {
            const int cc = wave * 32 + n * 16 + 4 * fq;
            const float4 sc = *(const float4*)(a.in[I_DSC] + l * 256 + cc);
#pragma unroll
            for (int m = 0; m < 5; ++m) {
                const int tok = m * 16 + fr;
                if (tok < 66) { uint2 o; o.x = pk2(acc[m][n][0] * sc.x, acc[m][n][1] * sc.y); o.y = pk2(acc[m][n][2] * sc.z, acc[m][n][3] * sc.w); *(uint2*)(mixed + (size_t)tile_row(tile, tok) * 1024 + 768 + cc) = o; }
            }
        }
    }
    for (int i = 0; i < 66; ++i) {
        const int row = tile_row(tile, i); int b, t, tl; bool smp;
        if (row < T_P) { b = row >> 11; t = row & 2047; tl = 2047; smp = false; } else { const int rs = row - T_P; b = rs >> 2; t = rs & 3; tl = 3; smp = true; }
        if (t == tl) {
            float* o = a.out + (smp ? O_SCS + ((size_t)l * 128 + b) * 1024 : O_PCS + ((size_t)l * 8 + b) * 1024);
            const float v0 = bf2f(P[(size_t)row * PN + PC_C + tid]), v1 = bf2f(P[(size_t)row * PN + PC_C + 512 + tid]);
            o[tid] = v0; o[512 + tid] = v1;
        }
        if (t >= tl - 2) {
            const int j = t - (tl - 2);
            float* o = a.out + (smp ? O_SBC + (((size_t)l * 128 + b) * 3 + j) * 768 : O_PBC + (((size_t)l * 8 + b) * 3 + j) * 768);
            const float v0 = bf2f(P[(size_t)row * PN + PC_BQ + tid]);
            o[tid] = v0;
            if (tid < 256) o[512 + tid] = bf2f(P[(size_t)row * PN + PC_BQ + 512 + tid]);
        }
    }
    __syncthreads();
}

__device__ __forceinline__ void gmlp_prompt_item(const Args& a, int l, int it, unsigned char* lds) {
    const int tid = otid(), t = tid >> 2, q = tid & 3;
    const int b = it >> 6, nc = (it >> 2) & 15, h = it & 3;
    const int row = b * 2048 + nc * 128 + t;
    const bf16* Pb = (const bf16*)(a.ws + WS_P);
    const bf16* Prow = Pb + (size_t)row * PN;
    bf16* mixed = (bf16*)(a.ws + WS_MIXED);
    bf16* wsb = (bf16*)lds;
    bf16* vT = (bf16*)(lds + 34816);
    float ss = 0.f;
#pragma unroll
    for (int k = 0; k < 8; ++k) { float x[8]; ld8(Prow + 256 + q * 64 + k * 8, x);
#pragma unroll
        for (int e = 0; e < 8; ++e) { const float g = gelu_t(x[e]); ss += g * g; } }
    ss += __shfl_xor(ss, 1); ss += __shfl_xor(ss, 2);
    const float rstd = rsqrtf(ss * (1.f / 256.f) + NORM_EPS);
    {
        const float* vg = a.in[I_AVG] + l * 256 + h * 64 + q * 16;
#pragma unroll
        for (int k = 0; k < 2; ++k) { float x[8]; ld8(Prow + 256 + h * 64 + q * 16 + k * 8, x);
#pragma unroll
            for (int e = 0; e < 8; ++e) vT[(q * 16 + k * 8 + e) * 136 + t] = (bf16)f2bf(gelu_t(x[e]) * rstd * vg[k * 8 + e]); }
    }
    {
        const float* wsrc = a.in[I_AWS] + ((size_t)l * 4 + h) * 16384;
        float4 wv[8];
#pragma unroll
        for (int j = 0; j < 8; ++j) { const int idx = tid + 512 * j; wv[j] = *(const float4*)(wsrc + (idx >> 5) * 128 + (idx & 31) * 4); }
#pragma unroll
        for (int j = 0; j < 8; ++j) {
            const int idx = tid + 512 * j, rr = idx >> 5, s0 = (idx & 31) * 4;
            uint2 o; o.x = pk2(s0 <= rr ? wv[j].x : 0.f, s0 + 1 <= rr ? wv[j].y : 0.f); o.y = pk2(s0 + 2 <= rr ? wv[j].z : 0.f, s0 + 3 <= rr ? wv[j].w : 0.f);
            *(uint2*)(wsb + rr * 136 + s0) = o;
        }
    }
    __syncthreads();
    const int wave = tid >> 6, lane = tid & 63, fr = lane & 15, fq = lane >> 4;
    f32x4 acc[4];
#pragma unroll
    for (int n = 0; n < 4; ++n) acc[n] = (f32x4){0.f, 0.f, 0.f, 0.f};
    const int nk = (wave >> 1) + 1;
#pragma unroll
    for (int k = 0; k < 4; ++k) {
        if (k < nk) {
            const pg8::bf16x8 af = *(const pg8::bf16x8*)(wsb + (wave * 16 + fr) * 136 + k * 32 + 8 * fq);
#pragma unroll
            for (int n = 0; n < 4; ++n) { const pg8::bf16x8 bfr = *(const pg8::bf16x8*)(vT + (n * 16 + fr) * 136 + k * 32 + 8 * fq); acc[n] = __builtin_amdgcn_mfma_f32_16x16x32_bf16(bfr, af, acc[n], 0, 0, 0); }
        }
    }
    {
        const int tt = wave * 16 + fr, ro = b * 2048 + nc * 128 + tt;
        const float bs = a.in[I_ABS][((size_t)l * 4 + h) * 128 + tt];
#pragma unroll
        for (int n = 0; n < 4; ++n) {
            const int cc = h * 64 + n * 16 + 4 * fq;
            float u[4]; ld4(Pb + (size_t)ro * PN + cc, u);
            uint2 o; o.x = pk2(gelu_t(u[0]) * (acc[n][0] + bs), gelu_t(u[1]) * (acc[n][1] + bs)); o.y = pk2(gelu_t(u[2]) * (acc[n][2] + bs), gelu_t(u[3]) * (acc[n][3] + bs));
            *(uint2*)(mixed + (size_t)ro * 1024 + cc) = o;
        }
    }
    __syncthreads();
}
__device__ __forceinline__ void gmlp_sample_item(const Args& a, int l, int b, float* Ls  ) {
    const int tid = otid(), lane = tid & 63, wave = tid >> 6, t = tid >> 7, c0 = (tid & 127) * 2;
    const int row = T_P + b * 4 + t;
    const bf16* Prow = (const bf16*)(a.ws + WS_P) + (size_t)row * PN;
    bf16* mixed = (bf16*)(a.ws + WS_MIXED);
    float* red = Ls + 1024;
    float x[2]; ld2(Prow + 256 + c0, x);
    const float g0 = gelu_t(x[0]), g1 = gelu_t(x[1]);
    const float ss = wave_sum(g0 * g0 + g1 * g1);
    if (lane == 0) red[wave] = ss;
    __syncthreads();
    const float rstd = rsqrtf((red[2 * t] + red[2 * t + 1]) * (1.f / 256.f) + NORM_EPS);
    const float v0 = g0 * rstd * a.in[I_AVG][l * 256 + c0], v1 = g1 * rstd * a.in[I_AVG][l * 256 + c0 + 1];
    Ls[t * 256 + c0] = v0; Ls[t * 256 + c0 + 1] = v1;
    float* sav = a.out + O_SAV + (((size_t)l * 128 + b) * 4 + t) * 256 + c0;
    sav[0] = v0; sav[1] = v1;
    __syncthreads();
    const int h = c0 >> 6;
    const float* wrow = a.in[I_AWS] + (((size_t)l * 4 + h) * 128 + t) * 128;
    const float bs = a.in[I_ABS][((size_t)l * 4 + h) * 128 + t];
    float m0 = bs, m1 = bs;
    for (int s = 0; s <= t; ++s) { const float ww = wrow[s]; m0 += ww * Ls[s * 256 + c0]; m1 += ww * Ls[s * 256 + c0 + 1]; }
    float u[2]; ld2(Prow + c0, u);
    *(unsigned*)(mixed + (size_t)row * 1024 + c0) = pk2(gelu_t(u[0]) * m0, gelu_t(u[1]) * m1);
    __syncthreads();
}

__device__ __forceinline__ void ba_tile(const Args& a, int l, int tile, unsigned char* lds) {
    const int tid = otid(), wave = tid >> 6, lane = tid & 63, fr = lane & 15, fq = lane >> 4;
    const bf16* xb = (const bf16*)(a.ws + WS_XB);
    const bf16* BAW = (const bf16*)(a.ws + WS_BAW) + (size_t)l * 16384;
    float* red = (float*)lds;
    f32x4 acc[5];
#pragma unroll
    for (int m = 0; m < 5; ++m) acc[m] = (f32x4){0.f, 0.f, 0.f, 0.f};
#pragma unroll
    for (int k = 0; k < 4; ++k) {
        const int kk = wave * 128 + k * 32 + 8 * fq;
        const pg8::bf16x8 bfr = *(const pg8::bf16x8*)(BAW + fr * 1024 + kk);
#pragma unroll
        for (int m = 0; m < 5; ++m) {
            const int tok = m * 16 + fr, row = tile_row(tile, tok < 66 ? tok : 65);
            const pg8::bf16x8 af = *(const pg8::bf16x8*)(xb + (size_t)row * 1024 + kk);
            acc[m] = __builtin_amdgcn_mfma_f32_16x16x32_bf16(bfr, af, acc[m], 0, 0, 0);
        }
    }
#pragma unroll
    for (int m = 0; m < 5; ++m) *(f32x4*)(red + ((wave * 80) + m * 16 + fr) * 16 + 4 * fq) = acc[m];
    __syncthreads();
    const float* rss = (const float*)(a.ws + WS_ROWSS) + (size_t)(2 * l) * TT;
    float* BA = (float*)(a.ws + WS_BA);
    for (int e = tid; e < 66 * 8; e += 512) {
        const int tok = e >> 3, n = e & 7, row = tile_row(tile, tok);
        float s = 0.f;
#pragma unroll
        for (int w = 0; w < 8; ++w) s += red[(w * 80 + tok) * 16 + n];
        BA[(size_t)row * 8 + n] = s * rsqrtf(rss[row] * (1.f / 1024.f) + NORM_EPS);
    }
    __syncthreads();
}

__device__ __forceinline__ void phase_pre(const Args& a, int l, unsigned char* lds, int mode = 0) {
    float* L = (float*)lds;
    const int G = gridDim.x, g = blockIdx.x;
    if (mode != 2) for (int tile = g; tile < 256; tile += G) { aux_tile(a, l, tile, lds); pool_tile(a, l, tile, lds); ba_tile(a, l, tile, lds); }
    if (mode != 1) for (int it = g; it < 512; it += G) gmlp_prompt_item(a, l, it, lds);
    for (int it = g; it < 128; it += G) gmlp_sample_item(a, l, it, L);
}

struct ChunkD { int valid, mixer, h, cg, b, sample, row0, t0, n, first, last; };
__device__ __forceinline__ ChunkD get_chunk(int idx, int g, int G, int mode = 0) {
    ChunkD d; d.valid = 0; d.mixer = 0; d.h = 0; d.cg = 0; d.b = 0; d.sample = 0; d.row0 = 0; d.t0 = 0; d.n = 0; d.first = 0; d.last = 0;
    int nP = g < 256 ? (256 - g + G - 1) / G : 0;
    int nS = g < 4096 ? (4096 - g + G - 1) / G : 0;
    nS = 0;
    if (mode == 2) nP = 0;
    if (idx < nP * 64) {
        const int it = g + (idx >> 6) * G, ch = idx & 63;
        d.valid = 1; d.mixer = it & 1; d.cg = (it >> 1) & 3; d.h = (it >> 3) & 3; d.b = it >> 5; d.sample = 0; d.row0 = d.b * 2048; d.t0 = ch * 32; d.n = 32; d.first = ch == 0; d.last = ch == 63;
    } else {
        const int j = idx - nP * 64;
        if (j < nS) { const int it = g + j * G; d.valid = 1; d.mixer = it & 1; d.cg = (it >> 1) & 3; d.h = (it >> 3) & 3; d.b = it >> 5; d.sample = 1; d.row0 = T_P + d.b * 4; d.t0 = 0; d.n = 4; d.first = 1; d.last = 1; }
    }
    return d;
}
constexpr int OPB_FLOATS = 10752;

struct Raw { uint4 u[8]; unsigned s[4]; float w[2]; };
__device__ __forceinline__ void unpack8(const uint4 u, float (&o)[8]) {
    o[0] = __uint_as_float(u.x << 16); o[1] = __uint_as_float(u.x & 0xffff0000u); o[2] = __uint_as_float(u.y << 16); o[3] = __uint_as_float(u.y & 0xffff0000u);
    o[4] = __uint_as_float(u.z << 16); o[5] = __uint_as_float(u.z & 0xffff0000u); o[6] = __uint_as_float(u.w << 16); o[7] = __uint_as_float(u.w & 0xffff0000u);
}
__device__ __forceinline__ uint4 pack8f(const float* p) {
    const float4 x = *(const float4*)p, y = *(const float4*)(p + 4);
    uint4 o; o.x = pk2(x.x, x.y); o.y = pk2(x.z, x.w); o.z = pk2(y.x, y.y); o.w = pk2(y.z, y.w); return o;
}
__device__ __forceinline__ void raw_load(const Args& a, int l, const ChunkD& d, int ptid, Raw& R) {
    const int tok = ptid >> 3, sub = ptid & 7;
    if (!d.valid || tok >= d.n) return;
    const int t = d.t0 + tok, row = d.row0 + t;
    const bf16* P = (const bf16*)(a.ws + WS_P);
    const uint4 z4 = make_uint4(0u, 0u, 0u, 0u);
    if (d.mixer == 0) {
        const int cq = d.h * 64 + sub * 8, cv = 512 + d.h * 64 + d.cg * 16 + sub * 2;
#pragma unroll
        for (int k = 0; k < 4; ++k) {
            const int tt = t - 3 + k;
            if (tt >= 0) { const bf16* pr = P + (size_t)(d.row0 + tt) * PN + PC_BQ; R.u[k] = *(const uint4*)(pr + cq); R.u[4 + k] = *(const uint4*)(pr + 256 + cq); R.s[k] = *(const unsigned*)(pr + cv); }
            else if (d.sample) { const float* sp = a.in[I_SBC] + (((size_t)l * 128 + d.b) * 3 + (tt + 3)) * 768; R.u[k] = pack8f(sp + cq); R.u[4 + k] = pack8f(sp + 256 + cq); R.s[k] = pk2(sp[cv], sp[cv + 1]); }
            else { R.u[k] = z4; R.u[4 + k] = z4; R.s[k] = 0u; }
        }
        { const float* ba = (const float*)(a.ws + WS_BA) + (size_t)row * 8; R.w[0] = ba[d.h]; R.w[1] = ba[4 + d.h]; }
    } else {
        const int ch = d.h * 64 + sub * 8, vcl = 512 + d.h * 64 + d.cg * 16 + sub * 2;
        const bf16* pc = P + (size_t)row * PN + PC_C;
        R.u[0] = *(const uint4*)(pc + ch); R.u[1] = *(const uint4*)(pc + 256 + ch); R.s[0] = *(const unsigned*)(pc + vcl);
        if (t > 0) { const bf16* pp = pc - PN; R.u[2] = *(const uint4*)(pp + ch); R.u[3] = *(const uint4*)(pp + 256 + ch); R.s[1] = *(const unsigned*)(pp + vcl); }
        else if (d.sample) { const float* sp = a.in[I_SCS] + ((size_t)l * 128 + d.b) * 1024; R.u[2] = pack8f(sp + ch); R.u[3] = pack8f(sp + 256 + ch); R.s[1] = pk2(sp[vcl], sp[vcl + 1]); }
        else { R.u[2] = z4; R.u[3] = z4; R.s[1] = 0u; }
        R.u[4] = *(const uint4*)((const bf16*)(a.ws + WS_AUXA) + (size_t)row * 256 + ch);
        const float* wp = (const float*)(a.ws + WS_AUXW) + (size_t)row * 256 + ch;
        R.u[5] = *(const uint4*)wp; R.u[6] = *(const uint4*)(wp + 4);
    }
}
__device__ __forceinline__ void prep_math(const Args& a, int l, const ChunkD& d, const Raw& R, float* ob, float* CST, int ptid) {
    const int tok = ptid >> 3, sub = ptid & 7;
    if (!d.valid || tok >= d.n) return;
    const int row = d.row0 + d.t0 + tok;
    float* Rp = ob + tok * 64 + sub * 8;
    float* V = ob + 10240 + tok * 16 + sub * 2;
    float r[8], w[8], k[8], kk[8], bb[8], v[2];
    if (d.mixer == 0) {
        const int cq = d.h * 64 + sub * 8, cv = 512 + d.h * 64 + d.cg * 16 + sub * 2;
        float q[8], kr[8];
#pragma unroll
        for (int i = 0; i < 8; ++i) { q[i] = 0.f; kr[i] = 0.f; }
        v[0] = 0.f; v[1] = 0.f;
        float* cst = CST + sub * 80;
        if (d.first) {
#pragma unroll
            for (int kx = 0; kx < 4; ++kx) {
                const float* cw = a.in[I_BCW] + ((size_t)l * 4 + kx) * 768;
                *(float4*)(cst + kx * 20) = *(const float4*)(cw + cq); *(float4*)(cst + kx * 20 + 4) = *(const float4*)(cw + cq + 4);
                *(float4*)(cst + kx * 20 + 8) = *(const float4*)(cw + 256 + cq); *(float4*)(cst + kx * 20 + 12) = *(const float4*)(cw + 256 + cq + 4);
                *(float2*)(cst + kx * 20 + 16) = *(const float2*)(cw + cv);
            }
        }
#pragma unroll
        for (int kx = 0; kx < 4; ++kx) {
            float xq[8], xk[8]; unpack8(R.u[kx], xq); unpack8(R.u[4 + kx], xk);
            const float4 a0 = *(const float4*)(cst + kx * 20), a1 = *(const float4*)(cst + kx * 20 + 4), b0 = *(const float4*)(cst + kx * 20 + 8), b1 = *(const float4*)(cst + kx * 20 + 12);
            const float2 c0 = *(const float2*)(cst + kx * 20 + 16);
            q[0] += xq[0] * a0.x; q[1] += xq[1] * a0.y; q[2] += xq[2] * a0.z; q[3] += xq[3] * a0.w; q[4] += xq[4] * a1.x; q[5] += xq[5] * a1.y; q[6] += xq[6] * a1.z; q[7] += xq[7] * a1.w;
            kr[0] += xk[0] * b0.x; kr[1] += xk[1] * b0.y; kr[2] += xk[2] * b0.z; kr[3] += xk[3] * b0.w; kr[4] += xk[4] * b1.x; kr[5] += xk[5] * b1.y; kr[6] += xk[6] * b1.z; kr[7] += xk[7] * b1.w;
            v[0] += __uint_as_float(R.s[kx] << 16) * c0.x; v[1] += __uint_as_float(R.s[kx] & 0xffff0000u) * c0.y;
        }
        float sq = 0.f, sk = 0.f;
#pragma unroll
        for (int i = 0; i < 8; ++i) { q[i] = silu(q[i]); kr[i] = silu(kr[i]); sq += q[i] * q[i]; sk += kr[i] * kr[i]; }
        v[0] = silu(v[0]); v[1] = silu(v[1]);
        sq = sum8(sq); sk = sum8(sk);
        const float iq = rsqrtf(sq + 1e-6f) * 0.125f, ik = rsqrtf(sk + 1e-6f);
        const float beta = sigm(R.w[0]);
        const float gg = -__expf(a.in[I_BAL][l * 4 + d.h]) * softplus_(R.w[1] + a.in[I_BDT][l * 4 + d.h]);
        const float dec = __expf(gg);
#pragma unroll
        for (int i = 0; i < 8; ++i) { const float kn = kr[i] * ik; r[i] = q[i] * iq; w[i] = dec; kk[i] = kn; k[i] = beta * kn; bb[i] = dec * beta * kn; }
    } else {
        const int ch = d.h * 64 + sub * 8, vcl = 512 + d.h * 64 + d.cg * 16 + sub * 2;
        float cur[8], pv[8], kx[8], av[8];
        const float* mu = a.in[I_CMU] + l * 1024;
        float m0[8], m1[8], kkw[8], kaw[8], rkw[8];
        float* cst = CST + sub * 80;
        if (d.first) {
            *(float4*)(cst) = *(const float4*)(mu + ch); *(float4*)(cst + 4) = *(const float4*)(mu + ch + 4);
            *(float4*)(cst + 8) = *(const float4*)(mu + 256 + ch); *(float4*)(cst + 12) = *(const float4*)(mu + 256 + ch + 4);
            const float* p1 = a.in[I_CKK] + l * 256 + ch; *(float4*)(cst + 16) = *(const float4*)p1; *(float4*)(cst + 20) = *(const float4*)(p1 + 4);
            const float* p2 = a.in[I_CKA] + l * 256 + ch; *(float4*)(cst + 24) = *(const float4*)p2; *(float4*)(cst + 28) = *(const float4*)(p2 + 4);
            const float* p3 = a.in[I_CRK] + l * 256 + ch; *(float4*)(cst + 32) = *(const float4*)p3; *(float4*)(cst + 36) = *(const float4*)(p3 + 4);
            *(float2*)(cst + 40) = *(const float2*)(mu + vcl);
        }
        ldf<8>(cst, m0); ldf<8>(cst + 8, m1); ldf<8>(cst + 16, kkw); ldf<8>(cst + 24, kaw); ldf<8>(cst + 32, rkw);
        const float mv0 = cst[40], mv1 = cst[41];
        unpack8(R.u[0], cur); unpack8(R.u[2], pv);
#pragma unroll
        for (int i = 0; i < 8; ++i) r[i] = cur[i] + (pv[i] - cur[i]) * m0[i];
        unpack8(R.u[1], cur); unpack8(R.u[3], pv);
#pragma unroll
        for (int i = 0; i < 8; ++i) kx[i] = cur[i] + (pv[i] - cur[i]) * m1[i];
        {
            const float c0 = __uint_as_float(R.s[0] << 16), c1 = __uint_as_float(R.s[0] & 0xffff0000u), p0 = __uint_as_float(R.s[1] << 16), p1 = __uint_as_float(R.s[1] & 0xffff0000u);
            v[0] = c0 + (p0 - c0) * mv0; v[1] = c1 + (p1 - c1) * mv1;
        }
        unpack8(R.u[4], av);
        float ss = 0.f;
#pragma unroll
        for (int i = 0; i < 8; ++i) { kk[i] = kx[i] * kkw[i]; ss += kk[i] * kk[i]; }
        w[0] = __uint_as_float(R.u[5].x); w[1] = __uint_as_float(R.u[5].y); w[2] = __uint_as_float(R.u[5].z); w[3] = __uint_as_float(R.u[5].w); w[4] = __uint_as_float(R.u[6].x); w[5] = __uint_as_float(R.u[6].y); w[6] = __uint_as_float(R.u[6].z); w[7] = __uint_as_float(R.u[6].w);
        ss = sum8(ss);
        const float inv = rsqrtf(ss + 1e-6f);
        float rk = 0.f;
#pragma unroll
        for (int i = 0; i < 8; ++i) { kk[i] *= inv; k[i] = kx[i] * (1.f + (av[i] - 1.f) * kaw[i]); bb[i] = kk[i] * av[i]; rk += r[i] * k[i] * rkw[i]; }
        rk = sum8(rk);
        if (sub == 0 && d.cg == 0) ((float*)(a.ws + WS_RK))[(size_t)row * 4 + d.h] = rk;
    }
    *(float4*)(Rp) = make_float4(r[0], r[1], r[2], r[3]); *(float4*)(Rp + 4) = make_float4(r[4], r[5], r[6], r[7]);
    *(float4*)(Rp + 2048) = make_float4(w[0], w[1], w[2], w[3]); *(float4*)(Rp + 2052) = make_float4(w[4], w[5], w[6], w[7]);
    *(float4*)(Rp + 4096) = make_float4(k[0], k[1], k[2], k[3]); *(float4*)(Rp + 4100) = make_float4(k[4], k[5], k[6], k[7]);
    *(float4*)(Rp + 6144) = make_float4(kk[0], kk[1], kk[2], kk[3]); *(float4*)(Rp + 6148) = make_float4(kk[4], kk[5], kk[6], kk[7]);
    *(float4*)(Rp + 8192) = make_float4(bb[0], bb[1], bb[2], bb[3]); *(float4*)(Rp + 8196) = make_float4(bb[4], bb[5], bb[6], bb[7]);
    V[0] = v[0]; V[1] = v[1];
}

__device__ __forceinline__ void flush_y(const Args& a, const ChunkD& d, const float* Yb, int ptid) {
    if (!d.valid) return;
    float* yraw = (float*)(a.ws + WS_XB) + (size_t)d.mixer * TT * 256;
    for (int e = ptid; e < d.n * 16; e += 256) {
        const float4* yp = (const float4*)(Yb + e * 16);
        const float4 a0 = yp[0], a1 = yp[1], a2 = yp[2], a3 = yp[3];
        const float y = ((a0.x + a0.y) + (a0.z + a0.w)) + ((a1.x + a1.y) + (a1.z + a1.w)) + ((a2.x + a2.y) + (a2.z + a2.w)) + ((a3.x + a3.y) + (a3.z + a3.w));
        const int st = e >> 4, c = e & 15; yraw[(size_t)(d.row0 + d.t0 + st) * 256 + d.h * 64 + d.cg * 16 + c] = y;
    }
}

typedef float f2 __attribute__((ext_vector_type(2)));
struct Ops { f32x4 r, w, k, q, b; float v; };
__device__ __forceinline__ void ops_load(Ops& o, const float* Rb, const float* Vb, int st) {
    o.r = *(const f32x4*)(Rb + st * 64); o.w = *(const f32x4*)(Rb + 2048 + st * 64); o.k = *(const f32x4*)(Rb + 4096 + st * 64);
    o.q = *(const f32x4*)(Rb + 6144 + st * 64); o.b = *(const f32x4*)(Rb + 8192 + st * 64); o.v = Vb[st * 16];
}
__device__ __forceinline__ void scan_step(const Ops& o, f2& S01, f2& S23, float* Yp) {
    const f2 p2 = o.q.xy * S01 + o.q.zw * S23;
    const float sk = dpp_sum16(p2.x + p2.y);
    const f2 vv = {o.v, o.v}, sk2 = {sk, sk};
    const f2 t01 = o.k.xy * vv - o.b.xy * sk2, t23 = o.k.zw * vv - o.b.zw * sk2;
    S01 = o.w.xy * S01 + t01; S23 = o.w.zw * S23 + t23;
    const f2 y2 = o.r.xy * S01 + o.r.zw * S23;
    *Yp = y2.x + y2.y;
}
__device__ __forceinline__ const float* state_in_ptr(const Args& a, int l, const ChunkD& d, int kg, int cc) {
    return a.in[d.mixer ? I_SCW : I_SBS] + ((((size_t)l * 128 + d.b) * 4 + d.h) * 64 + 4 * kg) * 64 + d.cg * 16 + cc;
}
__device__ __forceinline__ void consume_chunk(const Args& a, int l, const ChunkD& d, const ChunkD& nx, const float* ob, float* Yb, f2& S01, f2& S23, float (&Sn)[4], int wave, int lane) {
    const int kg = lane & 15, cc = wave * 4 + (lane >> 4);
    if (d.first) {
        if (d.sample) { S01.x = Sn[0]; S01.y = Sn[1]; S23.x = Sn[2]; S23.y = Sn[3]; }
        else { S01.x = 0.f; S01.y = 0.f; S23.x = 0.f; S23.y = 0.f; }
    }
    if (nx.valid && nx.first && nx.sample) { const float* sp = state_in_ptr(a, l, nx, kg, cc); Sn[0] = sp[0]; Sn[1] = sp[64]; Sn[2] = sp[128]; Sn[3] = sp[192]; }
    const float* Rb = ob + 4 * kg; const float* Vb = ob + 10240 + cc; float* Yp = Yb + cc * 16 + kg;
    Ops o0, o1, o2;
    ops_load(o0, Rb, Vb, 0); ops_load(o1, Rb, Vb, 1);
    for (int st = 0; st < d.n; st += 4) {
        ops_load(o2, Rb, Vb, st + 2); scan_step(o0, S01, S23, Yp + st * 256);
        ops_load(o0, Rb, Vb, st + 3); scan_step(o1, S01, S23, Yp + (st + 1) * 256);
        ops_load(o1, Rb, Vb, st + 4); scan_step(o2, S01, S23, Yp + (st + 2) * 256);
        ops_load(o2, Rb, Vb, st + 5); scan_step(o0, S01, S23, Yp + (st + 3) * 256);
        o0 = o1; o1 = o2;
    }
    if (d.last) {
        size_t off;
        if (d.sample) off = (d.mixer ? O_SCW : O_SBS) + ((((size_t)l * 128 + d.b) * 4 + d.h) * 64 + 4 * kg) * 64 + d.cg * 16 + cc;
        else off = (d.mixer ? O_PCW : O_PBS) + ((((size_t)l * 8 + d.b) * 4 + d.h) * 64 + 4 * kg) * 64 + d.cg * 16 + cc;
        float* sp = a.out + off;
        sp[0] = S01.x; sp[64] = S01.y; sp[128] = S23.x; sp[192] = S23.y;
    }
}

__device__ __forceinline__ void sample_item(const Args& a, int l, int it, float* wl  , int lane) {
    const int mixer = it & 1, h = (it >> 1) & 3, b = it >> 3;
    const bf16* P = (const bf16*)(a.ws + WS_P);
    const int row0 = T_P + b * 4;
    float S[64];
    {
        const float* sp = a.in[mixer ? I_SCW : I_SBS] + (((size_t)l * 128 + b) * 4 + h) * 4096 + lane;
#pragma unroll
        for (int k = 0; k < 64; ++k) S[k] = sp[k * 64];
    }
    float* yraw = (float*)(a.ws + WS_XB) + (size_t)mixer * TT * 256;
    const int ch = h * 64 + lane;
    float cq[4], ck[4], cv[4], mur = 0.f, muk = 0.f, muv = 0.f, kkw = 0.f, kaw = 0.f, rkw = 0.f, alog = 0.f, dtb = 0.f;
    if (mixer == 0) {
#pragma unroll
        for (int k = 0; k < 4; ++k) { const float* cw = a.in[I_BCW] + ((size_t)l * 4 + k) * 768; cq[k] = cw[ch]; ck[k] = cw[256 + ch]; cv[k] = cw[512 + ch]; }
        alog = a.in[I_BAL][l * 4 + h]; dtb = a.in[I_BDT][l * 4 + h];
    } else {
#pragma unroll
        for (int k = 0; k < 4; ++k) { cq[k] = 0.f; ck[k] = 0.f; cv[k] = 0.f; }
        const float* mu = a.in[I_CMU] + l * 1024; mur = mu[ch]; muk = mu[256 + ch]; muv = mu[512 + ch];
        kkw = a.in[I_CKK][l * 256 + ch]; kaw = a.in[I_CKA][l * 256 + ch]; rkw = a.in[I_CRK][l * 256 + ch];
    }
    float xq[7], xk[7], xv[7];
    if (mixer == 0) {
        const float* sb = a.in[I_SBC] + ((size_t)l * 128 + b) * 3 * 768;
#pragma unroll
        for (int j = 0; j < 3; ++j) { xq[j] = sb[j * 768 + ch]; xk[j] = sb[j * 768 + 256 + ch]; xv[j] = sb[j * 768 + 512 + ch]; }
#pragma unroll
        for (int j = 0; j < 4; ++j) { const bf16* pr = P + (size_t)(row0 + j) * PN + PC_BQ; xq[3 + j] = bf2f(pr[ch]); xk[3 + j] = bf2f(pr[256 + ch]); xv[3 + j] = bf2f(pr[512 + ch]); }
    } else {
        const float* sc = a.in[I_SCS] + ((size_t)l * 128 + b) * 1024;
        xq[0] = 0.f; xk[0] = 0.f; xv[0] = 0.f; xq[1] = 0.f; xk[1] = 0.f; xv[1] = 0.f;
        xq[2] = sc[ch]; xk[2] = sc[256 + ch]; xv[2] = sc[512 + ch];
#pragma unroll
        for (int j = 0; j < 4; ++j) { const bf16* pr = P + (size_t)(row0 + j) * PN + PC_C; xq[3 + j] = bf2f(pr[ch]); xk[3 + j] = bf2f(pr[256 + ch]); xv[3 + j] = bf2f(pr[512 + ch]); }
    }
#pragma unroll
    for (int t = 0; t < 4; ++t) {
        const int row = row0 + t;
        float r, w, k, kk, bb, v;
        if (mixer == 0) {
            const float q0 = silu(xq[t] * cq[0] + xq[t + 1] * cq[1] + xq[t + 2] * cq[2] + xq[t + 3] * cq[3]);
            const float k0 = silu(xk[t] * ck[0] + xk[t + 1] * ck[1] + xk[t + 2] * ck[2] + xk[t + 3] * ck[3]);
            v = silu(xv[t] * cv[0] + xv[t + 1] * cv[1] + xv[t + 2] * cv[2] + xv[t + 3] * cv[3]);
            const float iq = rsqrtf(wave_sum(q0 * q0) + 1e-6f) * 0.125f, ik = rsqrtf(wave_sum(k0 * k0) + 1e-6f);
            const float* ba = (const float*)(a.ws + WS_BA) + (size_t)row * 8;
            const float beta = sigm(ba[h]);
            const float dec = __expf(-__expf(alog) * softplus_(ba[4 + h] + dtb));
            const float kn = k0 * ik; r = q0 * iq; w = dec; kk = kn; k = beta * kn; bb = dec * beta * kn;
        } else {
            r = xq[3 + t] + (xq[2 + t] - xq[3 + t]) * mur;
            const float kx = xk[3 + t] + (xk[2 + t] - xk[3 + t]) * muk;
            v = xv[3 + t] + (xv[2 + t] - xv[3 + t]) * muv;
            w = ((const float*)(a.ws + WS_AUXW))[(size_t)row * 256 + ch];
            const float av = bf2f(((const bf16*)(a.ws + WS_AUXA))[(size_t)row * 256 + ch]);
            const float kr = kx * kkw;
            kk = kr * rsqrtf(wave_sum(kr * kr) + 1e-6f);
            k = kx * (1.f + (av - 1.f) * kaw); bb = kk * av;
            const float rk = wave_sum(r * k * rkw);
            if (lane == 0) ((float*)(a.ws + WS_RK))[(size_t)row * 4 + h] = rk;
        }
        wl[lane] = r; wl[64 + lane] = w; wl[128 + lane] = k; wl[192 + lane] = kk; wl[256 + lane] = bb;
        LDS_WAIT();
        float sk = 0.f;
#pragma unroll
        for (int k4 = 0; k4 < 16; ++k4) { const float4 x = *(const float4*)(wl + 192 + 4 * k4); sk += (x.x * S[4 * k4] + x.y * S[4 * k4 + 1]) + (x.z * S[4 * k4 + 2] + x.w * S[4 * k4 + 3]); }
        float y = 0.f;
#pragma unroll
        for (int k4 = 0; k4 < 16; ++k4) {
            const float4 ww = *(const float4*)(wl + 64 + 4 * k4), kx4 = *(const float4*)(wl + 128 + 4 * k4), b4 = *(const float4*)(wl + 256 + 4 * k4), r4 = *(const float4*)(wl + 4 * k4);
            S[4 * k4 + 0] = ww.x * S[4 * k4 + 0] + (kx4.x * v - b4.x * sk); S[4 * k4 + 1] = ww.y * S[4 * k4 + 1] + (kx4.y * v - b4.y * sk);
            S[4 * k4 + 2] = ww.z * S[4 * k4 + 2] + (kx4.z * v - b4.z * sk); S[4 * k4 + 3] = ww.w * S[4 * k4 + 3] + (kx4.w * v - b4.w * sk);
            y += (r4.x * S[4 * k4 + 0] + r4.y * S[4 * k4 + 1]) + (r4.z * S[4 * k4 + 2] + r4.w * S[4 * k4 + 3]);
        }
        yraw[(size_t)row * 256 + ch] = y;
        LDS_WAIT();
    }
    {
        float* sp = a.out + (mixer ? O_SCW : O_SBS) + (((size_t)l * 128 + b) * 4 + h) * 4096 + lane;
#pragma unroll
        for (int k = 0; k < 64; ++k) sp[k * 64] = S[k];
    }
}

__device__ __forceinline__ void phase_scan(const Args& a, int l, unsigned char* lds, int mode = 0) {
    const int tid = otid(), lane = tid & 63, wave = __builtin_amdgcn_readfirstlane(tid >> 6);
    const int G = gridDim.x, g = blockIdx.x;
    float* OB = (float*)lds;
    float* YB = OB + 2 * OPB_FLOATS + 512;
    float* CST = YB + 2 * 8192;
    const bool prod = wave >= 4; const int ptid = tid - 256;
    ChunkD cp = get_chunk(0, g, G, mode), c0 = cp, c1 = get_chunk(1, g, G, mode), c2 = get_chunk(2, g, G, mode);
    Raw RA, RB;
    f2 S01 = {0.f, 0.f}, S23 = {0.f, 0.f}; float Sn[4] = {0.f, 0.f, 0.f, 0.f};
    if (prod) { raw_load(a, l, c0, ptid, RA); prep_math(a, l, c0, RA, OB, CST, ptid); raw_load(a, l, c1, ptid, RA); }
    else if (c0.valid && c0.first && c0.sample) { const float* sp = state_in_ptr(a, l, c0, lane & 15, wave * 4 + (lane >> 4)); Sn[0] = sp[0]; Sn[1] = sp[64]; Sn[2] = sp[128]; Sn[3] = sp[192]; }
    __syncthreads();
    int idx = 0;
    while (c0.valid) {
        if (!prod) consume_chunk(a, l, c0, c1, OB + (idx & 1) * OPB_FLOATS, YB + (idx & 1) * 8192, S01, S23, Sn, wave, lane);
        else { raw_load(a, l, c2, ptid, RB); prep_math(a, l, c1, RA, OB + ((idx + 1) & 1) * OPB_FLOATS, CST, ptid); if (idx > 0) flush_y(a, cp, YB + ((idx - 1) & 1) * 8192, ptid); }
        __syncthreads();
        cp = c0; c0 = c1; c1 = c2; c2 = get_chunk(idx + 3, g, G, mode); ++idx;
        if (!c0.valid) break;
        if (!prod) consume_chunk(a, l, c0, c1, OB + (idx & 1) * OPB_FLOATS, YB + (idx & 1) * 8192, S01, S23, Sn, wave, lane);
        else { raw_load(a, l, c2, ptid, RA); prep_math(a, l, c1, RB, OB + ((idx + 1) & 1) * OPB_FLOATS, CST, ptid); flush_y(a, cp, YB + ((idx - 1) & 1) * 8192, ptid); }
        __syncthreads();
        cp = c0; c0 = c1; c1 = c2; c2 = get_chunk(idx + 3, g, G, mode); ++idx;
    }
    if (prod && idx > 0) flush_y(a, cp, YB + ((idx - 1) & 1) * 8192, ptid);
    __syncthreads();
    if (mode != 1) {
        float* wl = (float*)lds + wave * 320;
        if ((G & 1) == 0) { if (g & 1) for (int it = (g >> 1) * 8 + wave; it < 1024; it += (G >> 1) * 8) sample_item(a, l, it, wl, lane); }
        else for (int it = g * 8 + wave; it < 1024; it += G * 8) sample_item(a, l, it, wl, lane);
        __syncthreads();
    }
}

__device__ __forceinline__ void phase_post(const Args& a, int l) {
    const int tid = otid(), lane = tid & 63, wave = tid >> 6;
    const int gw = blockIdx.x * 8 + wave, NGW = gridDim.x * 8;
    const bf16* P = (const bf16*)(a.ws + WS_P);
    bf16* mixed = (bf16*)(a.ws + WS_MIXED);
    const float* yraw = (const float*)(a.ws + WS_XB);
    const int h = lane >> 4, col = lane * 4;
    for (int r = gw; r < TT; r += NGW) {
        const bf16* Prow = P + (size_t)r * PN;
        {
            const float4 o = *(const float4*)(yraw + (size_t)r * 256 + col);
            const float ss = sum16((o.x * o.x + o.y * o.y) + (o.z * o.z + o.w * o.w));
            const float rstd = rsqrtf(ss * (1.f / 64.f) + NORM_EPS);
            float gt[4]; ld4(Prow + PC_BG + col, gt);
            const float* on = a.in[I_BON] + l * 64 + (col & 63);
            uint2 w; w.x = pk2(o.x * rstd * on[0] * silu(gt[0]), o.y * rstd * on[1] * silu(gt[1])); w.y = pk2(o.z * rstd * on[2] * silu(gt[2]), o.w * rstd * on[3] * silu(gt[3]));
            *(uint2*)(mixed + (size_t)r * 1024 + 256 + col) = w;
        }
        {
            const float4 y = *(const float4*)(yraw + (size_t)TT * 256 + (size_t)r * 256 + col);
            const float mean = sum16((y.x + y.y) + (y.z + y.w)) * (1.f / 64.f);
            const float d0 = y.x - mean, d1 = y.y - mean, d2 = y.z - mean, d3 = y.w - mean;
            const float var = sum16((d0 * d0 + d1 * d1) + (d2 * d2 + d3 * d3)) * (1.f / 64.f);
            const float rstd = rsqrtf(var + 64e-5f);
            float vc[4], vp[4], gg[4]; ld4(Prow + PC_C + 512 + col, vc); prev_c<4>(a, l, r, 512 + col, vp);
            ld4((const bf16*)(a.ws + WS_AUXG) + (size_t)r * 256 + col, gg);
            const float* mu = a.in[I_CMU] + l * 1024 + 512 + col;
            const float* lg = a.in[I_CLG] + l * 256 + col; const float* lb = a.in[I_CLB] + l * 256 + col;
            const float rk = ((const float*)(a.ws + WS_RK))[(size_t)r * 4 + h];
            const float dd[4] = {d0, d1, d2, d3}; float o[4];
#pragma unroll
            for (int i = 0; i < 4; ++i) { const float v = vc[i] + (vp[i] - vc[i]) * mu[i]; o[i] = (dd[i] * rstd * lg[i] + lb[i] + rk * v) * gg[i]; }
            uint2 w; w.x = pk2(o[0], o[1]); w.y = pk2(o[2], o[3]);
            *(uint2*)(mixed + (size_t)r * 1024 + 512 + col) = w;
        }
    }
}

__device__ __forceinline__ void phase_final(const Args& a) {
    const int tid = otid(), lane = tid & 63, wave = tid >> 6;
    const int gw = blockIdx.x * 8 + wave, NGW = gridDim.x * 8;
    const float* rss = (const float*)(a.ws + WS_ROWSS) + 4 * TT;
    for (int r = gw; r < TT; r += NGW) {
        const float rs = rsqrtf(rss[r] * (1.f / 1024.f) + NORM_EPS);
        float4* xo = (float4*)(a.out + (size_t)r * 1024);
#pragma unroll
        for (int j = 0; j < 4; ++j) { float4 v = xo[lane + 64 * j]; const float4 g = ((const float4*)a.in[I_FG])[lane + 64 * j]; v.x *= rs * g.x; v.y *= rs * g.y; v.z *= rs * g.z; v.w *= rs * g.w; xo[lane + 64 * j] = v; }
    }
}

#ifndef MK_PER_PHASE
#define MK_PER_PHASE 0
#endif
#ifndef USE_SKINNY
#define USE_SKINNY 0
#endif
constexpr int GM = USE_SKINNY ? T_P : TT;
#ifndef SCAN_PROBE_MODE
#define SCAN_PROBE_MODE 0
#endif
#ifndef PRE_PROBE_MODE
#define PRE_PROBE_MODE 0
#endif
#ifndef REP_P0
#define REP_P0 1
#endif
#ifndef REP_GIN
#define REP_GIN 1
#endif
#ifndef REP_PRE
#define REP_PRE 1
#endif
#ifndef REP_SCAN
#define REP_SCAN 1
#endif
#ifndef REP_POST
#define REP_POST 1
#endif
#ifndef REP_GUP
#define REP_GUP 1
#endif
__global__ void __launch_bounds__(512, 2) mk_fwd(Args a) {
    extern __shared__ __attribute__((aligned(16))) unsigned char lds[];
    cg::grid_group grid = cg::this_grid();
    const int lo = a.ph_lo, hi = a.ph_hi, G = gridDim.x;
    volatile LAS unsigned* bst = (volatile LAS unsigned*)((LAS unsigned char*)lds + (LDS_BYTES - 16));
    if (threadIdx.x < 4) bst[threadIdx.x] = 0u;
    __syncthreads();
    XcdBarrier xbar; xbar.bar = (unsigned*)(a.ws + WS_BAR); xbar.x = 0; xbar.st = nullptr;
    if (!MK_PER_PHASE) xbar = xcd_barrier_post((unsigned*)(a.ws + WS_BAR), bst);
#define IN(k) (lo <= (k) && (k) < hi)
#define SEAM(k) do { if (lo <= (k) && (k) + 1 < hi) { if ((k) == 0) grid.sync(); else xcd_barrier(xbar); } } while (0)
#define REPEAT(n) for (int rep_ = 0; rep_ < (n); ++rep_, (rep_ < (n) ? xcd_barrier(xbar) : (void)0))
    float* rowss = (float*)(a.ws + WS_ROWSS);
    bf16* xb = (bf16*)(a.ws + WS_XB); bf16* P = (bf16*)(a.ws + WS_P); bf16* mixed = (bf16*)(a.ws + WS_MIXED); bf16* hid = (bf16*)(a.ws + WS_HID);
    if (IN(0)) REPEAT(REP_P0) phase0(a, lds);
    SEAM(0);
    for (int l = 0; l < 2; ++l) {
        const int pb = 1 + 7 * l;
        const bf16* wb = (const bf16*)(a.ws + WS_W) + (size_t)l * WL_ELEMS;
        if (IN(pb + 0)) REPEAT(REP_GIN) {
            pg8::Gemm g{xb, wb + WOFF_IN, GM, NIN, 1024}; pg8::StaticOrder S; S.init(GM, NIN, G, (int)blockIdx.x);
            EpiScale<false> E{P, PN, rowss + (2 * l) * TT};
            pg8::gemm_phase<EpiScale<false>, pg8::StaticOrder, true, true>((PG8_LAS unsigned char*)lds, g, S, E);
#if USE_SKINNY
            SkScale<false> E2{P, PN, rowss + (2 * l) * TT};
            skinny_gemm(xb + (size_t)T_P * 1024, wb + WOFF_IN, PN, 1024, E2);
#endif
        }
        SEAM(pb + 0);
        if (IN(pb + 1)) REPEAT(REP_PRE) phase_pre(a, l, lds, rep_ == 0 ? 0 : PRE_PROBE_MODE);
        SEAM(pb + 1);
        if (IN(pb + 2)) REPEAT(REP_SCAN) phase_scan(a, l, lds, rep_ == 0 ? 0 : SCAN_PROBE_MODE);
        SEAM(pb + 2);
        if (IN(pb + 3)) REPEAT(REP_POST) phase_post(a, l);
        SEAM(pb + 3);
        if (IN(pb + 4)) {
            pg8::Gemm g{mixed, wb + WOFF_OUT, GM, 1024, 1024};
            if (G == 256 && !USE_SKINNY && !MK_PER_PHASE) {
                DownOrder S; S.c = (int)blockIdx.x; S.snt = 2;
                EpiResSplit E{a.out, xb, rowss + (2 * l + 1) * TT, (float*)(a.ws + WS_AUXW), l == 0 ? a.in[I_XP] : nullptr, l == 0 ? a.in[I_XS] : nullptr};
                pg8::gemm_phase<EpiResSplit, DownOrder, true, true>((PG8_LAS unsigned char*)lds, g, S, E);
                xcd_barrier(xbar);
                sample_fix(a, rowss + (2 * l + 1) * TT, (const float*)(a.ws + WS_AUXW), l == 0 ? a.in[I_XS] : nullptr);
            } else {
                pg8::StaticOrder S; S.init(GM, 1024, G, (int)blockIdx.x);
                EpiRes E{a.out, xb, rowss + (2 * l + 1) * TT, l == 0 ? a.in[I_XP] : nullptr, l == 0 ? a.in[I_XS] : nullptr};
                pg8::gemm_phase<EpiRes, pg8::StaticOrder, true, true>((PG8_LAS unsigned char*)lds, g, S, E);
#if USE_SKINNY
                SkRes E2{a.out, xb, rowss + (2 * l + 1) * TT};
                skinny_gemm(mixed + (size_t)T_P * 1024, wb + WOFF_OUT, 1024, 1024, E2);
#endif
            }
        }
        SEAM(pb + 4);
        if (IN(pb + 5)) REPEAT(REP_GUP) {
            pg8::Gemm g{xb, wb + WOFF_UP, GM, FF, 1024}; pg8::StaticOrder S; S.init(GM, FF, G, (int)blockIdx.x);
            EpiScale<true> E{hid, FF, rowss + (2 * l + 1) * TT};
            pg8::gemm_phase<EpiScale<true>, pg8::StaticOrder, true, true>((PG8_LAS unsigned char*)lds, g, S, E);
            if (l == 0 && !MK_PER_PHASE && G == 256 && blockIdx.x >= 32) {
                const int tid_ = otid();
                convert_layer(a, 1, (float*)(lds + (tid_ >> 6) * 16384), ((int)blockIdx.x - 32) * 8 + (tid_ >> 6), (G - 32) * 8, tid_ & 63);
            }
#if USE_SKINNY
            SkScale<true> E2{hid, FF, rowss + (2 * l + 1) * TT};
            skinny_gemm(xb + (size_t)T_P * 1024, wb + WOFF_UP, FF, 1024, E2);
#endif
        }
        SEAM(pb + 5);
        if (IN(pb + 6)) {
            pg8::Gemm g{hid, wb + WOFF_DOWN, GM, 1024, FF};
            if (G == 256 && !USE_SKINNY && !MK_PER_PHASE) {
                DownOrder S; S.c = (int)blockIdx.x; S.snt = 8;
                if (l == 1) {
                    EpiResFinal E{a.out, rowss + 4 * TT, (float*)(a.ws + WS_AUXW), a.in[I_FG], (unsigned*)(a.ws + WS_PCNT)};
                    pg8::gemm_phase<EpiResFinal, DownOrder, true, true>((PG8_LAS unsigned char*)lds, g, S, E);
                    xcd_barrier(xbar);
                    sample_fix_final(a, (const float*)(a.ws + WS_AUXW));
                } else {
                EpiResSplit E{a.out, xb, rowss + (2 * l + 2) * TT, (float*)(a.ws + WS_AUXW), nullptr, nullptr};
                pg8::gemm_phase<EpiResSplit, DownOrder, true, true>((PG8_LAS unsigned char*)lds, g, S, E);
                xcd_barrier(xbar);
                sample_fix(a, rowss + (2 * l + 2) * TT, (const float*)(a.ws + WS_AUXW));
                }
            } else {
                pg8::StaticOrder S; S.init(GM, 1024, G, (int)blockIdx.x);
                EpiRes E{a.out, xb, rowss + (2 * l + 2) * TT, nullptr, nullptr};
                pg8::gemm_phase<EpiRes, pg8::StaticOrder, true, true>((PG8_LAS unsigned char*)lds, g, S, E);
#if USE_SKINNY
                SkRes E2{a.out, xb, rowss + (2 * l + 2) * TT};
                skinny_gemm(hid + (size_t)T_P * FF, wb + WOFF_DOWN, 1024, FF, E2);
#endif
            }
        }
        if (!(l == 1 && G == 256 && !USE_SKINNY && !MK_PER_PHASE)) SEAM(pb + 6);
    }
    if (IN(15) && !(G == 256 && !USE_SKINNY && !MK_PER_PHASE)) phase_final(a);
#undef IN
#undef SEAM
}

extern "C" void kernel_launch(void* const* d_in, const int* in_sizes, int n_in, void* d_out, int out_size, void* d_ws, size_t ws_size, hipStream_t stream) {
    static int grid = 0;
    if (grid == 0) {
        int dev = 0, cus = 0, per_cu = 0;
        (void)hipGetDevice(&dev);
        (void)hipDeviceGetAttribute(&cus, hipDeviceAttributeMultiprocessorCount, dev);
        if (hipFuncSetAttribute((const void*)mk_fwd, hipFuncAttributeMaxDynamicSharedMemorySize, LDS_BYTES) != hipSuccess) { fprintf(stderr, "kernel_launch: hipFuncSetAttribute failed\n"); }
        if (hipOccupancyMaxActiveBlocksPerMultiprocessor(&per_cu, (const void*)mk_fwd, 512, LDS_BYTES) != hipSuccess || per_cu < 1) { fprintf(stderr, "kernel_launch: occupancy query reports %d\n", per_cu); per_cu = 1; }
        (void)hipGetLastError();
        if (per_cu > 1) per_cu = 1;
        if (cus <= 0) cus = 256;
        grid = cus * per_cu;
    }
    Args a{};
    for (int i = 0; i < 34; ++i) a.in[i] = (const float*)d_in[i];
    a.out = (float*)d_out; a.ws = (unsigned char*)d_ws;
    (void)hipMemsetAsync((unsigned char*)d_ws + WS_BAR, 0, BAR_ZERO_BYTES, stream);
#if MK_PER_PHASE
    for (int ph = 0; ph < NPHASE; ++ph) { a.ph_lo = ph; a.ph_hi = ph + 1; hipLaunchKernelGGL(mk_fwd, dim3(grid), dim3(512), LDS_BYTES, stream, a); }
#else
    a.ph_lo = 0; a.ph_hi = NPHASE;
    void* args[] = {&a};
    const hipError_t e = hipLaunchCooperativeKernel((const void*)mk_fwd, dim3(grid), dim3(512), args, LDS_BYTES, stream);
    if (e != hipSuccess) fprintf(stderr, "cooperative launch failed: %s (grid %d)\n", hipGetErrorString(e), grid);
#endif
}
```

```cpp
#include <hip/hip_runtime.h>
#include <hip/hip_cooperative_groups.h>
#include <cstdio>
#include <cstdint>
namespace cg = cooperative_groups;
#define MK_PER_PHASE 0
namespace pg8 {
#define PG8_LAS __attribute__((address_space(3)))
typedef unsigned short bf16_t;
typedef short bf16x8 __attribute__((ext_vector_type(8)));
typedef float f32x4 __attribute__((ext_vector_type(4)));
typedef unsigned u32x4 __attribute__((ext_vector_type(4)));
constexpr int BM = 256, BK = 64, HALF = 128, HTB = HALF * BK * 2  , STAGE_BYTES = 8 * HTB, NXCD = 8, WGM = 8;

__host__ __device__ __forceinline__ int lds_byte(int r, int c) { const int st = (r >> 4) * 2 + (c >> 5), rr = r & 15, cc = c & 31, ob = rr * 64 + cc * 2; return st * 1024 + (ob ^ (((ob >> 9) & 1) << 5)); }
__host__ __device__ __forceinline__ void stage_rc(int b, int& R, int& C) { const int st = b / 1024, sb = b % 1024, swz = sb ^ (((sb >> 9) & 1) << 5); R = (st >> 1) * 16 + swz / 64; C = (st & 1) * 32 + (swz % 64) / 2; }
__host__ __device__ __forceinline__ int perm32(int rho) { const int n = rho >> 4, i = rho & 15; return 8 * (i >> 2) + 4 * n + (i & 3); }

struct Unit { int pm, pn, kofs, nt, part; };
struct Gemm { const bf16_t* A; const bf16_t* Bt; int M, N, K; };

struct StaticOrder {
    int nM, nN, nwg, G, c;
    __host__ __device__ void init(int M, int N, int G_, int c_) { nM = M / BM; nN = N / BM; nwg = nM * nN; G = G_; c = c_; }
    __host__ __device__ bool next(int i, Unit& u) const {
        const long L = (long)i * G + c; if (L >= nwg) return false;
        int wgid = (int)L; { const int q = nwg / NXCD, r = nwg % NXCD, xcd = wgid % NXCD, off = wgid / NXCD; wgid = (xcd < r ? xcd * (q + 1) : r * (q + 1) + (xcd - r) * q) + off; }
        const int nig = WGM * nN, gid = wgid / nig, fm = gid * WGM, gsz = (nM - fm) < WGM ? (nM - fm) : WGM;
        u.pm = fm + ((wgid % nig) % gsz); u.pn = (wgid % nig) / gsz; u.kofs = 0; u.nt = 0; u.part = -1; return true;
    }
    __device__ __forceinline__ void a_ready(const Unit&) const {}
    __device__ __forceinline__ void done(const Unit&) const {}
};

__device__ __forceinline__ unsigned cvt_pk_bf16(float lo, float hi) { unsigned r; asm volatile("v_cvt_pk_bf16_f32 %0, %1, %2" : "=v"(r) : "v"(lo), "v"(hi)); return r; }
typedef float f32x2 __attribute__((ext_vector_type(2)));
template <class Epi, class Sched, bool ALIGN_EPI = false, bool SP2 = false>
__device__ __forceinline__ void gemm_phase(PG8_LAS unsigned char* lds, const Gemm g, const Sched& S, const Epi& E) {
    int tid_ = threadIdx.x; asm volatile("" : "+v"(tid_)); const int tid = tid_, wid = __builtin_amdgcn_readfirstlane(tid >> 6), lane = tid & 63, wr = wid >> 2, wc = wid & 3, fr = lane & 15, fq = lane >> 4;
    const int K = g.K, nt = K / BK;
    unsigned voffA[2], voffB[2];
#pragma unroll
    for (int i = 0; i < 2; ++i) { int R, C; stage_rc(tid * 16 + i * 8192, R, C); const int Rb = Epi::PERM ? ((R & ~31) + perm32(R & 31)) : R;
        voffA[i] = (unsigned)(R * K + C) * 2u; voffB[i] = (unsigned)(Rb * K + C) * 2u; }
    const size_t kstep = (size_t)(BK * 2);
    const size_t hstep = (size_t)HALF * K * 2;
    const size_t tstep = 2 * hstep;
    const unsigned ldsw = (unsigned)wid * 1024u;
    const int aoff = lds_byte(wr * 64 + fr, fq * 8), boff = lds_byte(wc * 32 + fr, fq * 8);
#define PG8_SA(b, h) (((b) * 2 + (h)) * HTB)
#define PG8_SB(b, h) ((4 + (b) * 2 + (h)) * HTB)
#define PG8_STAGE(bufoff, gbase, voff) do { _Pragma("unroll") for (int _i = 0; _i < 2; ++_i) \
        __builtin_amdgcn_global_load_lds((const unsigned*)((const char*)(gbase) + (voff)[_i]), (PG8_LAS unsigned*)(lds + (bufoff) + ldsw + _i * 8192), 16, 0, 0); } while (0)
#define PG8_LDA(dst, b, h) do { _Pragma("unroll") for (int m = 0; m < 4; ++m) _Pragma("unroll") for (int k = 0; k < 2; ++k) dst[m][k] = *(const PG8_LAS bf16x8*)(lds + PG8_SA(b, h) + aoff + m * 2048 + k * 1024); } while (0)
#define PG8_LDB(dst, b, h) do { _Pragma("unroll") for (int n = 0; n < 2; ++n) _Pragma("unroll") for (int k = 0; k < 2; ++k) dst[n][k] = *(const PG8_LAS bf16x8*)(lds + PG8_SB(b, h) + boff + n * 2048 + k * 1024); } while (0)
#define PG8_MMA(ai, bj, At, Bt) do { __builtin_amdgcn_s_setprio(1); _Pragma("unroll") for (int m = 0; m < 4; ++m) _Pragma("unroll") for (int n = 0; n < 2; ++n) _Pragma("unroll") for (int k = 0; k < 2; ++k) \
        acc[ai][bj][m][n] = __builtin_amdgcn_mfma_f32_16x16x32_bf16(Bt[n][k], At[m][k], acc[ai][bj][m][n], 0, 0, 0); __builtin_amdgcn_s_setprio(0); } while (0)
#define PG8_WAIT_V(n) asm volatile("s_waitcnt vmcnt(" #n ")" ::: "memory")
#define PG8_WAIT_L(n) asm volatile("s_waitcnt lgkmcnt(" #n ")" ::: "memory")
#define PG8_BAR __builtin_amdgcn_s_barrier()
#define PG8_SCHED __builtin_amdgcn_sched_barrier(0)
    Unit cur, nxt; int ui = 0;
    if (!S.next(0, cur)) return;
    f32x4 acc[2][2][4][2];
#pragma unroll
    for (int a = 0; a < 2; ++a)
#pragma unroll
        for (int b = 0; b < 2; ++b)
#pragma unroll
            for (int m = 0; m < 4; ++m)
#pragma unroll
                for (int n = 0; n < 2; ++n) acc[a][b][m][n] = (f32x4){0.f, 0.f, 0.f, 0.f};
    bf16x8 At[4][2], B0[2][2], B1[2][2];
    const char* cA = (const char*)g.A + (size_t)cur.pm * tstep + cur.kofs; const char* cB = (const char*)g.Bt + (size_t)cur.pn * tstep + cur.kofs;
    S.a_ready(cur);
    if constexpr (SP2) {
        PG8_STAGE(PG8_SB(0, 0), cB, voffB); PG8_STAGE(PG8_SB(0, 1), cB + hstep, voffB); PG8_STAGE(PG8_SA(0, 0), cA, voffA); PG8_STAGE(PG8_SA(0, 1), cA + hstep, voffA);
        if (wr == 1) PG8_BAR;
        PG8_WAIT_V(2); PG8_BAR;
        PG8_STAGE(PG8_SB(1, 0), cB + kstep, voffB); PG8_STAGE(PG8_SA(1, 0), cA + kstep, voffA); PG8_STAGE(PG8_SB(1, 1), cB + hstep + kstep, voffB);
        PG8_WAIT_V(6); PG8_BAR;
    } else {
        PG8_STAGE(PG8_SB(0, 0), cB, voffB); PG8_STAGE(PG8_SA(0, 0), cA, voffA); PG8_STAGE(PG8_SB(0, 1), cB + hstep, voffB); PG8_STAGE(PG8_SA(0, 1), cA + hstep, voffA);
        if (wr == 1) PG8_BAR;
        PG8_WAIT_V(4); PG8_BAR;
        PG8_STAGE(PG8_SB(1, 0), cB + kstep, voffB); PG8_STAGE(PG8_SA(1, 0), cA + kstep, voffA); PG8_STAGE(PG8_SB(1, 1), cB + hstep + kstep, voffB);
        PG8_WAIT_V(6); PG8_BAR;
    }
    for (;;) {
        const bool has_next = S.next(ui + 1, nxt);
        const char* nA = has_next ? (const char*)g.A + (size_t)nxt.pm * tstep + nxt.kofs : cA; const char* nB = has_next ? (const char*)g.Bt + (size_t)nxt.pn * tstep + nxt.kofs : cB;
        const int cnt = cur.nt ? cur.nt : nt;
        for (int t = 0; t < cnt; t += 2) {
            const bool last = (t == cnt - 2);
            const char* a1 = cA + (size_t)(t + 1) * kstep;
            const char* a2 = last ? nA : cA + (size_t)(t + 2) * kstep; const char* b2 = last ? nB : cB + (size_t)(t + 2) * kstep;
            const char* a3 = a2 + kstep; const char* b3 = b2 + kstep;
            if (last && has_next) S.a_ready(nxt);
            if constexpr (SP2) {
            PG8_LDB(B0, 0, 0); PG8_LDB(B1, 0, 1); PG8_SCHED; PG8_LDA(At, 0, 0); PG8_STAGE(PG8_SA(1, 1), a1 + hstep, voffA);
            PG8_WAIT_V(8); PG8_WAIT_L(0); PG8_BAR; PG8_MMA(0, 0, At, B0); PG8_MMA(0, 1, At, B1); PG8_BAR; PG8_SCHED;
            PG8_LDA(At, 0, 1); PG8_STAGE(PG8_SB(0, 0), b2, voffB); PG8_STAGE(PG8_SB(0, 1), b2 + hstep, voffB); PG8_STAGE(PG8_SA(0, 0), a2, voffA);
            PG8_WAIT_V(8); PG8_WAIT_L(0); PG8_BAR; PG8_MMA(1, 0, At, B0); PG8_MMA(1, 1, At, B1); PG8_BAR; PG8_SCHED;
            PG8_LDB(B0, 1, 0); PG8_LDB(B1, 1, 1); PG8_SCHED; PG8_LDA(At, 1, 0); PG8_STAGE(PG8_SA(0, 1), a2 + hstep, voffA);
            PG8_WAIT_V(8); PG8_WAIT_L(0); PG8_BAR; PG8_MMA(0, 0, At, B0); PG8_MMA(0, 1, At, B1); PG8_BAR; PG8_SCHED;
            PG8_LDA(At, 1, 1); PG8_STAGE(PG8_SB(1, 0), b3, voffB); PG8_STAGE(PG8_SB(1, 1), b3 + hstep, voffB); PG8_STAGE(PG8_SA(1, 0), a3, voffA);
            PG8_WAIT_V(8); PG8_WAIT_L(0); PG8_BAR; PG8_MMA(1, 0, At, B0); PG8_MMA(1, 1, At, B1); PG8_BAR; PG8_SCHED;
            } else {
            PG8_LDB(B0, 0, 0); PG8_SCHED; PG8_LDA(At, 0, 0); PG8_STAGE(PG8_SA(1, 1), a1 + hstep, voffA);
            PG8_WAIT_L(8); PG8_BAR; PG8_WAIT_L(0); PG8_MMA(0, 0, At, B0); PG8_BAR; PG8_SCHED;
            PG8_LDB(B1, 0, 1); PG8_STAGE(PG8_SB(0, 0), b2, voffB);
            PG8_BAR; PG8_WAIT_L(0); PG8_MMA(0, 1, At, B1); PG8_BAR;
            PG8_LDA(At, 0, 1); PG8_STAGE(PG8_SA(0, 0), a2, voffA);
            PG8_BAR; PG8_WAIT_L(0); PG8_MMA(1, 0, At, B0); PG8_BAR; PG8_SCHED;
            PG8_STAGE(PG8_SB(0, 1), b2 + hstep, voffB);
            PG8_WAIT_V(6); PG8_BAR; PG8_MMA(1, 1, At, B1); PG8_BAR;
            PG8_LDB(B0, 1, 0); PG8_SCHED; PG8_LDA(At, 1, 0); PG8_STAGE(PG8_SA(0, 1), a2 + hstep, voffA);
            PG8_WAIT_L(8); PG8_BAR; PG8_WAIT_L(0); PG8_MMA(0, 0, At, B0); PG8_BAR; PG8_SCHED;
            PG8_LDB(B1, 1, 1); PG8_STAGE(PG8_SB(1, 0), b3, voffB);
            PG8_BAR; PG8_WAIT_L(0); PG8_MMA(0, 1, At, B1); PG8_BAR;
            PG8_LDA(At, 1, 1); PG8_STAGE(PG8_SA(1, 0), a3, voffA);
            PG8_BAR; PG8_WAIT_L(0); PG8_MMA(1, 0, At, B0); PG8_BAR; PG8_SCHED;
            PG8_STAGE(PG8_SB(1, 1), b3 + hstep, voffB);
            PG8_WAIT_V(6); PG8_BAR; PG8_MMA(1, 1, At, B1); PG8_BAR;
            }
        }
        if constexpr (ALIGN_EPI) { if (wr == 0) PG8_BAR; }
        if constexpr (!Epi::AFTER_DRAIN) { E(acc, cur, wr, wc, fr, fq); S.done(cur); }
        if (!has_next) break;
#pragma unroll
        for (int a = 0; a < 2; ++a)
#pragma unroll
            for (int b = 0; b < 2; ++b)
#pragma unroll
                for (int m = 0; m < 4; ++m)
#pragma unroll
                    for (int n = 0; n < 2; ++n) acc[a][b][m][n] = (f32x4){0.f, 0.f, 0.f, 0.f};
        cur = nxt; cA = nA; cB = nB; ++ui;
        if constexpr (ALIGN_EPI) { if (wr == 1) PG8_BAR; }
    }
    PG8_WAIT_V(0);
    if constexpr (!ALIGN_EPI) { if (wr == 0) PG8_BAR; }
    PG8_BAR;
    if constexpr (Epi::AFTER_DRAIN) { E.fused(acc, cur, wr, wc, fr, fq, lds, wid, lane); S.done(cur); }
#undef PG8_SA
#undef PG8_SB
#undef PG8_STAGE
#undef PG8_LDA
#undef PG8_LDB
#undef PG8_MMA
#undef PG8_WAIT_V
#undef PG8_WAIT_L
#undef PG8_BAR
#undef PG8_SCHED
}
}

#define LAS __attribute__((address_space(3)))

#define XB_TMO      128
#define XB_XCNT(j)  (256  + 64 * (j))
#define XB_XSUB(j)  (1280 + 64 * (j))
#define XB_XGEN(j)  (2304 + 64 * (j))
#define XB_TOP      3328
#define XB_TOPGEN   3392
#define XCD_BAR_WORDS 3456
#define XB_SPIN_CAP (1u << 18)

__device__ __forceinline__ unsigned xb_ld(unsigned* p)              { return __hip_atomic_load(p, __ATOMIC_RELAXED, __HIP_MEMORY_SCOPE_AGENT); }
__device__ __forceinline__ unsigned xb_add(unsigned* p, unsigned v) { return __hip_atomic_fetch_add(p, v, __ATOMIC_RELAXED, __HIP_MEMORY_SCOPE_AGENT); }
__device__ __forceinline__ unsigned xb_xcc_id() { return (unsigned)__builtin_amdgcn_s_getreg((3 << 11) | 20) & 0xFu; }
#define XB_SPIN(cond, bar) do { unsigned _sp = 0; while (cond) { __builtin_amdgcn_s_sleep(1); \
    if ((++_sp & 255u) == 0u) { if (xb_ld(&(bar)[XB_TMO])) break; if (_sp > XB_SPIN_CAP) { atomicAdd(&(bar)[XB_TMO], 1u); break; } } } } while (0)

struct XcdBarrier {
    unsigned* bar; unsigned x;
    volatile LAS unsigned* st;
};

__device__ __forceinline__ XcdBarrier xcd_barrier_post(unsigned* bar, volatile LAS unsigned* st) {
    XcdBarrier b; b.bar = bar; b.x = xb_xcc_id(); b.st = st;
    if (threadIdx.x == 0) (void)xb_add(&bar[XB_XCNT(b.x)], 1u);
    return b;
}
__device__ __forceinline__ void xcd_barrier_complete(unsigned* bar, unsigned x, unsigned& nloc, unsigned& nx) {
    const unsigned G = gridDim.x * gridDim.y * gridDim.z;
    unsigned sum, cnt, mine, sp = 0u;
    for (;;) {
        sum = 0u; cnt = 0u; mine = 0u;
#pragma unroll
        for (unsigned j = 0; j < 16; ++j) { const unsigned c = xb_ld(&bar[XB_XCNT(j)]); sum += c; cnt += (c > 0u) ? 1u : 0u; mine = (j == x) ? c : mine; }
        if (sum == G) break;
        __builtin_amdgcn_s_sleep(1);
        if ((++sp & 255u) == 0u) { if (xb_ld(&bar[XB_TMO])) break; if (sp > XB_SPIN_CAP) { atomicAdd(&bar[XB_TMO], 1u); break; } }
    }
    nloc = mine > 0u ? mine : 1u; nx = cnt > 0u ? cnt : 1u;
}

__device__ __forceinline__ void xcd_barrier(const XcdBarrier& b) {
    asm volatile("s_waitcnt vmcnt(0)" ::: "memory");
    __syncthreads();
    if (threadIdx.x == 0) {
        unsigned* bar = b.bar;
        __builtin_amdgcn_s_waitcnt(0);
        unsigned nloc = b.st[0], nx = b.st[1];
        if (nloc == 0u) { xcd_barrier_complete(bar, b.x, nloc, nx); b.st[0] = nloc; b.st[1] = nx; }
        const unsigned old = xb_add(&bar[XB_XSUB(b.x)], 1u);
        const unsigned gen = old / nloc;
        if (old + 1u == (gen + 1u) * nloc) {
            __builtin_amdgcn_fence(__ATOMIC_RELEASE, "agent");
            asm volatile("s_waitcnt vmcnt(0)" ::: "memory");
            const unsigned og = xb_add(&bar[XB_TOP], 1u);
            const unsigned tg = og / nx;
            if (og + 1u == (tg + 1u) * nx) xb_add(&bar[XB_TOPGEN], 1u);
            else XB_SPIN(xb_ld(&bar[XB_TOPGEN]) == tg, bar);
            __builtin_amdgcn_fence(__ATOMIC_ACQUIRE, "agent");
            xb_add(&bar[XB_XGEN(b.x)], 1u);
            asm volatile("s_waitcnt vmcnt(0)" ::: "memory");
        } else {
            XB_SPIN(xb_ld(&bar[XB_XGEN(b.x)]) == gen, bar);
            __builtin_amdgcn_fence(__ATOMIC_ACQUIRE, "agent");
            asm volatile("s_waitcnt vmcnt(0)" ::: "memory");
        }
    }
    __syncthreads();
}

typedef unsigned short bf16;
typedef pg8::f32x4 f32x4;
typedef pg8::u32x4 u32x4;
constexpr int DM = 1024, T_P = 16384, T_S = 512, TT = 16896, PN = 3072, NIN = 2816, FF = 4096;
constexpr float NORM_EPS = 1e-6f;
constexpr int PC_A = 0, PC_BQ = 512, PC_BK = 768, PC_BV = 1024, PC_BG = 1280, PC_C = 1536, PC_D = 2560, PC_BA = 2816;
constexpr size_t MiB = 1u << 20;
constexpr size_t WS_ROWSS = 0;
constexpr size_t WS_RK = 512 * 1024;
constexpr size_t WS_BAR = 800 * 1024;
constexpr size_t WS_PCNT = WS_BAR + 14336;
constexpr size_t BAR_ZERO_BYTES = 14336 + 64 * 256;
constexpr size_t WS_W = 1 * MiB;
constexpr size_t WS_XB = 49 * MiB;
constexpr size_t WS_P = 82 * MiB;
constexpr size_t WS_MIXED = 181 * MiB;
constexpr size_t WS_HID = 82 * MiB;
constexpr size_t WS_AUXW = 214 * MiB;
constexpr size_t WS_AUXA = WS_AUXW + (size_t)TT * 256 * 4;
constexpr size_t WS_AUXG = WS_AUXA + (size_t)TT * 256 * 2;
constexpr size_t WS_LW = WS_AUXG + (size_t)TT * 256 * 2;
constexpr size_t WS_BAW = WS_LW + 2 * 81920 * 2;
constexpr size_t WS_BA = WS_BAW + 2 * 16 * 1024 * 2;
constexpr size_t WS_END = WS_BA + (size_t)TT * 8 * 4;
static_assert(WS_END <= 256 * MiB, "ws map");
constexpr size_t WOFF_IN = 0, WOFF_OUT = 3145728, WOFF_UP = 4194304, WOFF_DOWN = 8388608, WL_ELEMS = 12582912;
constexpr size_t O_YP = 0, O_YS = O_YP + (size_t)T_P * DM, O_PBC = O_YS + (size_t)T_S * DM, O_PBS = O_PBC + 2 * 8 * 3 * 768, O_PCS = O_PBS + 2 * 8 * 4 * 4096,
                 O_PCW = O_PCS + 2 * 8 * 1024, O_PDP = O_PCW + 2 * 8 * 4 * 4096, O_SAV = O_PDP + 2 * 8 * 15 * 256, O_SBC = O_SAV + 2 * 128 * 4 * 256,
                 O_SBS = O_SBC + 2 * 128 * 3 * 768, O_SCS = O_SBS + 2 * 128 * 4 * 4096, O_SCW = O_SCS + 2 * 128 * 1024, O_SDP = O_SCW + 2 * 128 * 4 * 4096,
                 O_END = O_SDP + 2 * 128 * 15 * 256;
static_assert(O_END == 28426240, "d_out map");
constexpr int LDS_BYTES = 163840;
constexpr int NPHASE = 16;

struct Args { const float* in[34]; float* out; unsigned char* ws; int ph_lo, ph_hi; };
enum { I_XP = 0, I_XS, I_SBC, I_SBS, I_SCS, I_SCW, I_SDP, I_N1G, I_WIN, I_AWS, I_ABS, I_AVG, I_BCW, I_BAL, I_BDT, I_BON, I_CMU, I_CW0, I_CW2, I_CA0, I_CA2, I_CG2,
       I_CKK, I_CKA, I_CRK, I_CLG, I_CLB, I_DW, I_DSC, I_WOUT, I_N2G, I_WUP, I_WDN, I_FG };

#define LDS_WAIT() asm volatile("s_waitcnt lgkmcnt(0)" ::: "memory")

__device__ __forceinline__ int otid() { int t = threadIdx.x; asm volatile("" : "+v"(t)); return t; }
__device__ __forceinline__ float bf2f(unsigned h) { return __uint_as_float(h << 16); }
__device__ __forceinline__ unsigned f2bf(float f) { unsigned u = __float_as_uint(f); return (u + 0x7fffu + ((u >> 16) & 1u)) >> 16; }
__device__ __forceinline__ unsigned pk2(float lo, float hi) { return f2bf(lo) | (f2bf(hi) << 16); }
__device__ __forceinline__ void ld8(const bf16* p, float (&o)[8]) {
    const uint4 u = *(const uint4*)p;
    o[0] = __uint_as_float(u.x << 16); o[1] = __uint_as_float(u.x & 0xffff0000u); o[2] = __uint_as_float(u.y << 16); o[3] = __uint_as_float(u.y & 0xffff0000u);
    o[4] = __uint_as_float(u.z << 16); o[5] = __uint_as_float(u.z & 0xffff0000u); o[6] = __uint_as_float(u.w << 16); o[7] = __uint_as_float(u.w & 0xffff0000u);
}
__device__ __forceinline__ void ld4(const bf16* p, float (&o)[4]) {
    const uint2 u = *(const uint2*)p;
    o[0] = __uint_as_float(u.x << 16); o[1] = __uint_as_float(u.x & 0xffff0000u); o[2] = __uint_as_float(u.y << 16); o[3] = __uint_as_float(u.y & 0xffff0000u);
}
__device__ __forceinline__ void ld2(const bf16* p, float (&o)[2]) { const unsigned u = *(const unsigned*)p; o[0] = __uint_as_float(u << 16); o[1] = __uint_as_float(u & 0xffff0000u); }
template <int N> __device__ __forceinline__ void ldbf(const bf16* p, float (&o)[N]);
template <> __device__ __forceinline__ void ldbf<8>(const bf16* p, float (&o)[8]) { ld8(p, o); }
template <> __device__ __forceinline__ void ldbf<4>(const bf16* p, float (&o)[4]) { ld4(p, o); }
template <> __device__ __forceinline__ void ldbf<2>(const bf16* p, float (&o)[2]) { ld2(p, o); }
template <> __device__ __forceinline__ void ldbf<1>(const bf16* p, float (&o)[1]) { o[0] = bf2f(*p); }
template <int N> __device__ __forceinline__ void ldf(const float* p, float (&o)[N]) {
#pragma unroll
    for (int i = 0; i < N; ++i) o[i] = p[i];
}
__device__ __forceinline__ float sigm(float x) { return __builtin_amdgcn_rcpf(1.f + __expf(-x)); }
__device__ __forceinline__ float silu(float x) { return x * sigm(x); }
__device__ __forceinline__ float tanh_(float y) { return 1.f - 2.f * __builtin_amdgcn_rcpf(1.f + __expf(2.f * y)); }
__device__ __forceinline__ float gelu_t(float x) { return 0.5f * x * (1.f + tanh_(0.7978845608028654f * (x + 0.044715f * x * x * x))); }
__device__ __forceinline__ float softplus_(float x) { const float u = __expf(-fabsf(x)); return fmaxf(x, 0.f) + (u < 1e-3f ? u * (1.f - 0.5f * u) : __logf(1.f + u)); }
__device__ __forceinline__ float wave_sum(float v) {
#pragma unroll
    for (int o = 1; o < 64; o <<= 1) v += __shfl_xor(v, o);
    return v;
}
__device__ __forceinline__ float sum8(float v) { v += __shfl_xor(v, 1); v += __shfl_xor(v, 2); v += __shfl_xor(v, 4); return v; }
__device__ __forceinline__ float sum16(float v) { v = sum8(v); v += __shfl_xor(v, 8); return v; }
__device__ __forceinline__ float dpp_sum16(float x) {
    x += __int_as_float(__builtin_amdgcn_update_dpp(0, __float_as_int(x), 0xB1, 0xF, 0xF, false));
    x += __int_as_float(__builtin_amdgcn_update_dpp(0, __float_as_int(x), 0x4E, 0xF, 0xF, false));
    x += __int_as_float(__builtin_amdgcn_update_dpp(0, __float_as_int(x), 0x141, 0xF, 0xF, false));
    x += __int_as_float(__builtin_amdgcn_update_dpp(0, __float_as_int(x), 0x140, 0xF, 0xF, false));
    return x;
}

template <bool RELU2> struct EpiScale {
    static constexpr bool PERM = true, AFTER_DRAIN = false;
    bf16* O; int ldc; const float* rss; float* vss;
    __device__ __forceinline__ void operator()(const f32x4 (&acc)[2][2][4][2], const pg8::Unit& u, int wr, int wc, int fr, int fq) const {
        const int row0 = u.pm * 256 + wr * 64 + fr, col0 = u.pn * 256 + wc * 32 + 8 * fq;
        const bool dov = !RELU2 && vss != nullptr && u.pn == 1;
#pragma unroll
        for (int ai = 0; ai < 2; ++ai)
#pragma unroll
            for (int m = 0; m < 4; ++m) {
                const int r = row0 + ai * 128 + m * 16;
                const float rs = rsqrtf(rss[r] * (1.f / 1024.f) + NORM_EPS);
                bf16* rowp = O + (size_t)r * ldc + col0;
                float gs = 0.f;
#pragma unroll
                for (int bj = 0; bj < 2; ++bj) {
                    f32x4 v0 = acc[ai][bj][m][0] * rs, v1 = acc[ai][bj][m][1] * rs;
                    if (dov) {
#pragma unroll
                        for (int e = 0; e < 4; ++e) { const float g0 = gelu_t(v0[e]), g1 = gelu_t(v1[e]); gs += g0 * g0 + g1 * g1; }
                    }
                    if (RELU2) {
#pragma unroll
                        for (int e = 0; e < 4; ++e) { const float p0 = fmaxf(v0[e], 0.f), p1 = fmaxf(v1[e], 0.f); v0[e] = p0 * p0; v1[e] = p1 * p1; }
                    }
                    u32x4 w; w.x = pg8::cvt_pk_bf16(v0[0], v0[1]); w.y = pg8::cvt_pk_bf16(v0[2], v0[3]); w.z = pg8::cvt_pk_bf16(v1[0], v1[1]); w.w = pg8::cvt_pk_bf16(v1[2], v1[3]);
                    *(u32x4*)(rowp + bj * 128) = w;
                }
                if (dov) { gs += __shfl_xor(gs, 16); gs += __shfl_xor(gs, 32); if (fq == 0) atomicAdd(vss + r, gs); }
            }
    }
};
struct EpiRes {
    static constexpr bool PERM = true, AFTER_DRAIN = false;
    float* X; bf16* XB; float* rss; const float* Sp; const float* Ss;
    __device__ __forceinline__ void operator()(const f32x4 (&acc)[2][2][4][2], const pg8::Unit& u, int wr, int wc, int fr, int fq) const {
        const int row0 = u.pm * 256 + wr * 64 + fr, col0 = u.pn * 256 + wc * 32 + 8 * fq;
#pragma unroll
        for (int ai = 0; ai < 2; ++ai)
#pragma unroll
            for (int m = 0; m < 4; ++m) {
                const int r = row0 + ai * 128 + m * 16;
                const float* srow = Sp ? (r < T_P ? Sp + (size_t)r * 1024 : Ss + (size_t)(r - T_P) * 1024) : X + (size_t)r * 1024;
                float ss = 0.f;
#pragma unroll
                for (int bj = 0; bj < 2; ++bj) {
                    float* xp = X + (size_t)r * 1024 + col0 + bj * 128;
                    const float* sp = srow + col0 + bj * 128;
                    const f32x4 x0 = *(const f32x4*)sp + acc[ai][bj][m][0], x1 = *(const f32x4*)(sp + 4) + acc[ai][bj][m][1];
                    *(f32x4*)xp = x0; *(f32x4*)(xp + 4) = x1;
                    u32x4 w; w.x = pg8::cvt_pk_bf16(x0[0], x0[1]); w.y = pg8::cvt_pk_bf16(x0[2], x0[3]); w.z = pg8::cvt_pk_bf16(x1[0], x1[1]); w.w = pg8::cvt_pk_bf16(x1[2], x1[3]);
                    *(u32x4*)(XB + (size_t)r * 1024 + col0 + bj * 128) = w;
                    ss += (x0[0] * x0[0] + x0[1] * x0[1]) + (x0[2] * x0[2] + x0[3] * x0[3]) + (x1[0] * x1[0] + x1[1] * x1[1]) + (x1[2] * x1[2] + x1[3] * x1[3]);
                }
                ss += __shfl_xor(ss, 16); ss += __shfl_xor(ss, 32);
                if (fq == 0) atomicAdd(rss + r, ss);
            }
    }
};

struct EpiResFinal {
    static constexpr bool PERM = true, AFTER_DRAIN = false;
    float* X; float* rss; float* part; const float* fg; unsigned* pcnt;
    __device__ __forceinline__ void operator()(const f32x4 (&acc)[2][2][4][2], const pg8::Unit& u, int wr, int wc, int fr, int fq) const {
        if (u.part >= 0) {
            const int row0 = (u.pm - 64) * 256 + wr * 64 + fr, col0 = u.pn * 256 + wc * 32 + 8 * fq;
            float* pp = part + (size_t)u.part * 512 * 1024;
#pragma unroll
            for (int ai = 0; ai < 2; ++ai)
#pragma unroll
                for (int m = 0; m < 4; ++m)
#pragma unroll
                    for (int bj = 0; bj < 2; ++bj) { float* xp = pp + (size_t)(row0 + ai * 128 + m * 16) * 1024 + col0 + bj * 128; *(f32x4*)xp = acc[ai][bj][m][0]; *(f32x4*)(xp + 4) = acc[ai][bj][m][1]; }
            return;
        }
        const int row0 = u.pm * 256 + wr * 64 + fr, col0 = u.pn * 256 + wc * 32 + 8 * fq;
        float dummy = 0.f;
#pragma unroll
        for (int ai = 0; ai < 2; ++ai)
#pragma unroll
            for (int m = 0; m < 4; ++m) {
                const int r = row0 + ai * 128 + m * 16;
                float ss = 0.f;
#pragma unroll
                for (int bj = 0; bj < 2; ++bj) {
                    const float* sp = X + (size_t)r * 1024 + col0 + bj * 128;
                    const f32x4 x0 = *(const f32x4*)sp + acc[ai][bj][m][0], x1 = *(const f32x4*)(sp + 4) + acc[ai][bj][m][1];
                    ss += (x0[0] * x0[0] + x0[1] * x0[1]) + (x0[2] * x0[2] + x0[3] * x0[3]) + (x1[0] * x1[0] + x1[1] * x1[1]) + (x1[2] * x1[2] + x1[3] * x1[3]);
                }
                ss += __shfl_xor(ss, 16); ss += __shfl_xor(ss, 32);
                if (fq == 0) dummy += atomicAdd(rss + r, ss);
            }
        asm volatile("s_waitcnt vmcnt(0)" :: "v"(dummy) : "memory");
        unsigned* cnt = pcnt + 64 * u.pm;
        if ((threadIdx.x & 63) == 0) __hip_atomic_fetch_add(cnt, 1u, __ATOMIC_RELAXED, __HIP_MEMORY_SCOPE_AGENT);
        { unsigned sp_ = 0; while (__hip_atomic_load(cnt, __ATOMIC_RELAXED, __HIP_MEMORY_SCOPE_AGENT) < 32u) { __builtin_amdgcn_s_sleep(2); if (++sp_ > (1u << 22)) break; } }
        asm volatile("" ::: "memory");
#pragma unroll
        for (int ai = 0; ai < 2; ++ai)
#pragma unroll
            for (int m = 0; m < 4; ++m) {
                const int r = row0 + ai * 128 + m * 16;
                const float rs = rsqrtf(__hip_atomic_load(rss + r, __ATOMIC_RELAXED, __HIP_MEMORY_SCOPE_AGENT) * (1.f / 1024.f) + NORM_EPS);
#pragma unroll
                for (int bj = 0; bj < 2; ++bj) {
                    float* xp = X + (size_t)r * 1024 + col0 + bj * 128;
                    const f32x4 g0 = *(const f32x4*)(fg + col0 + bj * 128), g1 = *(const f32x4*)(fg + col0 + bj * 128 + 4);
                    const f32x4 x0 = *(const f32x4*)xp + acc[ai][bj][m][0], x1 = *(const f32x4*)(xp + 4) + acc[ai][bj][m][1];
                    *(f32x4*)xp = x0 * rs * g0; *(f32x4*)(xp + 4) = x1 * rs * g1;
                }
            }
    }
};
__device__ __forceinline__ void sample_fix_final(const Args& a, const float* part) {
    const int tid = otid(), lane = tid & 63, wave = tid >> 6;
    for (int r = T_P + blockIdx.x * 8 + wave; r < TT; r += gridDim.x * 8) {
        float4* xi = (float4*)(a.out + (size_t)r * 1024);
        float4 v[4]; float ss = 0.f;
#pragma unroll
        for (int j = 0; j < 4; ++j) {
            v[j] = xi[lane + 64 * j];
#pragma unroll
            for (int s = 0; s < 8; ++s) { const float4 p = ((const float4*)(part + ((size_t)s * 512 + (r - T_P)) * 1024))[lane + 64 * j]; v[j].x += p.x; v[j].y += p.y; v[j].z += p.z; v[j].w += p.w; }
            ss += (v[j].x * v[j].x + v[j].y * v[j].y) + (v[j].z * v[j].z + v[j].w * v[j].w);
        }
        const float rs = rsqrtf(wave_sum(ss) * (1.f / 1024.f) + NORM_EPS);
#pragma unroll
        for (int j = 0; j < 4; ++j) { const float4 g = ((const float4*)a.in[I_FG])[lane + 64 * j]; float4 o = v[j]; o.x *= rs * g.x; o.y *= rs * g.y; o.z *= rs * g.z; o.w *= rs * g.w; xi[lane + 64 * j] = o; }
    }
}

struct DownOrder {
    int c, snt;
    __device__ __forceinline__ bool next(int i, pg8::Unit& u) const {
        if (i == 0) { const int v = (c & 7) * 32 + (c >> 3); u.pm = v >> 2; u.pn = v & 3; u.kofs = 0; u.nt = 0; u.part = -1; return true; }
        if (i == 1 && c < 64) { const int su = c >> 3, sl = c & 7; u.pm = 64 + (su >> 2); u.pn = su & 3; u.kofs = sl * snt * 64 * 2; u.nt = snt; u.part = sl; return true; }
        return false;
    }
    __device__ __forceinline__ void a_ready(const pg8::Unit&) const {}
    __device__ __forceinline__ void done(const pg8::Unit&) const {}
};
struct EpiResSplit {
    static constexpr bool PERM = true, AFTER_DRAIN = false;
    float* X; bf16* XB; float* rss; float* part; const float* Sp; const float* Ss;
    __device__ __forceinline__ void operator()(const f32x4 (&acc)[2][2][4][2], const pg8::Unit& u, int wr, int wc, int fr, int fq) const {
        if (u.part < 0) { EpiRes E{X, XB, rss, Sp, Ss}; E(acc, u, wr, wc, fr, fq); return; }
        const int row0 = (u.pm - 64) * 256 + wr * 64 + fr, col0 = u.pn * 256 + wc * 32 + 8 * fq;
        float* pp = part + (size_t)u.part * 512 * 1024;
#pragma unroll
        for (int ai = 0; ai < 2; ++ai)
#pragma unroll
            for (int m = 0; m < 4; ++m)
#pragma unroll
                for (int bj = 0; bj < 2; ++bj) {
                    float* xp = pp + (size_t)(row0 + ai * 128 + m * 16) * 1024 + col0 + bj * 128;
                    *(f32x4*)xp = acc[ai][bj][m][0]; *(f32x4*)(xp + 4) = acc[ai][bj][m][1];
                }
    }
};
__device__ __forceinline__ void sample_fix(const Args& a, float* rss, const float* part, const float* Ss = nullptr) {
    const int tid = otid(), lane = tid & 63, wave = tid >> 6;
    bf16* xb = (bf16*)(a.ws + WS_XB);
    for (int r = T_P + blockIdx.x * 8 + wave; r < TT; r += gridDim.x * 8) {
        float4* xi = (float4*)(a.out + (size_t)r * 1024);
        const float4* xs = Ss ? (const float4*)(Ss + (size_t)(r - T_P) * 1024) : (const float4*)xi;
        uint2* bo = (uint2*)(xb + (size_t)r * 1024);
        float ss = 0.f;
#pragma unroll
        for (int j = 0; j < 4; ++j) {
            float4 v = xs[lane + 64 * j];
#pragma unroll
            for (int s = 0; s < 8; ++s) { const float4 p = ((const float4*)(part + ((size_t)s * 512 + (r - T_P)) * 1024))[lane + 64 * j]; v.x += p.x; v.y += p.y; v.z += p.z; v.w += p.w; }
            xi[lane + 64 * j] = v;
            ss += (v.x * v.x + v.y * v.y) + (v.z * v.z + v.w * v.w); uint2 w; w.x = pk2(v.x, v.y); w.y = pk2(v.z, v.w); bo[lane + 64 * j] = w;
        }
        ss = wave_sum(ss);
        if (lane == 0) rss[r] = ss;
    }
}

template <class Epi> __device__ __forceinline__ void skinny_gemm(const bf16* __restrict__ A  , const bf16* __restrict__ Bt, int N, int K, const Epi& E) {
    const int tid = otid(), wave = tid >> 6, lane = tid & 63, fr = lane & 15, fq = lane >> 4;
    const int nN = N >> 7, nU = 8 * nN;
    for (int u = blockIdx.x; u < nU; u += gridDim.x) {
        const int mb = u / nN, nb = u - mb * nN, n0 = nb * 128 + wave * 16;
        const bf16* ap = A + (size_t)(mb * 64 + fr) * K + 8 * fq;
        const bf16* bp = Bt + (size_t)(n0 + fr) * K + 8 * fq;
        f32x4 acc[4];
#pragma unroll
        for (int m = 0; m < 4; ++m) acc[m] = (f32x4){0.f, 0.f, 0.f, 0.f};
#pragma unroll 4
        for (int k = 0; k < K; k += 32) {
            const pg8::bf16x8 bfr = *(const pg8::bf16x8*)(bp + k);
#pragma unroll
            for (int m = 0; m < 4; ++m) { const pg8::bf16x8 af = *(const pg8::bf16x8*)(ap + (size_t)m * 16 * K + k); acc[m] = __builtin_amdgcn_mfma_f32_16x16x32_bf16(bfr, af, acc[m], 0, 0, 0); }
        }
        E(acc, T_P + mb * 64 + fr, n0 + 4 * fq, fq);
    }
}
template <bool RELU2> struct SkScale {
    bf16* O; int ldc; const float* rss;
    __device__ __forceinline__ void operator()(const f32x4 (&acc)[4], int row, int col, int fq) const {
#pragma unroll
        for (int m = 0; m < 4; ++m) {
            const int r = row + 16 * m;
            const float rs = rsqrtf(rss[r] * (1.f / 1024.f) + NORM_EPS);
            f32x4 v = acc[m] * rs;
            if (RELU2) {
#pragma unroll
                for (int e = 0; e < 4; ++e) { const float p = fmaxf(v[e], 0.f); v[e] = p * p; }
            }
            uint2 w; w.x = pg8::cvt_pk_bf16(v[0], v[1]); w.y = pg8::cvt_pk_bf16(v[2], v[3]);
            *(uint2*)(O + (size_t)r * ldc + col) = w;
        }
    }
};
struct SkRes {
    float* X; bf16* XB; float* rss;
    __device__ __forceinline__ void operator()(const f32x4 (&acc)[4], int row, int col, int fq) const {
#pragma unroll
        for (int m = 0; m < 4; ++m) {
            const int r = row + 16 * m;
            float* xp = X + (size_t)r * 1024 + col;
            const f32x4 x = *(const f32x4*)xp + acc[m];
            *(f32x4*)xp = x;
            uint2 w; w.x = pg8::cvt_pk_bf16(x[0], x[1]); w.y = pg8::cvt_pk_bf16(x[2], x[3]);
            *(uint2*)(XB + (size_t)r * 1024 + col) = w;
            float ss = (x[0] * x[0] + x[1] * x[1]) + (x[2] * x[2] + x[3] * x[3]);
            ss += __shfl_xor(ss, 16); ss += __shfl_xor(ss, 32);
            if (fq == 0) atomicAdd(rss + r, ss);
        }
    }
};

__device__ __forceinline__ void tr_item(const float* __restrict__ W, int K, int Nsrc, bf16* __restrict__ WT, const float* __restrict__ gain, bool inmap, float* scr, int item, int nblk, int lane) {
    const int kb = item / nblk, nb = item - kb * nblk, k0 = 64 * kb, n0 = 32 * nb;
    const int n = n0 + (lane & 31);
    int ns = n;
    if (inmap) ns = n < 1536 ? n : n + 8;
    float tv[32];
    const int nsc = ns >= 0 ? ns : 0;
#pragma unroll
    for (int i = 0; i < 32; ++i) tv[i] = W[(size_t)(k0 + 2 * i + (lane >> 5)) * Nsrc + nsc];
#pragma unroll
    for (int i = 0; i < 32; ++i) {
        const int kk = 2 * i + (lane >> 5);
        float v = ns >= 0 ? tv[i] : 0.f;
        if (gain) v *= gain[k0 + kk];
        scr[kk * 33 + (lane & 31)] = v;
    }
    LDS_WAIT();
    const int c = lane & 7;
#pragma unroll
    for (int j = 0; j < 4; ++j) {
        const int nn = (lane >> 3) + 8 * j; const float* s = scr + (8 * c) * 33 + nn;
        uint4 o; o.x = pk2(s[0], s[33]); o.y = pk2(s[66], s[99]); o.z = pk2(s[132], s[165]); o.w = pk2(s[198], s[231]);
        *(uint4*)(WT + (size_t)(n0 + nn) * K + k0 + 8 * c) = o;
    }
    LDS_WAIT();
}

__device__ __forceinline__ void convert_layer(const Args& a, int l, float* scr, int gw, int NGW, int lane) {
    bf16* wb = (bf16*)(a.ws + WS_W) + (size_t)l * WL_ELEMS;
    for (int it = gw; it < 6016; it += NGW) {
        int r = it;
        if (r < 1408) tr_item(a.in[I_WIN] + (size_t)l * 1024 * 2824, 1024, 2824, wb + WOFF_IN, a.in[I_N1G] + l * 1024, true, scr, r, 88, lane);
        else if ((r -= 1408) < 512) tr_item(a.in[I_WOUT] + (size_t)l * 1024 * 1024, 1024, 1024, wb + WOFF_OUT, nullptr, false, scr, r, 32, lane);
        else if ((r -= 512) < 2048) tr_item(a.in[I_WUP] + (size_t)l * 1024 * 4096, 1024, 4096, wb + WOFF_UP, a.in[I_N2G] + l * 1024, false, scr, r, 128, lane);
        else { r -= 2048; tr_item(a.in[I_WDN] + (size_t)l * 4096 * 1024, 4096, 1024, wb + WOFF_DOWN, nullptr, false, scr, r, 32, lane); }
    }
}
__device__ __forceinline__ void phase0(const Args& a, unsigned char* lds) {
    const int tid = otid(), lane = tid & 63, wave = tid >> 6;
    const int gw = blockIdx.x * 8 + wave, NGW = gridDim.x * 8;
    float* scr = (float*)(lds + wave * 16384);
    convert_layer(a, 0, scr, gw, NGW, lane);
    if (MK_PER_PHASE || gridDim.x != 256) convert_layer(a, 1, scr, gw, NGW, lane);
    {
        bf16* BAW = (bf16*)(a.ws + WS_BAW);
        for (int i = blockIdx.x * 512 + tid; i < 2 * 16 * 1024; i += gridDim.x * 512) {
            const int l = i >> 14, n = (i >> 10) & 15, kk = i & 1023;
            const float v = n < 8 ? a.in[I_WIN][((size_t)l * 1024 + kk) * 2824 + 1536 + n] * a.in[I_N1G][l * 1024 + kk] : 0.f;
            BAW[i] = (bf16)f2bf(v);
        }
    }
    float* rowss = (float*)(a.ws + WS_ROWSS);
    bf16* xb = (bf16*)(a.ws + WS_XB);
    for (int r = gw; r < TT; r += NGW) {
        const float* src = r < T_P ? a.in[I_XP] + (size_t)r * 1024 : a.in[I_XS] + (size_t)(r - T_P) * 1024;
        float4 v[4]; float ss = 0.f;
#pragma unroll
        for (int j = 0; j < 4; ++j) { v[j] = ((const float4*)src)[lane + 64 * j]; ss += (v[j].x * v[j].x + v[j].y * v[j].y) + (v[j].z * v[j].z + v[j].w * v[j].w); }
        ss = wave_sum(ss);
        if (lane == 0) rowss[r] = ss;
        uint2* bo = (uint2*)(xb + (size_t)r * 1024);
#pragma unroll
        for (int j = 0; j < 4; ++j) { uint2 w; w.x = pk2(v[j].x, v[j].y); w.y = pk2(v[j].z, v[j].w); bo[lane + 64 * j] = w; }
    }
    for (int i = blockIdx.x * 512 + tid; i < 6 * TT; i += gridDim.x * 512) rowss[TT + i] = 0.f;
    {
        bf16* LW = (bf16*)(a.ws + WS_LW);
        for (int i = blockIdx.x * 512 + tid; i < 2 * 81920; i += gridDim.x * 512) {
            const int l = i / 81920; int r = i - l * 81920; float v;
            if (r < 16384) { const int c = r >> 6, j = r & 63; v = a.in[I_CW2][((size_t)l * 64 + j) * 256 + c]; }
            else if (r < 32768) { r -= 16384; const int c = r >> 6, j = r & 63; v = a.in[I_CA2][((size_t)l * 64 + j) * 256 + c]; }
            else if (r < 65536) { r -= 32768; const int c = r >> 7, j = r & 127; v = a.in[I_CG2][((size_t)l * 128 + j) * 256 + c]; }
            else { r -= 65536; const int c = r >> 6, cin = r & 63; v = a.in[I_DW][(((size_t)l * 4 + (c >> 6)) * 64 + cin) * 64 + (c & 63)]; }
            LW[i] = (bf16)f2bf(v);
        }
    }
}

template <int N> __device__ __forceinline__ void prev_c(const Args& a, int l, int row, int ccol, float (&o)[N]) {
    const bf16* P = (const bf16*)(a.ws + WS_P);
    bool first, smp = row >= T_P; int b = 0;
    if (!smp) first = (row & 2047) == 0; else { const int rs = row - T_P; first = (rs & 3) == 0; b = rs >> 2; }
    const int pr = row > 0 ? row - 1 : 0;
    float pv[N], sv[N];
    ldbf<N>(P + (size_t)pr * PN + PC_C + ccol, pv);
    ldf<N>(a.in[I_SCS] + ((size_t)l * 128 + b) * 1024 + ccol, sv);
#pragma unroll
    for (int i = 0; i < N; ++i) o[i] = first ? (smp ? sv[i] : 0.f) : pv[i];
}

__device__ __forceinline__ int tile_row(int tile, int i) { return i < 64 ? tile * 64 + i : T_P + tile * 2 + (i - 64); }
constexpr int XS = 264;
template <int KSTEPS> __device__ __forceinline__ void lora_mfma(const bf16* X, int joff, const bf16* __restrict__ WT, int wave, int lane, f32x4 (&acc)[5][2]) {
    const int fr = lane & 15, fq = lane >> 4;
#pragma unroll
    for (int m = 0; m < 5; ++m) { acc[m][0] = (f32x4){0.f, 0.f, 0.f, 0.f}; acc[m][1] = (f32x4){0.f, 0.f, 0.f, 0.f}; }
#pragma unroll
    for (int k = 0; k < KSTEPS; ++k) {
        pg8::bf16x8 bf[2];
#pragma unroll
        for (int n = 0; n < 2; ++n) bf[n] = *(const pg8::bf16x8*)(WT + (size_t)(wave * 32 + n * 16 + fr) * (32 * KSTEPS) + k * 32 + 8 * fq);
#pragma unroll
        for (int m = 0; m < 5; ++m) {
            const pg8::bf16x8 af = *(const pg8::bf16x8*)(X + (m * 16 + fr) * XS + joff + k * 32 + 8 * fq);
#pragma unroll
            for (int n = 0; n < 2; ++n) acc[m][n] = __builtin_amdgcn_mfma_f32_16x16x32_bf16(bf[n], af, acc[m][n], 0, 0, 0);
        }
    }
}

__device__ __forceinline__ void aux_tile(const Args& a, int l, int tile, unsigned char* lds) {
    const int tid = otid(), c = tid & 255, half = tid >> 8;
    const bf16* P = (const bf16*)(a.ws + WS_P);
    bf16* X = (bf16*)lds;
    {
        const float mu = a.in[I_CMU][l * 1024 + 768 + c];
#pragma unroll
        for (int j = 0; j < 33; ++j) {
            const int i = half * 33 + j, row = tile_row(tile, i);
            const float cur = bf2f(P[(size_t)row * PN + PC_C + 768 + c]);
            float pv[1]; prev_c<1>(a, l, row, 768 + c, pv);
            float xm = cur + (pv[0] - cur) * mu;
            if (c < 64) xm = tanh_(xm); else if (c >= 128) xm = sigm(xm);
            X[i * XS + c] = (bf16)f2bf(xm);
        }
    }
    __syncthreads();
    const int wave = tid >> 6, lane = tid & 63, fr = lane & 15, fq = lane >> 4;
    const bf16* LW = (const bf16*)(a.ws + WS_LW) + (size_t)l * 81920;
    float* auxw = (float*)(a.ws + WS_AUXW); bf16* auxa = (bf16*)(a.ws + WS_AUXA); bf16* auxg = (bf16*)(a.ws + WS_AUXG);
    f32x4 acc[5][2];
    lora_mfma<2>(X, 0, LW, wave, lane, acc);
#pragma unroll
    for (int n = 0; n < 2; ++n) {
        const int cc = wave * 32 + n * 16 + 4 * fq;
        const float4 w0c = *(const float4*)(a.in[I_CW0] + l * 256 + cc);
#pragma unroll
        for (int m = 0; m < 5; ++m) {
            const int tok = m * 16 + fr;
            if (tok < 66) {
                float4 o;
                o.x = __expf(-__expf(-softplus_(-(w0c.x + acc[m][n][0])) - 0.5f)); o.y = __expf(-__expf(-softplus_(-(w0c.y + acc[m][n][1])) - 0.5f));
                o.z = __expf(-__expf(-softplus_(-(w0c.z + acc[m][n][2])) - 0.5f)); o.w = __expf(-__expf(-softplus_(-(w0c.w + acc[m][n][3])) - 0.5f));
                *(float4*)(auxw + (size_t)tile_row(tile, tok) * 256 + cc) = o;
            }
        }
    }
    lora_mfma<2>(X, 64, LW + 16384, wave, lane, acc);
#pragma unroll
    for (int n = 0; n < 2; ++n) {
        const int cc = wave * 32 + n * 16 + 4 * fq;
        const float4 a0c = *(const float4*)(a.in[I_CA0] + l * 256 + cc);
#pragma unroll
        for (int m = 0; m < 5; ++m) {
            const int tok = m * 16 + fr;
            if (tok < 66) { uint2 o; o.x = pk2(sigm(a0c.x + acc[m][n][0]), sigm(a0c.y + acc[m][n][1])); o.y = pk2(sigm(a0c.z + acc[m][n][2]), sigm(a0c.w + acc[m][n][3])); *(uint2*)(auxa + (size_t)tile_row(tile, tok) * 256 + cc) = o; }
        }
    }
    lora_mfma<4>(X, 128, LW + 32768, wave, lane, acc);
#pragma unroll
    for (int n = 0; n < 2; ++n) {
        const int cc = wave * 32 + n * 16 + 4 * fq;
#pragma unroll
        for (int m = 0; m < 5; ++m) {
            const int tok = m * 16 + fr;
            if (tok < 66) { uint2 o; o.x = pk2(acc[m][n][0], acc[m][n][1]); o.y = pk2(acc[m][n][2], acc[m][n][3]); *(uint2*)(auxg + (size_t)tile_row(tile, tok) * 256 + cc) = o; }
        }
    }
    __syncthreads();
}

__device__ __forceinline__ void pool_tile(const Args& a, int l, int tile, unsigned char* lds) {
    bf16* X = (bf16*)lds;
    const int tid = otid(), c = tid & 255, half = tid >> 8, r0 = tile * 64;
    const bf16* P = (const bf16*)(a.ws + WS_P);
    bf16* mixed = (bf16*)(a.ws + WS_MIXED);
    const int gi = c >> 6, w = 2 << gi;
    unsigned short* Sg = (unsigned short*)(lds + 43008);
#pragma unroll
    for (int j = 0; j < 40; ++j) {
        const int k = half * 40 + j;
        if (k < 79) { const int gr = r0 - 15 + k; unsigned short v = 0; if (gr >= 0) v = P[(size_t)gr * PN + PC_D + c]; Sg[k * 256 + c] = v; }
    }
    __syncthreads();
    for (int j = 0; j < 32; ++j) {
        const int i = half * 32 + j, row = r0 + i;
        const unsigned short* sp = Sg + (15 + i) * 256 + c;
        const float xc = bf2f(sp[0]);
        const int b = row >> 11, t = row & 2047;
        const int n = t + 1 < w ? t + 1 : w;
        float sum = xc;
#pragma unroll
        for (int q = 1; q < 16; ++q) { const float hv = bf2f(sp[-q * 256]); if (q < n) sum += hv; }
        if (t >= 2033) a.out[O_PDP + (((size_t)l * 8 + b) * 15 + (t - 2033)) * 256 + c] = xc;
        X[i * XS + c] = (bf16)f2bf(sum / (float)n - xc);
    }
    {
        const int i = 64 + half, rs = tile * 2 + half, row = T_P + rs, b = rs >> 2, t = rs & 3;
        const float* sb = a.in[I_SDP] + ((size_t)l * 128 + b) * 15 * 256 + c;
        const float xc = bf2f(P[(size_t)row * PN + PC_D + c]);
        float hv[15];
#pragma unroll
        for (int q = 1; q < 16; ++q) {
            const int tq = t - q;
            const float pv = bf2f(P[(size_t)(row - (tq >= 0 ? q : 0)) * PN + PC_D + c]);
            const float sv = sb[(tq >= 0 ? 0 : 15 + tq) * 256];
            hv[q - 1] = tq >= 0 ? pv : sv;
        }
        float sum = xc;
#pragma unroll
        for (int q = 1; q < 16; ++q) if (q < w) sum += hv[q - 1];
        float* so = a.out + O_SDP + ((size_t)l * 128 + b) * 15 * 256 + c;
        so[(11 + t) * 256] = xc;
        if (t == 0) {
            float tv[11];
#pragma unroll
            for (int jj = 0; jj < 11; ++jj) tv[jj] = sb[(jj + 4) * 256];
#pragma unroll
            for (int jj = 0; jj < 11; ++jj) so[jj * 256] = tv[jj];
        }
        X[i * XS + c] = (bf16)f2bf(sum / (float)w - xc);
    }
    __syncthreads();
    {
        const int wave = tid >> 6, lane = tid & 63, fr = lane & 15, fq = lane >> 4;
        const bf16* LW = (const bf16*)(a.ws + WS_LW) + (size_t)l * 81920 + 65536;
        f32x4 acc[5][2];
        lora_mfma<2>(X, (wave >> 1) * 64, LW, wave, lane, acc);
#pragma unroll
        for (int n = 0; n < 2; ++n) {
            const int cc = wave * 32 + n * 16 + 4 * fq;
            const float4 sc = *(const float4*)(a.in[I_DSC] + l * 256 + cc);
#pragma unroll
            for (int m = 0; m < 5; ++m) {
                const int tok = m * 16 + fr;
                if (tok < 66) { uint2 o; o.x = pk2(acc[m][n][0] * sc.x, acc[m][n][1] * sc.y); o.y = pk2(acc[m][n][2] * sc.z, acc[m][n][3] * sc.w); *(uint2*)(mixed + (size_t)tile_row(tile, tok) * 1024 + 768 + cc) = o; }
            }
        }
    }
    for (int i = 0; i < 66; ++i) {
        const int row = tile_row(tile, i); int b, t, tl; bool smp;
        if (row < T_P) { b = row >> 11; t = row & 2047; tl = 2047; smp = false; } else { const int rs = row - T_P; b = rs >> 2; t = rs & 3; tl = 3; smp = true; }
        if (t == tl) {
            float* o = a.out + (smp ? O_SCS + ((size_t)l * 128 + b) * 1024 : O_PCS + ((size_t)l * 8 + b) * 1024);
            const float v0 = bf2f(P[(size_t)row * PN + PC_C + tid]), v1 = bf2f(P[(size_t)row * PN + PC_C + 512 + tid]);
            o[tid] = v0; o[512 + tid] = v1;
        }
        if (t >= tl - 2) {
            const int j = t - (tl - 2);
            float* o = a.out + (smp ? O_SBC + (((size_t)l * 128 + b) * 3 + j) * 768 : O_PBC + (((size_t)l * 8 + b) * 3 + j) * 768);
            const float v0 = bf2f(P[(size_t)row * PN + PC_BQ + tid]);
            o[tid] = v0;
            if (tid < 256) o[512 + tid] = bf2f(P[(size_t)row * PN + PC_BQ + 512 + tid]);
        }
    }
    __syncthreads();
}

__device__ __forceinline__ void gmlp_prompt_item(const Args& a, int l, int it, unsigned char* lds) {
    const int tid = otid(), t = tid >> 2, q = tid & 3;
    const int b = it >> 6, nc = (it >> 2) & 15, h = it & 3;
    const int row = b * 2048 + nc * 128 + t;
    const bf16* Pb = (const bf16*)(a.ws + WS_P);
    const bf16* Prow = Pb + (size_t)row * PN;
    bf16* mixed = (bf16*)(a.ws + WS_MIXED);
    bf16* wsb = (bf16*)lds;
    bf16* vT = (bf16*)(lds + 34816);
    const float rstd = rsqrtf(((const float*)(a.ws + WS_ROWSS))[(size_t)(5 + l) * TT + row] * (1.f / 256.f) + NORM_EPS);
    {
        const float* vg = a.in[I_AVG] + l * 256 + h * 64 + q * 16;
#pragma unroll
        for (int k = 0; k < 2; ++k) { float x[8]; ld8(Prow + 256 + h * 64 + q * 16 + k * 8, x);
#pragma unroll
            for (int e = 0; e < 8; ++e) vT[(q * 16 + k * 8 + e) * 136 + t] = (bf16)f2bf(gelu_t(x[e]) * rstd * vg[k * 8 + e]); }
    }
    {
        const float* wsrc = a.in[I_AWS] + ((size_t)l * 4 + h) * 16384;
        float4 wv[8];
#pragma unroll
        for (int j = 0; j < 8; ++j) { const int idx = tid + 512 * j; wv[j] = *(const float4*)(wsrc + (idx >> 5) * 128 + (idx & 31) * 4); }
#pragma unroll
        for (int j = 0; j < 8; ++j) {
            const int idx = tid + 512 * j, rr = idx >> 5, s0 = (idx & 31) * 4;
            uint2 o; o.x = pk2(s0 <= rr ? wv[j].x : 0.f, s0 + 1 <= rr ? wv[j].y : 0.f); o.y = pk2(s0 + 2 <= rr ? wv[j].z : 0.f, s0 + 3 <= rr ? wv[j].w : 0.f);
            *(uint2*)(wsb + rr * 136 + s0) = o;
        }
    }
    __syncthreads();
    const int wave = tid >> 6, lane = tid & 63, fr = lane & 15, fq = lane >> 4;
    f32x4 acc[4];
#pragma unroll
    for (int n = 0; n < 4; ++n) acc[n] = (f32x4){0.f, 0.f, 0.f, 0.f};
    const int nk = (wave >> 1) + 1;
#pragma unroll
    for (int k = 0; k < 4; ++k) {
        if (k < nk) {
            const pg8::bf16x8 af = *(const pg8::bf16x8*)(wsb + (wave * 16 + fr) * 136 + k * 32 + 8 * fq);
#pragma unroll
            for (int n = 0; n < 4; ++n) { const pg8::bf16x8 bfr = *(const pg8::bf16x8*)(vT + (n * 16 + fr) * 136 + k * 32 + 8 * fq); acc[n] = __builtin_amdgcn_mfma_f32_16x16x32_bf16(bfr, af, acc[n], 0, 0, 0); }
        }
    }
    {
        const int tt = wave * 16 + fr, ro = b * 2048 + nc * 128 + tt;
        const float bs = a.in[I_ABS][((size_t)l * 4 + h) * 128 + tt];
#pragma unroll
        for (int n = 0; n < 4; ++n) {
            const int cc = h * 64 + n * 16 + 4 * fq;
            float u[4]; ld4(Pb + (size_t)ro * PN + cc, u);
            uint2 o; o.x = pk2(gelu_t(u[0]) * (acc[n][0] + bs), gelu_t(u[1]) * (acc[n][1] + bs)); o.y = pk2(gelu_t(u[2]) * (acc[n][2] + bs), gelu_t(u[3]) * (acc[n][3] + bs));
            *(uint2*)(mixed + (size_t)ro * 1024 + cc) = o;
        }
    }
    __syncthreads();
}
__device__ __forceinline__ void gmlp_sample_item(const Args& a, int l, int b, float* Ls  ) {
    const int tid = otid(), lane = tid & 63, wave = tid >> 6, t = tid >> 7, c0 = (tid & 127) * 2;
    const int row = T_P + b * 4 + t;
    const bf16* Prow = (const bf16*)(a.ws + WS_P) + (size_t)row * PN;
    bf16* mixed = (bf16*)(a.ws + WS_MIXED);
    float* red = Ls + 1024;
    float x[2]; ld2(Prow + 256 + c0, x);
    const float g0 = gelu_t(x[0]), g1 = gelu_t(x[1]);
    const float ss = wave_sum(g0 * g0 + g1 * g1);
    if (lane == 0) red[wave] = ss;
    __syncthreads();
    const float rstd = rsqrtf((red[2 * t] + red[2 * t + 1]) * (1.f / 256.f) + NORM_EPS);
    const float v0 = g0 * rstd * a.in[I_AVG][l * 256 + c0], v1 = g1 * rstd * a.in[I_AVG][l * 256 + c0 + 1];
    Ls[t * 256 + c0] = v0; Ls[t * 256 + c0 + 1] = v1;
    float* sav = a.out + O_SAV + (((size_t)l * 128 + b) * 4 + t) * 256 + c0;
    sav[0] = v0; sav[1] = v1;
    __syncthreads();
    const int h = c0 >> 6;
    const float* wrow = a.in[I_AWS] + (((size_t)l * 4 + h) * 128 + t) * 128;
    const float bs = a.in[I_ABS][((size_t)l * 4 + h) * 128 + t];
    float m0 = bs, m1 = bs;
    for (int s = 0; s <= t; ++s) { const float ww = wrow[s]; m0 += ww * Ls[s * 256 + c0]; m1 += ww * Ls[s * 256 + c0 + 1]; }
    float u[2]; ld2(Prow + c0, u);
    *(unsigned*)(mixed + (size_t)row * 1024 + c0) = pk2(gelu_t(u[0]) * m0, gelu_t(u[1]) * m1);
    __syncthreads();
}

__device__ __forceinline__ void ba_tile(const Args& a, int l, int tile, unsigned char* lds) {
    const int tid = otid(), wave = tid >> 6, lane = tid & 63, fr = lane & 15, fq = lane >> 4;
    const bf16* xb = (const bf16*)(a.ws + WS_XB);
    const bf16* BAW = (const bf16*)(a.ws + WS_BAW) + (size_t)l * 16384;
    float* red = (float*)lds;
    f32x4 acc[5];
#pragma unroll
    for (int m = 0; m < 5; ++m) acc[m] = (f32x4){0.f, 0.f, 0.f, 0.f};
#pragma unroll
    for (int k = 0; k < 4; ++k) {
        const int kk = wave * 128 + k * 32 + 8 * fq;
        const pg8::bf16x8 bfr = *(const pg8::bf16x8*)(BAW + fr * 1024 + kk);
#pragma unroll
        for (int m = 0; m < 5; ++m) {
            const int tok = m * 16 + fr, row = tile_row(tile, tok < 66 ? tok : 65);
            const pg8::bf16x8 af = *(const pg8::bf16x8*)(xb + (size_t)row * 1024 + kk);
            acc[m] = __builtin_amdgcn_mfma_f32_16x16x32_bf16(bfr, af, acc[m], 0, 0, 0);
        }
    }
#pragma unroll
    for (int m = 0; m < 5; ++m) *(f32x4*)(red + ((wave * 80) + m * 16 + fr) * 16 + 4 * fq) = acc[m];
    __syncthreads();
    const float* rss = (const float*)(a.ws + WS_ROWSS) + (size_t)(2 * l) * TT;
    float* BA = (float*)(a.ws + WS_BA);
    for (int e = tid; e < 66 * 8; e += 512) {
        const int tok = e >> 3, n = e & 7, row = tile_row(tile, tok);
        float s = 0.f;
#pragma unroll
        for (int w = 0; w < 8; ++w) s += red[(w * 80 + tok) * 16 + n];
        BA[(size_t)row * 8 + n] = s * rsqrtf(rss[row] * (1.f / 1024.f) + NORM_EPS);
    }
    __syncthreads();
}

__device__ __forceinline__ void phase_pre(const Args& a, int l, unsigned char* lds, int mode = 0) {
    float* L = (float*)lds;
    const int G = gridDim.x, g = blockIdx.x;
    if (mode != 2) for (int tile = g; tile < 256; tile += G) { aux_tile(a, l, tile, lds); pool_tile(a, l, tile, lds); ba_tile(a, l, tile, lds); }
    if (mode != 1) for (int it = g; it < 512; it += G) gmlp_prompt_item(a, l, it, lds);
    for (int it = g; it < 128; it += G) gmlp_sample_item(a, l, it, L);
}

struct ChunkD { int valid, mixer, h, cg, b, sample, row0, t0, n, first, last; };
__device__ __forceinline__ ChunkD get_chunk(int idx, int g, int G, int mode = 0) {
    ChunkD d; d.valid = 0; d.mixer = 0; d.h = 0; d.cg = 0; d.b = 0; d.sample = 0; d.row0 = 0; d.t0 = 0; d.n = 0; d.first = 0; d.last = 0;
    int nP = g < 256 ? (256 - g + G - 1) / G : 0;
    int nS = g < 4096 ? (4096 - g + G - 1) / G : 0;
    nS = 0;
    if (mode == 2) nP = 0;
    if (idx < nP * 64) {
        const int it = g + (idx >> 6) * G, ch = idx & 63;
        d.valid = 1; d.mixer = it & 1; d.cg = (it >> 1) & 3; d.h = (it >> 3) & 3; d.b = it >> 5; d.sample = 0; d.row0 = d.b * 2048; d.t0 = ch * 32; d.n = 32; d.first = ch == 0; d.last = ch == 63;
    } else {
        const int j = idx - nP * 64;
        if (j < nS) { const int it = g + j * G; d.valid = 1; d.mixer = it & 1; d.cg = (it >> 1) & 3; d.h = (it >> 3) & 3; d.b = it >> 5; d.sample = 1; d.row0 = T_P + d.b * 4; d.t0 = 0; d.n = 4; d.first = 1; d.last = 1; }
    }
    return d;
}
constexpr int OPB_FLOATS = 10752;

struct Raw { uint4 u[8]; unsigned s[4]; float w[2]; };
__device__ __forceinline__ void unpack8(const uint4 u, float (&o)[8]) {
    o[0] = __uint_as_float(u.x << 16); o[1] = __uint_as_float(u.x & 0xffff0000u); o[2] = __uint_as_float(u.y << 16); o[3] = __uint_as_float(u.y & 0xffff0000u);
    o[4] = __uint_as_float(u.z << 16); o[5] = __uint_as_float(u.z & 0xffff0000u); o[6] = __uint_as_float(u.w << 16); o[7] = __uint_as_float(u.w & 0xffff0000u);
}
__device__ __forceinline__ uint4 pack8f(const float* p) {
    const float4 x = *(const float4*)p, y = *(const float4*)(p + 4);
    uint4 o; o.x = pk2(x.x, x.y); o.y = pk2(x.z, x.w); o.z = pk2(y.x, y.y); o.w = pk2(y.z, y.w); return o;
}
__device__ __forceinline__ void raw_load(const Args& a, int l, const ChunkD& d, int ptid, Raw& R) {
    const int tok = ptid >> 3, sub = ptid & 7;
    if (!d.valid || tok >= d.n) return;
    const int t = d.t0 + tok, row = d.row0 + t;
    const bf16* P = (const bf16*)(a.ws + WS_P);
    const uint4 z4 = make_uint4(0u, 0u, 0u, 0u);
    if (d.mixer == 0) {
        const int cq = d.h * 64 + sub * 8, cv = 512 + d.h * 64 + d.cg * 16 + sub * 2;
#pragma unroll
        for (int k = 0; k < 4; ++k) {
            const int tt = t - 3 + k;
            if (tt >= 0) { const bf16* pr = P + (size_t)(d.row0 + tt) * PN + PC_BQ; R.u[k] = *(const uint4*)(pr + cq); R.u[4 + k] = *(const uint4*)(pr + 256 + cq); R.s[k] = *(const unsigned*)(pr + cv); }
            else if (d.sample) { const float* sp = a.in[I_SBC] + (((size_t)l * 128 + d.b) * 3 + (tt + 3)) * 768; R.u[k] = pack8f(sp + cq); R.u[4 + k] = pack8f(sp + 256 + cq); R.s[k] = pk2(sp[cv], sp[cv + 1]); }
            else { R.u[k] = z4; R.u[4 + k] = z4; R.s[k] = 0u; }
        }
        { const float* ba = (const float*)(a.ws + WS_BA) + (size_t)row * 8; R.w[0] = ba[d.h]; R.w[1] = ba[4 + d.h]; }
    } else {
        const int ch = d.h * 64 + sub * 8, vcl = 512 + d.h * 64 + d.cg * 16 + sub * 2;
        const bf16* pc = P + (size_t)row * PN + PC_C;
        R.u[0] = *(const uint4*)(pc + ch); R.u[1] = *(const uint4*)(pc + 256 + ch); R.s[0] = *(const unsigned*)(pc + vcl);
        if (t > 0) { const bf16* pp = pc - PN; R.u[2] = *(const uint4*)(pp + ch); R.u[3] = *(const uint4*)(pp + 256 + ch); R.s[1] = *(const unsigned*)(pp + vcl); }
        else if (d.sample) { const float* sp = a.in[I_SCS] + ((size_t)l * 128 + d.b) * 1024; R.u[2] = pack8f(sp + ch); R.u[3] = pack8f(sp + 256 + ch); R.s[1] = pk2(sp[vcl], sp[vcl + 1]); }
        else { R.u[2] = z4; R.u[3] = z4; R.s[1] = 0u; }
        R.u[4] = *(const uint4*)((const bf16*)(a.ws + WS_AUXA) + (size_t)row * 256 + ch);
        const float* wp = (const float*)(a.ws + WS_AUXW) + (size_t)row * 256 + ch;
        R.u[5] = *(const uint4*)wp; R.u[6] = *(const uint4*)(wp + 4);
    }
}
__device__ __forceinline__ void prep_math(const Args& a, int l, const ChunkD& d, const Raw& R, float* ob, float* CST, int ptid) {
    const int tok = ptid >> 3, sub = ptid & 7;
    if (!d.valid || tok >= d.n) return;
    const int row = d.row0 + d.t0 + tok;
    float* Rp = ob + tok * 64 + sub * 8;
    float* V = ob + 10240 + tok * 16 + sub * 2;
    float r[8], w[8], k[8], kk[8], bb[8], v[2];
    if (d.mixer == 0) {
        const int cq = d.h * 64 + sub * 8, cv = 512 + d.h * 64 + d.cg * 16 + sub * 2;
        float q[8], kr[8];
#pragma unroll
        for (int i = 0; i < 8; ++i) { q[i] = 0.f; kr[i] = 0.f; }
        v[0] = 0.f; v[1] = 0.f;
        float* cst = CST + sub * 80;
        if (d.first) {
#pragma unroll
            for (int kx = 0; kx < 4; ++kx) {
                const float* cw = a.in[I_BCW] + ((size_t)l * 4 + kx) * 768;
                *(float4*)(cst + kx * 20) = *(const float4*)(cw + cq); *(float4*)(cst + kx * 20 + 4) = *(const float4*)(cw + cq + 4);
                *(float4*)(cst + kx * 20 + 8) = *(const float4*)(cw + 256 + cq); *(float4*)(cst + kx * 20 + 12) = *(const float4*)(cw + 256 + cq + 4);
                *(float2*)(cst + kx * 20 + 16) = *(const float2*)(cw + cv);
            }
        }
#pragma unroll
        for (int kx = 0; kx < 4; ++kx) {
            float xq[8], xk[8]; unpack8(R.u[kx], xq); unpack8(R.u[4 + kx], xk);
            const float4 a0 = *(const float4*)(cst + kx * 20), a1 = *(const float4*)(cst + kx * 20 + 4), b0 = *(const float4*)(cst + kx * 20 + 8), b1 = *(const float4*)(cst + kx * 20 + 12);
            const float2 c0 = *(const float2*)(cst + kx * 20 + 16);
            q[0] += xq[0] * a0.x; q[1] += xq[1] * a0.y; q[2] += xq[2] * a0.z; q[3] += xq[3] * a0.w; q[4] += xq[4] * a1.x; q[5] += xq[5] * a1.y; q[6] += xq[6] * a1.z; q[7] += xq[7] * a1.w;
            kr[0] += xk[0] * b0.x; kr[1] += xk[1] * b0.y; kr[2] += xk[2] * b0.z; kr[3] += xk[3] * b0.w; kr[4] += xk[4] * b1.x; kr[5] += xk[5] * b1.y; kr[6] += xk[6] * b1.z; kr[7] += xk[7] * b1.w;
            v[0] += __uint_as_float(R.s[kx] << 16) * c0.x; v[1] += __uint_as_float(R.s[kx] & 0xffff0000u) * c0.y;
        }
        float sq = 0.f, sk = 0.f;
#pragma unroll
        for (int i = 0; i < 8; ++i) { q[i] = silu(q[i]); kr[i] = silu(kr[i]); sq += q[i] * q[i]; sk += kr[i] * kr[i]; }
        v[0] = silu(v[0]); v[1] = silu(v[1]);
        sq = sum8(sq); sk = sum8(sk);
        const float iq = rsqrtf(sq + 1e-6f) * 0.125f, ik = rsqrtf(sk + 1e-6f);
        const float beta = sigm(R.w[0]);
        const float gg = -__expf(a.in[I_BAL][l * 4 + d.h]) * softplus_(R.w[1] + a.in[I_BDT][l * 4 + d.h]);
        const float dec = __expf(gg);
#pragma unroll
        for (int i = 0; i < 8; ++i) { const float kn = kr[i] * ik; r[i] = q[i] * iq; w[i] = dec; kk[i] = kn; k[i] = beta * kn; bb[i] = dec * beta * kn; }
    } else {
        const int ch = d.h * 64 + sub * 8, vcl = 512 + d.h * 64 + d.cg * 16 + sub * 2;
        float cur[8], pv[8], kx[8], av[8];
        const float* mu = a.in[I_CMU] + l * 1024;
        float m0[8], m1[8], kkw[8], kaw[8], rkw[8];
        float* cst = CST + sub * 80;
        if (d.first) {
            *(float4*)(cst) = *(const float4*)(mu + ch); *(float4*)(cst + 4) = *(const float4*)(mu + ch + 4);
            *(float4*)(cst + 8) = *(const float4*)(mu + 256 + ch); *(float4*)(cst + 12) = *(const float4*)(mu + 256 + ch + 4);
            const float* p1 = a.in[I_CKK] + l * 256 + ch; *(float4*)(cst + 16) = *(const float4*)p1; *(float4*)(cst + 20) = *(const float4*)(p1 + 4);
            const float* p2 = a.in[I_CKA] + l * 256 + ch; *(float4*)(cst + 24) = *(const float4*)p2; *(float4*)(cst + 28) = *(const float4*)(p2 + 4);
            const float* p3 = a.in[I_CRK] + l * 256 + ch; *(float4*)(cst + 32) = *(const float4*)p3; *(float4*)(cst + 36) = *(const float4*)(p3 + 4);
            *(float2*)(cst + 40) = *(const float2*)(mu + vcl);
        }
        ldf<8>(cst, m0); ldf<8>(cst + 8, m1); ldf<8>(cst + 16, kkw); ldf<8>(cst + 24, kaw); ldf<8>(cst + 32, rkw);
        const float mv0 = cst[40], mv1 = cst[41];
        unpack8(R.u[0], cur); unpack8(R.u[2], pv);
#pragma unroll
        for (int i = 0; i < 8; ++i) r[i] = cur[i] + (pv[i] - cur[i]) * m0[i];
        unpack8(R.u[1], cur); unpack8(R.u[3], pv);
#pragma unroll
        for (int i = 0; i < 8; ++i) kx[i] = cur[i] + (pv[i] - cur[i]) * m1[i];
        {
            const float c0 = __uint_as_float(R.s[0] << 16), c1 = __uint_as_float(R.s[0] & 0xffff0000u), p0 = __uint_as_float(R.s[1] << 16), p1 = __uint_as_float(R.s[1] & 0xffff0000u);
            v[0] = c0 + (p0 - c0) * mv0; v[1] = c1 + (p1 - c1) * mv1;
        }
        unpack8(R.u[4], av);
        float ss = 0.f;
#pragma unroll
        for (int i = 0; i < 8; ++i) { kk[i] = kx[i] * kkw[i]; ss += kk[i] * kk[i]; }
        w[0] = __uint_as_float(R.u[5].x); w[1] = __uint_as_float(R.u[5].y); w[2] = __uint_as_float(R.u[5].z); w[3] = __uint_as_float(R.u[5].w); w[4] = __uint_as_float(R.u[6].x); w[5] = __uint_as_float(R.u[6].y); w[6] = __uint_as_float(R.u[6].z); w[7] = __uint_as_float(R.u[6].w);
        ss = sum8(ss);
        const float inv = rsqrtf(ss + 1e-6f);
        float rk = 0.f;
#pragma unroll
        for (int i = 0; i < 8; ++i) { kk[i] *= inv; k[i] = kx[i] * (1.f + (av[i] - 1.f) * kaw[i]); bb[i] = kk[i] * av[i]; rk += r[i] * k[i] * rkw[i]; }
        rk = sum8(rk);
        if (sub == 0 && d.cg == 0) ((float*)(a.ws + WS_RK))[(size_t)row * 4 + d.h] = rk;
    }
    *(float4*)(Rp) = make_float4(r[0], r[1], r[2], r[3]); *(float4*)(Rp + 4) = make_float4(r[4], r[5], r[6], r[7]);
    *(float4*)(Rp + 2048) = make_float4(w[0], w[1], w[2], w[3]); *(float4*)(Rp + 2052) = make_float4(w[4], w[5], w[6], w[7]);
    *(float4*)(Rp + 4096) = make_float4(k[0], k[1], k[2], k[3]); *(float4*)(Rp + 4100) = make_float4(k[4], k[5], k[6], k[7]);
    *(float4*)(Rp + 6144) = make_float4(kk[0], kk[1], kk[2], kk[3]); *(float4*)(Rp + 6148) = make_float4(kk[4], kk[5], kk[6], kk[7]);
    *(float4*)(Rp + 8192) = make_float4(bb[0], bb[1], bb[2], bb[3]); *(float4*)(Rp + 8196) = make_float4(bb[4], bb[5], bb[6], bb[7]);
    V[0] = v[0]; V[1] = v[1];
}

__device__ __forceinline__ void flush_y(const Args& a, const ChunkD& d, const float* Yb, int ptid) {
    if (!d.valid) return;
    float* yraw = (float*)(a.ws + WS_XB) + (size_t)d.mixer * TT * 256;
    for (int e = ptid; e < d.n * 16; e += 256) {
        const float4* yp = (const float4*)(Yb + e * 16);
        const float4 a0 = yp[0], a1 = yp[1], a2 = yp[2], a3 = yp[3];
        const float y = ((a0.x + a0.y) + (a0.z + a0.w)) + ((a1.x + a1.y) + (a1.z + a1.w)) + ((a2.x + a2.y) + (a2.z + a2.w)) + ((a3.x + a3.y) + (a3.z + a3.w));
        const int st = e >> 4, c = e & 15; yraw[(size_t)(d.row0 + d.t0 + st) * 256 + d.h * 64 + d.cg * 16 + c] = y;
    }
}

typedef float f2 __attribute__((ext_vector_type(2)));
struct Ops { f32x4 r, w, k, q, b; float v; };
__device__ __forceinline__ void ops_load(Ops& o, const float* Rb, const float* Vb, int st) {
    o.r = *(const f32x4*)(Rb + st * 64); o.w = *(const f32x4*)(Rb + 2048 + st * 64); o.k = *(const f32x4*)(Rb + 4096 + st * 64);
    o.q = *(const f32x4*)(Rb + 6144 + st * 64); o.b = *(const f32x4*)(Rb + 8192 + st * 64); o.v = Vb[st * 16];
}
__device__ __forceinline__ void scan_step(const Ops& o, f2& S01, f2& S23, float* Yp) {
    const f2 p2 = o.q.xy * S01 + o.q.zw * S23;
    const float sk = dpp_sum16(p2.x + p2.y);
    const f2 vv = {o.v, o.v}, sk2 = {sk, sk};
    const f2 t01 = o.k.xy * vv - o.b.xy * sk2, t23 = o.k.zw * vv - o.b.zw * sk2;
    S01 = o.w.xy * S01 + t01; S23 = o.w.zw * S23 + t23;
    const f2 y2 = o.r.xy * S01 + o.r.zw * S23;
    *Yp = y2.x + y2.y;
}
__device__ __forceinline__ const float* state_in_ptr(const Args& a, int l, const ChunkD& d, int kg, int cc) {
    return a.in[d.mixer ? I_SCW : I_SBS] + ((((size_t)l * 128 + d.b) * 4 + d.h) * 64 + 4 * kg) * 64 + d.cg * 16 + cc;
}
__device__ __forceinline__ void consume_chunk(const Args& a, int l, const ChunkD& d, const ChunkD& nx, const float* ob, float* Yb, f2& S01, f2& S23, float (&Sn)[4], int wave, int lane) {
    const int kg = lane & 15, cc = wave * 4 + (lane >> 4);
    if (d.first) {
        if (d.sample) { S01.x = Sn[0]; S01.y = Sn[1]; S23.x = Sn[2]; S23.y = Sn[3]; }
        else { S01.x = 0.f; S01.y = 0.f; S23.x = 0.f; S23.y = 0.f; }
    }
    if (nx.valid && nx.first && nx.sample) { const float* sp = state_in_ptr(a, l, nx, kg, cc); Sn[0] = sp[0]; Sn[1] = sp[64]; Sn[2] = sp[128]; Sn[3] = sp[192]; }
    const float* Rb = ob + 4 * kg; const float* Vb = ob + 10240 + cc; float* Yp = Yb + cc * 16 + kg;
    Ops o0, o1, o2;
    ops_load(o0, Rb, Vb, 0); ops_load(o1, Rb, Vb, 1);
    for (int st = 0; st < d.n; st += 4) {
        ops_load(o2, Rb, Vb, st + 2); scan_step(o0, S01, S23, Yp + st * 256);
        ops_load(o0, Rb, Vb, st + 3); scan_step(o1, S01, S23, Yp + (st + 1) * 256);
        ops_load(o1, Rb, Vb, st + 4); scan_step(o2, S01, S23, Yp + (st + 2) * 256);
        ops_load(o2, Rb, Vb, st + 5); scan_step(o0, S01, S23, Yp + (st + 3) * 256);
        o0 = o1; o1 = o2;
    }
    if (d.last) {
        size_t off;
        if (d.sample) off = (d.mixer ? O_SCW : O_SBS) + ((((size_t)l * 128 + d.b) * 4 + d.h) * 64 + 4 * kg) * 64 + d.cg * 16 + cc;
        else off = (d.mixer ? O_PCW : O_PBS) + ((((size_t)l * 8 + d.b) * 4 + d.h) * 64 + 4 * kg) * 64 + d.cg * 16 + cc;
        float* sp = a.out + off;
        sp[0] = S01.x; sp[64] = S01.y; sp[128] = S23.x; sp[192] = S23.y;
    }
}

__device__ __forceinline__ void sample_item(const Args& a, int l, int it, float* wl  , int lane) {
    const int mixer = it & 1, h = (it >> 1) & 3, b = it >> 3;
    const bf16* P = (const bf16*)(a.ws + WS_P);
    const int row0 = T_P + b * 4;
    float S[64];
    {
        const float* sp = a.in[mixer ? I_SCW : I_SBS] + (((size_t)l * 128 + b) * 4 + h) * 4096 + lane;
#pragma unroll
        for (int k = 0; k < 64; ++k) S[k] = sp[k * 64];
    }
    float* yraw = (float*)(a.ws + WS_XB) + (size_t)mixer * TT * 256;
    const int ch = h * 64 + lane;
    float cq[4], ck[4], cv[4], mur = 0.f, muk = 0.f, muv = 0.f, kkw = 0.f, kaw = 0.f, rkw = 0.f, alog = 0.f, dtb = 0.f;
    if (mixer == 0) {
#pragma unroll
        for (int k = 0; k < 4; ++k) { const float* cw = a.in[I_BCW] + ((size_t)l * 4 + k) * 768; cq[k] = cw[ch]; ck[k] = cw[256 + ch]; cv[k] = cw[512 + ch]; }
        alog = a.in[I_BAL][l * 4 + h]; dtb = a.in[I_BDT][l * 4 + h];
    } else {
#pragma unroll
        for (int k = 0; k < 4; ++k) { cq[k] = 0.f; ck[k] = 0.f; cv[k] = 0.f; }
        const float* mu = a.in[I_CMU] + l * 1024; mur = mu[ch]; muk = mu[256 + ch]; muv = mu[512 + ch];
        kkw = a.in[I_CKK][l * 256 + ch]; kaw = a.in[I_CKA][l * 256 + ch]; rkw = a.in[I_CRK][l * 256 + ch];
    }
    float xq[7], xk[7], xv[7];
    if (mixer == 0) {
        const float* sb = a.in[I_SBC] + ((size_t)l * 128 + b) * 3 * 768;
#pragma unroll
        for (int j = 0; j < 3; ++j) { xq[j] = sb[j * 768 + ch]; xk[j] = sb[j * 768 + 256 + ch]; xv[j] = sb[j * 768 + 512 + ch]; }
#pragma unroll
        for (int j = 0; j < 4; ++j) { const bf16* pr = P + (size_t)(row0 + j) * PN + PC_BQ; xq[3 + j] = bf2f(pr[ch]); xk[3 + j] = bf2f(pr[256 + ch]); xv[3 + j] = bf2f(pr[512 + ch]); }
    } else {
        const float* sc = a.in[I_SCS] + ((size_t)l * 128 + b) * 1024;
        xq[0] = 0.f; xk[0] = 0.f; xv[0] = 0.f; xq[1] = 0.f; xk[1] = 0.f; xv[1] = 0.f;
        xq[2] = sc[ch]; xk[2] = sc[256 + ch]; xv[2] = sc[512 + ch];
#pragma unroll
        for (int j = 0; j < 4; ++j) { const bf16* pr = P + (size_t)(row0 + j) * PN + PC_C; xq[3 + j] = bf2f(pr[ch]); xk[3 + j] = bf2f(pr[256 + ch]); xv[3 + j] = bf2f(pr[512 + ch]); }
    }
#pragma unroll
    for (int t = 0; t < 4; ++t) {
        const int row = row0 + t;
        float r, w, k, kk, bb, v;
        if (mixer == 0) {
            const float q0 = silu(xq[t] * cq[0] + xq[t + 1] * cq[1] + xq[t + 2] * cq[2] + xq[t + 3] * cq[3]);
            const float k0 = silu(xk[t] * ck[0] + xk[t + 1] * ck[1] + xk[t + 2] * ck[2] + xk[t + 3] * ck[3]);
            v = silu(xv[t] * cv[0] + xv[t + 1] * cv[1] + xv[t + 2] * cv[2] + xv[t + 3] * cv[3]);
            const float iq = rsqrtf(wave_sum(q0 * q0) + 1e-6f) * 0.125f, ik = rsqrtf(wave_sum(k0 * k0) + 1e-6f);
            const float* ba = (const float*)(a.ws + WS_BA) + (size_t)row * 8;
            const float beta = sigm(ba[h]);
            const float dec = __expf(-__expf(alog) * softplus_(ba[4 + h] + dtb));
            const float kn = k0 * ik; r = q0 * iq; w = dec; kk = kn; k = beta * kn; bb = dec * beta * kn;
        } else {
            r = xq[3 + t] + (xq[2 + t] - xq[3 + t]) * mur;
            const float kx = xk[3 + t] + (xk[2 + t] - xk[3 + t]) * muk;
            v = xv[3 + t] + (xv[2 + t] - xv[3 + t]) * muv;
            w = ((const float*)(a.ws + WS_AUXW))[(size_t)row * 256 + ch];
            const float av = bf2f(((const bf16*)(a.ws + WS_AUXA))[(size_t)row * 256 + ch]);
            const float kr = kx * kkw;
            kk = kr * rsqrtf(wave_sum(kr * kr) + 1e-6f);
            k = kx * (1.f + (av - 1.f) * kaw); bb = kk * av;
            const float rk = wave_sum(r * k * rkw);
            if (lane == 0) ((float*)(a.ws + WS_RK))[(size_t)row * 4 + h] = rk;
        }
        wl[lane] = r; wl[64 + lane] = w; wl[128 + lane] = k; wl[192 + lane] = kk; wl[256 + lane] = bb;
        LDS_WAIT();
        float sk = 0.f;
#pragma unroll
        for (int k4 = 0; k4 < 16; ++k4) { const float4 x = *(const float4*)(wl + 192 + 4 * k4); sk += (x.x * S[4 * k4] + x.y * S[4 * k4 + 1]) + (x.z * S[4 * k4 + 2] + x.w * S[4 * k4 + 3]); }
        float y = 0.f;
#pragma unroll
        for (int k4 = 0; k4 < 16; ++k4) {
            const float4 ww = *(const float4*)(wl + 64 + 4 * k4), kx4 = *(const float4*)(wl + 128 + 4 * k4), b4 = *(const float4*)(wl + 256 + 4 * k4), r4 = *(const float4*)(wl + 4 * k4);
            S[4 * k4 + 0] = ww.x * S[4 * k4 + 0] + (kx4.x * v - b4.x * sk); S[4 * k4 + 1] = ww.y * S[4 * k4 + 1] + (kx4.y * v - b4.y * sk);
            S[4 * k4 + 2] = ww.z * S[4 * k4 + 2] + (kx4.z * v - b4.z * sk); S[4 * k4 + 3] = ww.w * S[4 * k4 + 3] + (kx4.w * v - b4.w * sk);
            y += (r4.x * S[4 * k4 + 0] + r4.y * S[4 * k4 + 1]) + (r4.z * S[4 * k4 + 2] + r4.w * S[4 * k4 + 3]);
        }
        yraw[(size_t)row * 256 + ch] = y;
        LDS_WAIT();
    }
    {
        float* sp = a.out + (mixer ? O_SCW : O_SBS) + (((size_t)l * 128 + b) * 4 + h) * 4096 + lane;
#pragma unroll
        for (int k = 0; k < 64; ++k) sp[k * 64] = S[k];
    }
}

__device__ __forceinline__ void phase_scan(const Args& a, int l, unsigned char* lds, int mode = 0) {
    const int tid = otid(), lane = tid & 63, wave = __builtin_amdgcn_readfirstlane(tid >> 6);
    const int G = gridDim.x, g = blockIdx.x;
    float* OB = (float*)lds;
    float* YB = OB + 2 * OPB_FLOATS + 512;
    float* CST = YB + 2 * 8192;
    const bool prod = wave >= 4; const int ptid = tid - 256;
    ChunkD cp = get_chunk(0, g, G, mode), c0 = cp, c1 = get_chunk(1, g, G, mode), c2 = get_chunk(2, g, G, mode);
    Raw RA, RB;
    f2 S01 = {0.f, 0.f}, S23 = {0.f, 0.f}; float Sn[4] = {0.f, 0.f, 0.f, 0.f};
    if (prod) { raw_load(a, l, c0, ptid, RA); prep_math(a, l, c0, RA, OB, CST, ptid); raw_load(a, l, c1, ptid, RA); }
    else if (c0.valid && c0.first && c0.sample) { const float* sp = state_in_ptr(a, l, c0, lane & 15, wave * 4 + (lane >> 4)); Sn[0] = sp[0]; Sn[1] = sp[64]; Sn[2] = sp[128]; Sn[3] = sp[192]; }
    __syncthreads();
    int idx = 0;
    while (c0.valid) {
        if (!prod) consume_chunk(a, l, c0, c1, OB + (idx & 1) * OPB_FLOATS, YB + (idx & 1) * 8192, S01, S23, Sn, wave, lane);
        else { raw_load(a, l, c2, ptid, RB); prep_math(a, l, c1, RA, OB + ((idx + 1) & 1) * OPB_FLOATS, CST, ptid); if (idx > 0) flush_y(a, cp, YB + ((idx - 1) & 1) * 8192, ptid); }
        __syncthreads();
        cp = c0; c0 = c1; c1 = c2; c2 = get_chunk(idx + 3, g, G, mode); ++idx;
        if (!c0.valid) break;
        if (!prod) consume_chunk(a, l, c0, c1, OB + (idx & 1) * OPB_FLOATS, YB + (idx & 1) * 8192, S01, S23, Sn, wave, lane);
        else { raw_load(a, l, c2, ptid, RA); prep_math(a, l, c1, RB, OB + ((idx + 1) & 1) * OPB_FLOATS, CST, ptid); flush_y(a, cp, YB + ((idx - 1) & 1) * 8192, ptid); }
        __syncthreads();
        cp = c0; c0 = c1; c1 = c2; c2 = get_chunk(idx + 3, g, G, mode); ++idx;
    }
    if (prod && idx > 0) flush_y(a, cp, YB + ((idx - 1) & 1) * 8192, ptid);
    __syncthreads();
    if (mode != 1) {
        float* wl = (float*)lds + wave * 320;
        if ((G & 1) == 0) { if (g & 1) for (int it = (g >> 1) * 8 + wave; it < 1024; it += (G >> 1) * 8) sample_item(a, l, it, wl, lane); }
        else for (int it = g * 8 + wave; it < 1024; it += G * 8) sample_item(a, l, it, wl, lane);
        __syncthreads();
    }
}

__device__ __forceinline__ void phase_post(const Args& a, int l) {
    const int tid = otid(), lane = tid & 63, wave = tid >> 6;
    const int gw = blockIdx.x * 8 + wave, NGW = gridDim.x * 8;
    const bf16* P = (const bf16*)(a.ws + WS_P);
    bf16* mixed = (bf16*)(a.ws + WS_MIXED);
    const float* yraw = (const float*)(a.ws + WS_XB);
    const int h = lane >> 4, col = lane * 4;
    for (int r = gw; r < TT; r += NGW) {
        const bf16* Prow = P + (size_t)r * PN;
        {
            const float4 o = *(const float4*)(yraw + (size_t)r * 256 + col);
            const float ss = sum16((o.x * o.x + o.y * o.y) + (o.z * o.z + o.w * o.w));
            const float rstd = rsqrtf(ss * (1.f / 64.f) + NORM_EPS);
            float gt[4]; ld4(Prow + PC_BG + col, gt);
            const float* on = a.in[I_BON] + l * 64 + (col & 63);
            uint2 w; w.x = pk2(o.x * rstd * on[0] * silu(gt[0]), o.y * rstd * on[1] * silu(gt[1])); w.y = pk2(o.z * rstd * on[2] * silu(gt[2]), o.w * rstd * on[3] * silu(gt[3]));
            *(uint2*)(mixed + (size_t)r * 1024 + 256 + col) = w;
        }
        {
            const float4 y = *(const float4*)(yraw + (size_t)TT * 256 + (size_t)r * 256 + col);
            const float mean = sum16((y.x + y.y) + (y.z + y.w)) * (1.f / 64.f);
            const float d0 = y.x - mean, d1 = y.y - mean, d2 = y.z - mean, d3 = y.w - mean;
            const float var = sum16((d0 * d0 + d1 * d1) + (d2 * d2 + d3 * d3)) * (1.f / 64.f);
            const float rstd = rsqrtf(var + 64e-5f);
            float vc[4], vp[4], gg[4]; ld4(Prow + PC_C + 512 + col, vc); prev_c<4>(a, l, r, 512 + col, vp);
            ld4((const bf16*)(a.ws + WS_AUXG) + (size_t)r * 256 + col, gg);
            const float* mu = a.in[I_CMU] + l * 1024 + 512 + col;
            const float* lg = a.in[I_CLG] + l * 256 + col; const float* lb = a.in[I_CLB] + l * 256 + col;
            const float rk = ((const float*)(a.ws + WS_RK))[(size_t)r * 4 + h];
            const float dd[4] = {d0, d1, d2, d3}; float o[4];
#pragma unroll
            for (int i = 0; i < 4; ++i) { const float v = vc[i] + (vp[i] - vc[i]) * mu[i]; o[i] = (dd[i] * rstd * lg[i] + lb[i] + rk * v) * gg[i]; }
            uint2 w; w.x = pk2(o[0], o[1]); w.y = pk2(o[2], o[3]);
            *(uint2*)(mixed + (size_t)r * 1024 + 512 + col) = w;
        }
    }
}

__device__ __forceinline__ void phase_final(const Args& a) {
    const int tid = otid(), lane = tid & 63, wave = tid >> 6;
    const int gw = blockIdx.x * 8 + wave, NGW = gridDim.x * 8;
    const float* rss = (const float*)(a.ws + WS_ROWSS) + 4 * TT;
    for (int r = gw; r < TT; r += NGW) {
        const float rs = rsqrtf(rss[r] * (1.f / 1024.f) + NORM_EPS);
        float4* xo = (float4*)(a.out + (size_t)r * 1024);
#pragma unroll
        for (int j = 0; j < 4; ++j) { float4 v = xo[lane + 64 * j]; const float4 g = ((const float4*)a.in[I_FG])[lane + 64 * j]; v.x *= rs * g.x; v.y *= rs * g.y; v.z *= rs * g.z; v.w *= rs * g.w; xo[lane + 64 * j] = v; }
    }
}

#ifndef MK_PER_PHASE
#define MK_PER_PHASE 0
#endif
#ifndef USE_SKINNY
#define USE_SKINNY 0
#endif
constexpr int GM = USE_SKINNY ? T_P : TT;
#ifndef SCAN_PROBE_MODE
#define SCAN_PROBE_MODE 0
#endif
#ifndef PRE_PROBE_MODE
#define PRE_PROBE_MODE 0
#endif
#ifndef REP_P0
#define REP_P0 1
#endif
#ifndef REP_GIN
#define REP_GIN 1
#endif
#ifndef REP_PRE
#define REP_PRE 1
#endif
#ifndef REP_SCAN
#define REP_SCAN 1
#endif
#ifndef REP_POST
#define REP_POST 1
#endif
#ifndef REP_GUP
#define REP_GUP 1
#endif
__global__ void __launch_bounds__(512, 2) mk_fwd(Args a) {
    extern __shared__ __attribute__((aligned(16))) unsigned char lds[];
    cg::grid_group grid = cg::this_grid();
    const int lo = a.ph_lo, hi = a.ph_hi, G = gridDim.x;
    volatile LAS unsigned* bst = (volatile LAS unsigned*)((LAS unsigned char*)lds + (LDS_BYTES - 16));
    if (threadIdx.x < 4) bst[threadIdx.x] = 0u;
    __syncthreads();
    XcdBarrier xbar; xbar.bar = (unsigned*)(a.ws + WS_BAR); xbar.x = 0; xbar.st = nullptr;
    if (!MK_PER_PHASE) xbar = xcd_barrier_post((unsigned*)(a.ws + WS_BAR), bst);
#define IN(k) (lo <= (k) && (k) < hi)
#define SEAM(k) do { if (lo <= (k) && (k) + 1 < hi) { if ((k) == 0) grid.sync(); else xcd_barrier(xbar); } } while (0)
#define REPEAT(n) for (int rep_ = 0; rep_ < (n); ++rep_, (rep_ < (n) ? xcd_barrier(xbar) : (void)0))
    float* rowss = (float*)(a.ws + WS_ROWSS);
    bf16* xb = (bf16*)(a.ws + WS_XB); bf16* P = (bf16*)(a.ws + WS_P); bf16* mixed = (bf16*)(a.ws + WS_MIXED); bf16* hid = (bf16*)(a.ws + WS_HID);
    if (IN(0)) REPEAT(REP_P0) phase0(a, lds);
    SEAM(0);
    for (int l = 0; l < 2; ++l) {
        const int pb = 1 + 7 * l;
        const bf16* wb = (const bf16*)(a.ws + WS_W) + (size_t)l * WL_ELEMS;
        if (IN(pb + 0)) REPEAT(REP_GIN) {
            pg8::Gemm g{xb, wb + WOFF_IN, GM, NIN, 1024}; pg8::StaticOrder S; S.init(GM, NIN, G, (int)blockIdx.x);
            EpiScale<false> E{P, PN, rowss + (2 * l) * TT, rowss + (5 + l) * TT};
            pg8::gemm_phase<EpiScale<false>, pg8::StaticOrder, true, true>((PG8_LAS unsigned char*)lds, g, S, E);
#if USE_SKINNY
            SkScale<false> E2{P, PN, rowss + (2 * l) * TT};
            skinny_gemm(xb + (size_t)T_P * 1024, wb + WOFF_IN, PN, 1024, E2);
#endif
        }
        SEAM(pb + 0);
        if (IN(pb + 1)) REPEAT(REP_PRE) phase_pre(a, l, lds, rep_ == 0 ? 0 : PRE_PROBE_MODE);
        SEAM(pb + 1);
        if (IN(pb + 2)) REPEAT(REP_SCAN) phase_scan(a, l, lds, rep_ == 0 ? 0 : SCAN_PROBE_MODE);
        SEAM(pb + 2);
        if (IN(pb + 3)) REPEAT(REP_POST) phase_post(a, l);
        SEAM(pb + 3);
        if (IN(pb + 4)) {
            pg8::Gemm g{mixed, wb + WOFF_OUT, GM, 1024, 1024};
            if (G == 256 && !USE_SKINNY && !MK_PER_PHASE) {
                DownOrder S; S.c = (int)blockIdx.x; S.snt = 2;
                EpiResSplit E{a.out, xb, rowss + (2 * l + 1) * TT, (float*)(a.ws + WS_AUXW), l == 0 ? a.in[I_XP] : nullptr, l == 0 ? a.in[I_XS] : nullptr};
                pg8::gemm_phase<EpiResSplit, DownOrder, true, true>((PG8_LAS unsigned char*)lds, g, S, E);
                xcd_barrier(xbar);
                sample_fix(a, rowss + (2 * l + 1) * TT, (const float*)(a.ws + WS_AUXW), l == 0 ? a.in[I_XS] : nullptr);
            } else {
                pg8::StaticOrder S; S.init(GM, 1024, G, (int)blockIdx.x);
                EpiRes E{a.out, xb, rowss + (2 * l + 1) * TT, l == 0 ? a.in[I_XP] : nullptr, l == 0 ? a.in[I_XS] : nullptr};
                pg8::gemm_phase<EpiRes, pg8::StaticOrder, true, true>((PG8_LAS unsigned char*)lds, g, S, E);
#if USE_SKINNY
                SkRes E2{a.out, xb, rowss + (2 * l + 1) * TT};
                skinny_gemm(mixed + (size_t)T_P * 1024, wb + WOFF_OUT, 1024, 1024, E2);
#endif
            }
        }
        SEAM(pb + 4);
        if (IN(pb + 5)) REPEAT(REP_GUP) {
            pg8::Gemm g{xb, wb + WOFF_UP, GM, FF, 1024}; pg8::StaticOrder S; S.init(GM, FF, G, (int)blockIdx.x);
            EpiScale<true> E{hid, FF, rowss + (2 * l + 1) * TT};
            pg8::gemm_phase<EpiScale<true>, pg8::StaticOrder, true, true>((PG8_LAS unsigned char*)lds, g, S, E);
            if (l == 0 && !MK_PER_PHASE && G == 256 && blockIdx.x >= 32) {
                const int tid_ = otid();
                convert_layer(a, 1, (float*)(lds + (tid_ >> 6) * 16384), ((int)blockIdx.x - 32) * 8 + (tid_ >> 6), (G - 32) * 8, tid_ & 63);
            }
#if USE_SKINNY
            SkScale<true> E2{hid, FF, rowss + (2 * l + 1) * TT};
            skinny_gemm(xb + (size_t)T_P * 1024, wb + WOFF_UP, FF, 1024, E2);
#endif
        }
        SEAM(pb + 5);
        if (IN(pb + 6)) {
            pg8::Gemm g{hid, wb + WOFF_DOWN, GM, 1024, FF};
            if (G == 256 && !USE_SKINNY && !MK_PER_PHASE) {
                DownOrder S; S.c = (int)blockIdx.x; S.snt = 8;
                if (l == 1) {
                    EpiResFinal E{a.out, rowss + 4 * TT, (float*)(a.ws + WS_AUXW), a.in[I_FG], (unsigned*)(a.ws + WS_PCNT)};
                    pg8::gemm_phase<EpiResFinal, DownOrder, true, true>((PG8_LAS unsigned char*)lds, g, S, E);
                    xcd_barrier(xbar);
                    sample_fix_final(a, (const float*)(a.ws + WS_AUXW));
                } else {
                EpiResSplit E{a.out, xb, rowss + (2 * l + 2) * TT, (float*)(a.ws + WS_AUXW), nullptr, nullptr};
                pg8::gemm_phase<EpiResSplit, DownOrder, true, true>((PG8_LAS unsigned char*)lds, g, S, E);
                xcd_barrier(xbar);
                sample_fix(a, rowss + (2 * l + 2) * TT, (const float*)(a.ws + WS_AUXW));
                }
            } else {
                pg8::StaticOrder S; S.init(GM, 1024, G, (int)blockIdx.x);
                EpiRes E{a.out, xb, rowss + (2 * l + 2) * TT, nullptr, nullptr};
                pg8::gemm_phase<EpiRes, pg8::StaticOrder, true, true>((PG8_LAS unsigned char*)lds, g, S, E);
#if USE_SKINNY
                SkRes E2{a.out, xb, rowss + (2 * l + 2) * TT};
                skinny_gemm(hid + (size_t)T_P * FF, wb + WOFF_DOWN, 1024, FF, E2);
#endif
            }
        }
        if (!(l == 1 && G == 256 && !USE_SKINNY && !MK_PER_PHASE)) SEAM(pb + 6);
    }
    if (IN(15) && !(G == 256 && !USE_SKINNY && !MK_PER_PHASE)) phase_final(a);
#undef IN
#undef SEAM
}

extern "C" void kernel_launch(void* const* d_in, const int* in_sizes, int n_in, void* d_out, int out_size, void* d_ws, size_t ws_size, hipStream_t stream) {
    static int grid = 0;
    if (grid == 0) {
        int dev = 0, cus = 0, per_cu = 0;
        (void)hipGetDevice(&dev);
        (void)hipDeviceGetAttribute(&cus, hipDeviceAttributeMultiprocessorCount, dev);
        if (hipFuncSetAttribute((const void*)mk_fwd, hipFuncAttributeMaxDynamicSharedMemorySize, LDS_BYTES) != hipSuccess) { fprintf(stderr, "kernel_launch: hipFuncSetAttribute failed\n"); }
        if (hipOccupancyMaxActiveBlocksPerMultiprocessor(&per_cu, (const void*)mk_fwd, 512, LDS_BYTES) != hipSuccess || per_cu < 1) { fprintf(stderr, "kernel_launch: occupancy query reports %d\n", per_cu); per_cu = 1; }
        (void)hipGetLastError();
        if (per_cu > 1) per_cu = 1;
        if (cus <= 0) cus = 256;
        grid = cus * per_cu;
    }
    Args a{};
    for (int i = 0; i < 34; ++i) a.in[i] = (const float*)d_in[i];
    a.out = (float*)d_out; a.ws = (unsigned char*)d_ws;
    (void)hipMemsetAsync((unsigned char*)d_ws + WS_BAR, 0, BAR_ZERO_BYTES, stream);
#if MK_PER_PHASE
    for (int ph = 0; ph < NPHASE; ++ph) { a.ph_lo = ph; a.ph_hi = ph + 1; hipLaunchKernelGGL(mk_fwd, dim3(grid), dim3(512), LDS_BYTES, stream, a); }
#else
    a.ph_lo = 0; a.ph_hi = NPHASE;
    void* args[] = {&a};
    const hipError_t e = hipLaunchCooperativeKernel((const void*)mk_fwd, dim3(grid), dim3(512), args, LDS_BYTES, stream);
    if (e != hipSuccess) fprintf(stderr, "cooperative launch failed: %s (grid %d)\n", hipGetErrorString(e), grid);
#endif
}
```

```cpp
#include <hip/hip_runtime.h>
#include <hip/hip_cooperative_groups.h>
#include <cstdio>
#include <cstdint>
namespace cg = cooperative_groups;
#define MK_PER_PHASE 0
namespace pg8 {
#define PG8_LAS __attribute__((address_space(3)))
typedef unsigned short bf16_t;
typedef short bf16x8 __attribute__((ext_vector_type(8)));
typedef float f32x4 __attribute__((ext_vector_type(4)));
typedef unsigned u32x4 __attribute__((ext_vector_type(4)));
constexpr int BM = 256, BK = 64, HALF = 128, HTB = HALF * BK * 2  , STAGE_BYTES = 8 * HTB, NXCD = 8, WGM = 8;

__host__ __device__ __forceinline__ int lds_byte(int r, int c) { const int st = (r >> 4) * 2 + (c >> 5), rr = r & 15, cc = c & 31, ob = rr * 64 + cc * 2; return st * 1024 + (ob ^ (((ob >> 9) & 1) << 5)); }
__host__ __device__ __forceinline__ void stage_rc(int b, int& R, int& C) { const int st = b / 1024, sb = b % 1024, swz = sb ^ (((sb >> 9) & 1) << 5); R = (st >> 1) * 16 + swz / 64; C = (st & 1) * 32 + (swz % 64) / 2; }
__host__ __device__ __forceinline__ int perm32(int rho) { const int n = rho >> 4, i = rho & 15; return 8 * (i >> 2) + 4 * n + (i & 3); }

struct Unit { int pm, pn, kofs, nt, part; };
struct Gemm { const bf16_t* A; const bf16_t* Bt; int M, N, K; };

struct StaticOrder {
    int nM, nN, nwg, G, c;
    __host__ __device__ void init(int M, int N, int G_, int c_) { nM = M / BM; nN = N / BM; nwg = nM * nN; G = G_; c = c_; }
    __host__ __device__ bool next(int i, Unit& u) const {
        const long L = (long)i * G + c; if (L >= nwg) return false;
        int wgid = (int)L; { const int q = nwg / NXCD, r = nwg % NXCD, xcd = wgid % NXCD, off = wgid / NXCD; wgid = (xcd < r ? xcd * (q + 1) : r * (q + 1) + (xcd - r) * q) + off; }
        const int nig = WGM * nN, gid = wgid / nig, fm = gid * WGM, gsz = (nM - fm) < WGM ? (nM - fm) : WGM;
        u.pm = fm + ((wgid % nig) % gsz); u.pn = (wgid % nig) / gsz; u.kofs = 0; u.nt = 0; u.part = -1; return true;
    }
    __device__ __forceinline__ void a_ready(const Unit&) const {}
    __device__ __forceinline__ void done(const Unit&) const {}
};

__device__ __forceinline__ unsigned cvt_pk_bf16(float lo, float hi) { unsigned r; asm volatile("v_cvt_pk_bf16_f32 %0, %1, %2" : "=v"(r) : "v"(lo), "v"(hi)); return r; }
typedef float f32x2 __attribute__((ext_vector_type(2)));
template <class Epi, class Sched, bool ALIGN_EPI = false, bool SP2 = false>
__device__ __forceinline__ void gemm_phase(PG8_LAS unsigned char* lds, const Gemm g, const Sched& S, const Epi& E) {
    int tid_ = threadIdx.x; asm volatile("" : "+v"(tid_)); const int tid = tid_, wid = __builtin_amdgcn_readfirstlane(tid >> 6), lane = tid & 63, wr = wid >> 2, wc = wid & 3, fr = lane & 15, fq = lane >> 4;
    const int K = g.K, nt = K / BK;
    unsigned voffA[2], voffB[2];
#pragma unroll
    for (int i = 0; i < 2; ++i) { int R, C; stage_rc(tid * 16 + i * 8192, R, C); const int Rb = Epi::PERM ? ((R & ~31) + perm32(R & 31)) : R;
        voffA[i] = (unsigned)(R * K + C) * 2u; voffB[i] = (unsigned)(Rb * K + C) * 2u; }
    const size_t kstep = (size_t)(BK * 2);
    const size_t hstep = (size_t)HALF * K * 2;
    const size_t tstep = 2 * hstep;
    const unsigned ldsw = (unsigned)wid * 1024u;
    const int aoff = lds_byte(wr * 64 + fr, fq * 8), boff = lds_byte(wc * 32 + fr, fq * 8);
#define PG8_SA(b, h) (((b) * 2 + (h)) * HTB)
#define PG8_SB(b, h) ((4 + (b) * 2 + (h)) * HTB)
#define PG8_STAGE(bufoff, gbase, voff) do { _Pragma("unroll") for (int _i = 0; _i < 2; ++_i) \
        __builtin_amdgcn_global_load_lds((const unsigned*)((const char*)(gbase) + (voff)[_i]), (PG8_LAS unsigned*)(lds + (bufoff) + ldsw + _i * 8192), 16, 0, 0); } while (0)
#define PG8_LDA(dst, b, h) do { _Pragma("unroll") for (int m = 0; m < 4; ++m) _Pragma("unroll") for (int k = 0; k < 2; ++k) dst[m][k] = *(const PG8_LAS bf16x8*)(lds + PG8_SA(b, h) + aoff + m * 2048 + k * 1024); } while (0)
#define PG8_LDB(dst, b, h) do { _Pragma("unroll") for (int n = 0; n < 2; ++n) _Pragma("unroll") for (int k = 0; k < 2; ++k) dst[n][k] = *(const PG8_LAS bf16x8*)(lds + PG8_SB(b, h) + boff + n * 2048 + k * 1024); } while (0)
#define PG8_MMA(ai, bj, At, Bt) do { __builtin_amdgcn_s_setprio(1); _Pragma("unroll") for (int m = 0; m < 4; ++m) _Pragma("unroll") for (int n = 0; n < 2; ++n) _Pragma("unroll") for (int k = 0; k < 2; ++k) \
        acc[ai][bj][m][n] = __builtin_amdgcn_mfma_f32_16x16x32_bf16(Bt[n][k], At[m][k], acc[ai][bj][m][n], 0, 0, 0); __builtin_amdgcn_s_setprio(0); } while (0)
#define PG8_WAIT_V(n) asm volatile("s_waitcnt vmcnt(" #n ")" ::: "memory")
#define PG8_WAIT_L(n) asm volatile("s_waitcnt lgkmcnt(" #n ")" ::: "memory")
#define PG8_BAR __builtin_amdgcn_s_barrier()
#define PG8_SCHED __builtin_amdgcn_sched_barrier(0)
    Unit cur, nxt; int ui = 0;
    if (!S.next(0, cur)) return;
    f32x4 acc[2][2][4][2];
#pragma unroll
    for (int a = 0; a < 2; ++a)
#pragma unroll
        for (int b = 0; b < 2; ++b)
#pragma unroll
            for (int m = 0; m < 4; ++m)
#pragma unroll
                for (int n = 0; n < 2; ++n) acc[a][b][m][n] = (f32x4){0.f, 0.f, 0.f, 0.f};
    bf16x8 At[4][2], B0[2][2], B1[2][2];
    const char* cA = (const char*)g.A + (size_t)cur.pm * tstep + cur.kofs; const char* cB = (const char*)g.Bt + (size_t)cur.pn * tstep + cur.kofs;
    S.a_ready(cur);
    if constexpr (SP2) {
        PG8_STAGE(PG8_SB(0, 0), cB, voffB); PG8_STAGE(PG8_SB(0, 1), cB + hstep, voffB); PG8_STAGE(PG8_SA(0, 0), cA, voffA); PG8_STAGE(PG8_SA(0, 1), cA + hstep, voffA);
        if (wr == 1) PG8_BAR;
        PG8_WAIT_V(2); PG8_BAR;
        PG8_STAGE(PG8_SB(1, 0), cB + kstep, voffB); PG8_STAGE(PG8_SA(1, 0), cA + kstep, voffA); PG8_STAGE(PG8_SB(1, 1), cB + hstep + kstep, voffB);
        PG8_WAIT_V(6); PG8_BAR;
    } else {
        PG8_STAGE(PG8_SB(0, 0), cB, voffB); PG8_STAGE(PG8_SA(0, 0), cA, voffA); PG8_STAGE(PG8_SB(0, 1), cB + hstep, voffB); PG8_STAGE(PG8_SA(0, 1), cA + hstep, voffA);
        if (wr == 1) PG8_BAR;
        PG8_WAIT_V(4); PG8_BAR;
        PG8_STAGE(PG8_SB(1, 0), cB + kstep, voffB); PG8_STAGE(PG8_SA(1, 0), cA + kstep, voffA); PG8_STAGE(PG8_SB(1, 1), cB + hstep + kstep, voffB);
        PG8_WAIT_V(6); PG8_BAR;
    }
    for (;;) {
        const bool has_next = S.next(ui + 1, nxt);
        const char* nA = has_next ? (const char*)g.A + (size_t)nxt.pm * tstep + nxt.kofs : cA; const char* nB = has_next ? (const char*)g.Bt + (size_t)nxt.pn * tstep + nxt.kofs : cB;
        const int cnt = cur.nt ? cur.nt : nt;
        for (int t = 0; t < cnt; t += 2) {
            const bool last = (t == cnt - 2);
            const char* a1 = cA + (size_t)(t + 1) * kstep;
            const char* a2 = last ? nA : cA + (size_t)(t + 2) * kstep; const char* b2 = last ? nB : cB + (size_t)(t + 2) * kstep;
            const char* a3 = a2 + kstep; const char* b3 = b2 + kstep;
            if (last && has_next) S.a_ready(nxt);
            if constexpr (SP2) {
            PG8_LDB(B0, 0, 0); PG8_LDB(B1, 0, 1); PG8_SCHED; PG8_LDA(At, 0, 0); PG8_STAGE(PG8_SA(1, 1), a1 + hstep, voffA);
            PG8_WAIT_V(8); PG8_WAIT_L(0); PG8_BAR; PG8_MMA(0, 0, At, B0); PG8_MMA(0, 1, At, B1); PG8_BAR; PG8_SCHED;
            PG8_LDA(At, 0, 1); PG8_STAGE(PG8_SB(0, 0), b2, voffB); PG8_STAGE(PG8_SB(0, 1), b2 + hstep, voffB); PG8_STAGE(PG8_SA(0, 0), a2, voffA);
            PG8_WAIT_V(8); PG8_WAIT_L(0); PG8_BAR; PG8_MMA(1, 0, At, B0); PG8_MMA(1, 1, At, B1); PG8_BAR; PG8_SCHED;
            PG8_LDB(B0, 1, 0); PG8_LDB(B1, 1, 1); PG8_SCHED; PG8_LDA(At, 1, 0); PG8_STAGE(PG8_SA(0, 1), a2 + hstep, voffA);
            PG8_WAIT_V(8); PG8_WAIT_L(0); PG8_BAR; PG8_MMA(0, 0, At, B0); PG8_MMA(0, 1, At, B1); PG8_BAR; PG8_SCHED;
            PG8_LDA(At, 1, 1); PG8_STAGE(PG8_SB(1, 0), b3, voffB); PG8_STAGE(PG8_SB(1, 1), b3 + hstep, voffB); PG8_STAGE(PG8_SA(1, 0), a3, voffA);
            PG8_WAIT_V(8); PG8_WAIT_L(0); PG8_BAR; PG8_MMA(1, 0, At, B0); PG8_MMA(1, 1, At, B1); PG8_BAR; PG8_SCHED;
            } else {
            PG8_LDB(B0, 0, 0); PG8_SCHED; PG8_LDA(At, 0, 0); PG8_STAGE(PG8_SA(1, 1), a1 + hstep, voffA);
            PG8_WAIT_L(8); PG8_BAR; PG8_WAIT_L(0); PG8_MMA(0, 0, At, B0); PG8_BAR; PG8_SCHED;
            PG8_LDB(B1, 0, 1); PG8_STAGE(PG8_SB(0, 0), b2, voffB);
            PG8_BAR; PG8_WAIT_L(0); PG8_MMA(0, 1, At, B1); PG8_BAR;
            PG8_LDA(At, 0, 1); PG8_STAGE(PG8_SA(0, 0), a2, voffA);
            PG8_BAR; PG8_WAIT_L(0); PG8_MMA(1, 0, At, B0); PG8_BAR; PG8_SCHED;
            PG8_STAGE(PG8_SB(0, 1), b2 + hstep, voffB);
            PG8_WAIT_V(6); PG8_BAR; PG8_MMA(1, 1, At, B1); PG8_BAR;
            PG8_LDB(B0, 1, 0); PG8_SCHED; PG8_LDA(At, 1, 0); PG8_STAGE(PG8_SA(0, 1), a2 + hstep, voffA);
            PG8_WAIT_L(8); PG8_BAR; PG8_WAIT_L(0); PG8_MMA(0, 0, At, B0); PG8_BAR; PG8_SCHED;
            PG8_LDB(B1, 1, 1); PG8_STAGE(PG8_SB(1, 0), b3, voffB);
            PG8_BAR; PG8_WAIT_L(0); PG8_MMA(0, 1, At, B1); PG8_BAR;
            PG8_LDA(At, 1, 1); PG8_STAGE(PG8_SA(1, 0), a3, voffA);
            PG8_BAR; PG8_WAIT_L(0); PG8_MMA(1, 0, At, B0); PG8_BAR; PG8_SCHED;
            PG8_STAGE(PG8_SB(1, 1), b3 + hstep, voffB);
            PG8_WAIT_V(6); PG8_BAR; PG8_MMA(1, 1, At, B1); PG8_BAR;
            }
        }
        if constexpr (ALIGN_EPI) { if (wr == 0) PG8_BAR; }
        if constexpr (!Epi::AFTER_DRAIN) { E(acc, cur, wr, wc, fr, fq); S.done(cur); }
        if (!has_next) break;
#pragma unroll
        for (int a = 0; a < 2; ++a)
#pragma unroll
            for (int b = 0; b < 2; ++b)
#pragma unroll
                for (int m = 0; m < 4; ++m)
#pragma unroll
                    for (int n = 0; n < 2; ++n) acc[a][b][m][n] = (f32x4){0.f, 0.f, 0.f, 0.f};
        cur = nxt; cA = nA; cB = nB; ++ui;
        if constexpr (ALIGN_EPI) { if (wr == 1) PG8_BAR; }
    }
    PG8_WAIT_V(0);
    if constexpr (!ALIGN_EPI) { if (wr == 0) PG8_BAR; }
    PG8_BAR;
    if constexpr (Epi::AFTER_DRAIN) { E.fused(acc, cur, wr, wc, fr, fq, lds, wid, lane); S.done(cur); }
#undef PG8_SA
#undef PG8_SB
#undef PG8_STAGE
#undef PG8_LDA
#undef PG8_LDB
#undef PG8_MMA
#undef PG8_WAIT_V
#undef PG8_WAIT_L
#undef PG8_BAR
#undef PG8_SCHED
}
}

#define LAS __attribute__((address_space(3)))

#define XB_TMO      128
#define XB_XCNT(j)  (256  + 64 * (j))
#define XB_XSUB(j)  (1280 + 64 * (j))
#define XB_XGEN(j)  (2304 + 64 * (j))
#define XB_TOP      3328
#define XB_TOPGEN   3392
#define XCD_BAR_WORDS 3456
#define XB_SPIN_CAP (1u << 18)

__device__ __forceinline__ unsigned xb_ld(unsigned* p)              { return __hip_atomic_load(p, __ATOMIC_RELAXED, __HIP_MEMORY_SCOPE_AGENT); }
__device__ __forceinline__ unsigned xb_add(unsigned* p, unsigned v) { return __hip_atomic_fetch_add(p, v, __ATOMIC_RELAXED, __HIP_MEMORY_SCOPE_AGENT); }
__device__ __forceinline__ unsigned xb_xcc_id() { return (unsigned)__builtin_amdgcn_s_getreg((3 << 11) | 20) & 0xFu; }
#define XB_SPIN(cond, bar) do { unsigned _sp = 0; while (cond) { __builtin_amdgcn_s_sleep(1); \
    if ((++_sp & 255u) == 0u) { if (xb_ld(&(bar)[XB_TMO])) break; if (_sp > XB_SPIN_CAP) { atomicAdd(&(bar)[XB_TMO], 1u); break; } } } } while (0)

struct XcdBarrier {
    unsigned* bar; unsigned x;
    volatile LAS unsigned* st;
};

__device__ __forceinline__ XcdBarrier xcd_barrier_post(unsigned* bar, volatile LAS unsigned* st) {
    XcdBarrier b; b.bar = bar; b.x = xb_xcc_id(); b.st = st;
    if (threadIdx.x == 0) (void)xb_add(&bar[XB_XCNT(b.x)], 1u);
    return b;
}
__device__ __forceinline__ void xcd_barrier_complete(unsigned* bar, unsigned x, unsigned& nloc, unsigned& nx) {
    const unsigned G = gridDim.x * gridDim.y * gridDim.z;
    unsigned sum, cnt, mine, sp = 0u;
    for (;;) {
        sum = 0u; cnt = 0u; mine = 0u;
#pragma unroll
        for (unsigned j = 0; j < 16; ++j) { const unsigned c = xb_ld(&bar[XB_XCNT(j)]); sum += c; cnt += (c > 0u) ? 1u : 0u; mine = (j == x) ? c : mine; }
        if (sum == G) break;
        __builtin_amdgcn_s_sleep(1);
        if ((++sp & 255u) == 0u) { if (xb_ld(&bar[XB_TMO])) break; if (sp > XB_SPIN_CAP) { atomicAdd(&bar[XB_TMO], 1u); break; } }
    }
    nloc = mine > 0u ? mine : 1u; nx = cnt > 0u ? cnt : 1u;
}

__device__ __forceinline__ void xcd_barrier(const XcdBarrier& b) {
    asm volatile("s_waitcnt vmcnt(0)" ::: "memory");
    __syncthreads();
    if (threadIdx.x == 0) {
        unsigned* bar = b.bar;
        __builtin_amdgcn_s_waitcnt(0);
        unsigned nloc = b.st[0], nx = b.st[1];
        if (nloc == 0u) { xcd_barrier_complete(bar, b.x, nloc, nx); b.st[0] = nloc; b.st[1] = nx; }
        const unsigned old = xb_add(&bar[XB_XSUB(b.x)], 1u);
        const unsigned gen = old / nloc;
        if (old + 1u == (gen + 1u) * nloc) {
            __builtin_amdgcn_fence(__ATOMIC_RELEASE, "agent");
            asm volatile("s_waitcnt vmcnt(0)" ::: "memory");
            const unsigned og = xb_add(&bar[XB_TOP], 1u);
            const unsigned tg = og / nx;
            if (og + 1u == (tg + 1u) * nx) xb_add(&bar[XB_TOPGEN], 1u);
            else XB_SPIN(xb_ld(&bar[XB_TOPGEN]) == tg, bar);
            __builtin_amdgcn_fence(__ATOMIC_ACQUIRE, "agent");
            xb_add(&bar[XB_XGEN(b.x)], 1u);
            asm volatile("s_waitcnt vmcnt(0)" ::: "memory");
        } else {
            XB_SPIN(xb_ld(&bar[XB_XGEN(b.x)]) == gen, bar);
            __builtin_amdgcn_fence(__ATOMIC_ACQUIRE, "agent");
            asm volatile("s_waitcnt vmcnt(0)" ::: "memory");
        }
    }
    __syncthreads();
}

typedef unsigned short bf16;
typedef pg8::f32x4 f32x4;
typedef pg8::u32x4 u32x4;
constexpr int DM = 1024, T_P = 16384, T_S = 512, TT = 16896, PN = 3072, NIN = 2816, FF = 4096;
constexpr float NORM_EPS = 1e-6f;
constexpr int PC_A = 0, PC_BQ = 512, PC_BK = 768, PC_BV = 1024, PC_BG = 1280, PC_C = 1536, PC_D = 2560, PC_BA = 2816;
constexpr size_t MiB = 1u << 20;
constexpr size_t WS_ROWSS = 0;
constexpr size_t WS_RK = 512 * 1024;
constexpr size_t WS_BAR = 800 * 1024;
constexpr size_t WS_PCNT = WS_BAR + 14336;
constexpr size_t BAR_ZERO_BYTES = 14336 + 64 * 256;
constexpr size_t WS_W = 1 * MiB;
constexpr size_t WS_XB = 49 * MiB;
constexpr size_t WS_P = 82 * MiB;
constexpr size_t WS_MIXED = 181 * MiB;
constexpr size_t WS_HID = 82 * MiB;
constexpr size_t WS_AUXW = 214 * MiB;
constexpr size_t WS_AUXA = WS_AUXW + (size_t)TT * 256 * 4;
constexpr size_t WS_AUXG = WS_AUXA + (size_t)TT * 256 * 2;
constexpr size_t WS_LW = WS_AUXG + (size_t)TT * 256 * 2;
constexpr size_t WS_BAW = WS_LW + 2 * 81920 * 2;
constexpr size_t WS_BA = WS_BAW + 2 * 16 * 1024 * 2;
constexpr size_t WS_END = WS_BA + (size_t)TT * 8 * 4;
static_assert(WS_END <= 256 * MiB, "ws map");
constexpr size_t WOFF_IN = 0, WOFF_OUT = 3145728, WOFF_UP = 4194304, WOFF_DOWN = 8388608, WL_ELEMS = 12582912;
constexpr size_t O_YP = 0, O_YS = O_YP + (size_t)T_P * DM, O_PBC = O_YS + (size_t)T_S * DM, O_PBS = O_PBC + 2 * 8 * 3 * 768, O_PCS = O_PBS + 2 * 8 * 4 * 4096,
                 O_PCW = O_PCS + 2 * 8 * 1024, O_PDP = O_PCW + 2 * 8 * 4 * 4096, O_SAV = O_PDP + 2 * 8 * 15 * 256, O_SBC = O_SAV + 2 * 128 * 4 * 256,
                 O_SBS = O_SBC + 2 * 128 * 3 * 768, O_SCS = O_SBS + 2 * 128 * 4 * 4096, O_SCW = O_SCS + 2 * 128 * 1024, O_SDP = O_SCW + 2 * 128 * 4 * 4096,
                 O_END = O_SDP + 2 * 128 * 15 * 256;
static_assert(O_END == 28426240, "d_out map");
constexpr int LDS_BYTES = 163840;
constexpr int NPHASE = 16;

struct Args { const float* in[34]; float* out; unsigned char* ws; int ph_lo, ph_hi; };
enum { I_XP = 0, I_XS, I_SBC, I_SBS, I_SCS, I_SCW, I_SDP, I_N1G, I_WIN, I_AWS, I_ABS, I_AVG, I_BCW, I_BAL, I_BDT, I_BON, I_CMU, I_CW0, I_CW2, I_CA0, I_CA2, I_CG2,
       I_CKK, I_CKA, I_CRK, I_CLG, I_CLB, I_DW, I_DSC, I_WOUT, I_N2G, I_WUP, I_WDN, I_FG };

#define LDS_WAIT() asm volatile("s_waitcnt lgkmcnt(0)" ::: "memory")

__device__ __forceinline__ int otid() { int t = threadIdx.x; asm volatile("" : "+v"(t)); return t; }
__device__ __forceinline__ float bf2f(unsigned h) { return __uint_as_float(h << 16); }
__device__ __forceinline__ unsigned f2bf(float f) { unsigned u = __float_as_uint(f); return (u + 0x7fffu + ((u >> 16) & 1u)) >> 16; }
__device__ __forceinline__ unsigned pk2(float lo, float hi) { return f2bf(lo) | (f2bf(hi) << 16); }
__device__ __forceinline__ void ld8(const bf16* p, float (&o)[8]) {
    const uint4 u = *(const uint4*)p;
    o[0] = __uint_as_float(u.x << 16); o[1] = __uint_as_float(u.x & 0xffff0000u); o[2] = __uint_as_float(u.y << 16); o[3] = __uint_as_float(u.y & 0xffff0000u);
    o[4] = __uint_as_float(u.z << 16); o[5] = __uint_as_float(u.z & 0xffff0000u); o[6] = __uint_as_float(u.w << 16); o[7] = __uint_as_float(u.w & 0xffff0000u);
}
__device__ __forceinline__ void ld4(const bf16* p, float (&o)[4]) {
    const uint2 u = *(const uint2*)p;
    o[0] = __uint_as_float(u.x << 16); o[1] = __uint_as_float(u.x & 0xffff0000u); o[2] = __uint_as_float(u.y << 16); o[3] = __uint_as_float(u.y & 0xffff0000u);
}
__device__ __forceinline__ void ld2(const bf16* p, float (&o)[2]) { const unsigned u = *(const unsigned*)p; o[0] = __uint_as_float(u << 16); o[1] = __uint_as_float(u & 0xffff0000u); }
template <int N> __device__ __forceinline__ void ldbf(const bf16* p, float (&o)[N]);
template <> __device__ __forceinline__ void ldbf<8>(const bf16* p, float (&o)[8]) { ld8(p, o); }
template <> __device__ __forceinline__ void ldbf<4>(const bf16* p, float (&o)[4]) { ld4(p, o); }
template <> __device__ __forceinline__ void ldbf<2>(const bf16* p, float (&o)[2]) { ld2(p, o); }
template <> __device__ __forceinline__ void ldbf<1>(const bf16* p, float (&o)[1]) { o[0] = bf2f(*p); }
template <int N> __device__ __forceinline__ void ldf(const float* p, float (&o)[N]) {
#pragma unroll
    for (int i = 0; i < N; ++i) o[i] = p[i];
}
__device__ __forceinline__ float sigm(float x) { return __builtin_amdgcn_rcpf(1.f + __expf(-x)); }
__device__ __forceinline__ float silu(float x) { return x * sigm(x); }
__device__ __forceinline__ float tanh_(float y) { return 1.f - 2.f * __builtin_amdgcn_rcpf(1.f + __expf(2.f * y)); }
__device__ __forceinline__ float gelu_t(float x) { return 0.5f * x * (1.f + tanh_(0.7978845608028654f * (x + 0.044715f * x * x * x))); }
__device__ __forceinline__ float softplus_(float x) { const float u = __expf(-fabsf(x)); return fmaxf(x, 0.f) + (u < 1e-3f ? u * (1.f - 0.5f * u) : __logf(1.f + u)); }
__device__ __forceinline__ float wave_sum(float v) {
#pragma unroll
    for (int o = 1; o < 64; o <<= 1) v += __shfl_xor(v, o);
    return v;
}
__device__ __forceinline__ float sum8(float v) { v += __shfl_xor(v, 1); v += __shfl_xor(v, 2); v += __shfl_xor(v, 4); return v; }
__device__ __forceinline__ float sum16(float v) { v = sum8(v); v += __shfl_xor(v, 8); return v; }
__device__ __forceinline__ float dpp_sum16(float x) {
    x += __int_as_float(__builtin_amdgcn_update_dpp(0, __float_as_int(x), 0xB1, 0xF, 0xF, false));
    x += __int_as_float(__builtin_amdgcn_update_dpp(0, __float_as_int(x), 0x4E, 0xF, 0xF, false));
    x += __int_as_float(__builtin_amdgcn_update_dpp(0, __float_as_int(x), 0x141, 0xF, 0xF, false));
    x += __int_as_float(__builtin_amdgcn_update_dpp(0, __float_as_int(x), 0x140, 0xF, 0xF, false));
    return x;
}

template <bool RELU2> struct EpiScale {
    static constexpr bool PERM = true, AFTER_DRAIN = false;
    bf16* O; int ldc; const float* rss; float* vss;
    __device__ __forceinline__ void operator()(const f32x4 (&acc)[2][2][4][2], const pg8::Unit& u, int wr, int wc, int fr, int fq) const {
        const int row0 = u.pm * 256 + wr * 64 + fr, col0 = u.pn * 256 + wc * 32 + 8 * fq;
        const bool dov = !RELU2 && vss != nullptr && u.pn == 1;
#pragma unroll
        for (int ai = 0; ai < 2; ++ai)
#pragma unroll
            for (int m = 0; m < 4; ++m) {
                const int r = row0 + ai * 128 + m * 16;
                const float rs = rsqrtf(rss[r] * (1.f / 1024.f) + NORM_EPS);
                bf16* rowp = O + (size_t)r * ldc + col0;
                float gs = 0.f;
#pragma unroll
                for (int bj = 0; bj < 2; ++bj) {
                    f32x4 v0 = acc[ai][bj][m][0] * rs, v1 = acc[ai][bj][m][1] * rs;
                    if (dov) {
#pragma unroll
                        for (int e = 0; e < 4; ++e) { const float g0 = gelu_t(v0[e]), g1 = gelu_t(v1[e]); gs += g0 * g0 + g1 * g1; }
                    }
                    if (RELU2) {
#pragma unroll
                        for (int e = 0; e < 4; ++e) { const float p0 = fmaxf(v0[e], 0.f), p1 = fmaxf(v1[e], 0.f); v0[e] = p0 * p0; v1[e] = p1 * p1; }
                    }
                    u32x4 w; w.x = pg8::cvt_pk_bf16(v0[0], v0[1]); w.y = pg8::cvt_pk_bf16(v0[2], v0[3]); w.z = pg8::cvt_pk_bf16(v1[0], v1[1]); w.w = pg8::cvt_pk_bf16(v1[2], v1[3]);
                    *(u32x4*)(rowp + bj * 128) = w;
                }
                if (dov) { gs += __shfl_xor(gs, 16); gs += __shfl_xor(gs, 32); if (fq == 0) atomicAdd(vss + r, gs); }
            }
    }
};
struct EpiRes {
    static constexpr bool PERM = true, AFTER_DRAIN = false;
    float* X; bf16* XB; float* rss; const float* Sp; const float* Ss;
    __device__ __forceinline__ void operator()(const f32x4 (&acc)[2][2][4][2], const pg8::Unit& u, int wr, int wc, int fr, int fq) const {
        const int row0 = u.pm * 256 + wr * 64 + fr, col0 = u.pn * 256 + wc * 32 + 8 * fq;
#pragma unroll
        for (int ai = 0; ai < 2; ++ai)
#pragma unroll
            for (int m = 0; m < 4; ++m) {
                const int r = row0 + ai * 128 + m * 16;
                const float* srow = Sp ? (r < T_P ? Sp + (size_t)r * 1024 : Ss + (size_t)(r - T_P) * 1024) : X + (size_t)r * 1024;
                float ss = 0.f;
#pragma unroll
                for (int bj = 0; bj < 2; ++bj) {
                    float* xp = X + (size_t)r * 1024 + col0 + bj * 128;
                    const float* sp = srow + col0 + bj * 128;
                    const f32x4 x0 = *(const f32x4*)sp + acc[ai][bj][m][0], x1 = *(const f32x4*)(sp + 4) + acc[ai][bj][m][1];
                    *(f32x4*)xp = x0; *(f32x4*)(xp + 4) = x1;
                    u32x4 w; w.x = pg8::cvt_pk_bf16(x0[0], x0[1]); w.y = pg8::cvt_pk_bf16(x0[2], x0[3]); w.z = pg8::cvt_pk_bf16(x1[0], x1[1]); w.w = pg8::cvt_pk_bf16(x1[2], x1[3]);
                    *(u32x4*)(XB + (size_t)r * 1024 + col0 + bj * 128) = w;
                    ss += (x0[0] * x0[0] + x0[1] * x0[1]) + (x0[2] * x0[2] + x0[3] * x0[3]) + (x1[0] * x1[0] + x1[1] * x1[1]) + (x1[2] * x1[2] + x1[3] * x1[3]);
                }
                ss += __shfl_xor(ss, 16); ss += __shfl_xor(ss, 32);
                if (fq == 0) atomicAdd(rss + r, ss);
            }
    }
};

struct EpiResFinal {
    static constexpr bool PERM = true, AFTER_DRAIN = false;
    float* X; float* rss; float* part; const float* fg; unsigned* pcnt;
    __device__ __forceinline__ void operator()(const f32x4 (&acc)[2][2][4][2], const pg8::Unit& u, int wr, int wc, int fr, int fq) const {
        if (u.part >= 0) {
            const int row0 = (u.pm - 64) * 256 + wr * 64 + fr, col0 = u.pn * 256 + wc * 32 + 8 * fq;
            float* pp = part + (size_t)u.part * 512 * 1024;
#pragma unroll
            for (int ai = 0; ai < 2; ++ai)
#pragma unroll
                for (int m = 0; m < 4; ++m)
#pragma unroll
                    for (int bj = 0; bj < 2; ++bj) { float* xp = pp + (size_t)(row0 + ai * 128 + m * 16) * 1024 + col0 + bj * 128; *(f32x4*)xp = acc[ai][bj][m][0]; *(f32x4*)(xp + 4) = acc[ai][bj][m][1]; }
            return;
        }
        const int row0 = u.pm * 256 + wr * 64 + fr, col0 = u.pn * 256 + wc * 32 + 8 * fq;
        float dummy = 0.f;
#pragma unroll
        for (int ai = 0; ai < 2; ++ai)
#pragma unroll
            for (int m = 0; m < 4; ++m) {
                const int r = row0 + ai * 128 + m * 16;
                float ss = 0.f;
#pragma unroll
                for (int bj = 0; bj < 2; ++bj) {
                    const float* sp = X + (size_t)r * 1024 + col0 + bj * 128;
                    const f32x4 x0 = *(const f32x4*)sp + acc[ai][bj][m][0], x1 = *(const f32x4*)(sp + 4) + acc[ai][bj][m][1];
                    ss += (x0[0] * x0[0] + x0[1] * x0[1]) + (x0[2] * x0[2] + x0[3] * x0[3]) + (x1[0] * x1[0] + x1[1] * x1[1]) + (x1[2] * x1[2] + x1[3] * x1[3]);
                }
                ss += __shfl_xor(ss, 16); ss += __shfl_xor(ss, 32);
                if (fq == 0) dummy += atomicAdd(rss + r, ss);
            }
        asm volatile("s_waitcnt vmcnt(0)" :: "v"(dummy) : "memory");
        unsigned* cnt = pcnt + 64 * u.pm;
        if ((threadIdx.x & 63) == 0) __hip_atomic_fetch_add(cnt, 1u, __ATOMIC_RELAXED, __HIP_MEMORY_SCOPE_AGENT);
        { unsigned sp_ = 0; while (__hip_atomic_load(cnt, __ATOMIC_RELAXED, __HIP_MEMORY_SCOPE_AGENT) < 32u) { __builtin_amdgcn_s_sleep(2); if (++sp_ > (1u << 22)) break; } }
        asm volatile("" ::: "memory");
#pragma unroll
        for (int ai = 0; ai < 2; ++ai)
#pragma unroll
            for (int m = 0; m < 4; ++m) {
                const int r = row0 + ai * 128 + m * 16;
                const float rs = rsqrtf(__hip_atomic_load(rss + r, __ATOMIC_RELAXED, __HIP_MEMORY_SCOPE_AGENT) * (1.f / 1024.f) + NORM_EPS);
#pragma unroll
                for (int bj = 0; bj < 2; ++bj) {
                    float* xp = X + (size_t)r * 1024 + col0 + bj * 128;
                    const f32x4 g0 = *(const f32x4*)(fg + col0 + bj * 128), g1 = *(const f32x4*)(fg + col0 + bj * 128 + 4);
                    const f32x4 x0 = *(const f32x4*)xp + acc[ai][bj][m][0], x1 = *(const f32x4*)(xp + 4) + acc[ai][bj][m][1];
                    *(f32x4*)xp = x0 * rs * g0; *(f32x4*)(xp + 4) = x1 * rs * g1;
                }
            }
    }
};
__device__ __forceinline__ void sample_fix_final(const Args& a, const float* part) {
    const int tid = otid(), lane = tid & 63, wave = tid >> 6;
    for (int r = T_P + blockIdx.x * 8 + wave; r < TT; r += gridDim.x * 8) {
        float4* xi = (float4*)(a.out + (size_t)r * 1024);
        float4 v[4]; float ss = 0.f;
#pragma unroll
        for (int j = 0; j < 4; ++j) {
            v[j] = xi[lane + 64 * j];
#pragma unroll
            for (int s = 0; s < 8; ++s) { const float4 p = ((const float4*)(part + ((size_t)s * 512 + (r - T_P)) * 1024))[lane + 64 * j]; v[j].x += p.x; v[j].y += p.y; v[j].z += p.z; v[j].w += p.w; }
            ss += (v[j].x * v[j].x + v[j].y * v[j].y) + (v[j].z * v[j].z + v[j].w * v[j].w);
        }
        const float rs = rsqrtf(wave_sum(ss) * (1.f / 1024.f) + NORM_EPS);
#pragma unroll
        for (int j = 0; j < 4; ++j) { const float4 g = ((const float4*)a.in[I_FG])[lane + 64 * j]; float4 o = v[j]; o.x *= rs * g.x; o.y *= rs * g.y; o.z *= rs * g.z; o.w *= rs * g.w; xi[lane + 64 * j] = o; }
    }
}

struct DownOrder {
    int c, snt;
    __device__ __forceinline__ bool next(int i, pg8::Unit& u) const {
        if (i == 0) { const int v = (c & 7) * 32 + (c >> 3); u.pm = v >> 2; u.pn = v & 3; u.kofs = 0; u.nt = 0; u.part = -1; return true; }
        if (i == 1 && c < 64) { const int su = c >> 3, sl = c & 7; u.pm = 64 + (su >> 2); u.pn = su & 3; u.kofs = sl * snt * 64 * 2; u.nt = snt; u.part = sl; return true; }
        return false;
    }
    __device__ __forceinline__ void a_ready(const pg8::Unit&) const {}
    __device__ __forceinline__ void done(const pg8::Unit&) const {}
};
struct EpiResSplit {
    static constexpr bool PERM = true, AFTER_DRAIN = false;
    float* X; bf16* XB; float* rss; float* part; const float* Sp; const float* Ss;
    __device__ __forceinline__ void operator()(const f32x4 (&acc)[2][2][4][2], const pg8::Unit& u, int wr, int wc, int fr, int fq) const {
        if (u.part < 0) { EpiRes E{X, XB, rss, Sp, Ss}; E(acc, u, wr, wc, fr, fq); return; }
        const int row0 = (u.pm - 64) * 256 + wr * 64 + fr, col0 = u.pn * 256 + wc * 32 + 8 * fq;
        float* pp = part + (size_t)u.part * 512 * 1024;
#pragma unroll
        for (int ai = 0; ai < 2; ++ai)
#pragma unroll
            for (int m = 0; m < 4; ++m)
#pragma unroll
                for (int bj = 0; bj < 2; ++bj) {
                    float* xp = pp + (size_t)(row0 + ai * 128 + m * 16) * 1024 + col0 + bj * 128;
                    *(f32x4*)xp = acc[ai][bj][m][0]; *(f32x4*)(xp + 4) = acc[ai][bj][m][1];
                }
    }
};
__device__ __forceinline__ void sample_fix(const Args& a, float* rss, const float* part, const float* Ss = nullptr) {
    const int tid = otid(), lane = tid & 63, wave = tid >> 6;
    bf16* xb = (bf16*)(a.ws + WS_XB);
    for (int r = T_P + blockIdx.x * 8 + wave; r < TT; r += gridDim.x * 8) {
        float4* xi = (float4*)(a.out + (size_t)r * 1024);
        const float4* xs = Ss ? (const float4*)(Ss + (size_t)(r - T_P) * 1024) : (const float4*)xi;
        uint2* bo = (uint2*)(xb + (size_t)r * 1024);
        float ss = 0.f;
#pragma unroll
        for (int j = 0; j < 4; ++j) {
            float4 v = xs[lane + 64 * j];
#pragma unroll
            for (int s = 0; s < 8; ++s) { const float4 p = ((const float4*)(part + ((size_t)s * 512 + (r - T_P)) * 1024))[lane + 64 * j]; v.x += p.x; v.y += p.y; v.z += p.z; v.w += p.w; }
            xi[lane + 64 * j] = v;
            ss += (v.x * v.x + v.y * v.y) + (v.z * v.z + v.w * v.w); uint2 w; w.x = pk2(v.x, v.y); w.y = pk2(v.z, v.w); bo[lane + 64 * j] = w;
        }
        ss = wave_sum(ss);
        if (lane == 0) rss[r] = ss;
    }
}

template <class Epi> __device__ __forceinline__ void skinny_gemm(const bf16* __restrict__ A  , const bf16* __restrict__ Bt, int N, int K, const Epi& E) {
    const int tid = otid(), wave = tid >> 6, lane = tid & 63, fr = lane & 15, fq = lane >> 4;
    const int nN = N >> 7, nU = 8 * nN;
    for (int u = blockIdx.x; u < nU; u += gridDim.x) {
        const int mb = u / nN, nb = u - mb * nN, n0 = nb * 128 + wave * 16;
        const bf16* ap = A + (size_t)(mb * 64 + fr) * K + 8 * fq;
        const bf16* bp = Bt + (size_t)(n0 + fr) * K + 8 * fq;
        f32x4 acc[4];
#pragma unroll
        for (int m = 0; m < 4; ++m) acc[m] = (f32x4){0.f, 0.f, 0.f, 0.f};
#pragma unroll 4
        for (int k = 0; k < K; k += 32) {
            const pg8::bf16x8 bfr = *(const pg8::bf16x8*)(bp + k);
#pragma unroll
            for (int m = 0; m < 4; ++m) { const pg8::bf16x8 af = *(const pg8::bf16x8*)(ap + (size_t)m * 16 * K + k); acc[m] = __builtin_amdgcn_mfma_f32_16x16x32_bf16(bfr, af, acc[m], 0, 0, 0); }
        }
        E(acc, T_P + mb * 64 + fr, n0 + 4 * fq, fq);
    }
}
template <bool RELU2> struct SkScale {
    bf16* O; int ldc; const float* rss;
    __device__ __forceinline__ void operator()(const f32x4 (&acc)[4], int row, int col, int fq) const {
#pragma unroll
        for (int m = 0; m < 4; ++m) {
            const int r = row + 16 * m;
            const float rs = rsqrtf(rss[r] * (1.f / 1024.f) + NORM_EPS);
            f32x4 v = acc[m] * rs;
            if (RELU2) {
#pragma unroll
                for (int e = 0; e < 4; ++e) { const float p = fmaxf(v[e], 0.f); v[e] = p * p; }
            }
            uint2 w; w.x = pg8::cvt_pk_bf16(v[0], v[1]); w.y = pg8::cvt_pk_bf16(v[2], v[3]);
            *(uint2*)(O + (size_t)r * ldc + col) = w;
        }
    }
};
struct SkRes {
    float* X; bf16* XB; float* rss;
    __device__ __forceinline__ void operator()(const f32x4 (&acc)[4], int row, int col, int fq) const {
#pragma unroll
        for (int m = 0; m < 4; ++m) {
            const int r = row + 16 * m;
            float* xp = X + (size_t)r * 1024 + col;
            const f32x4 x = *(const f32x4*)xp + acc[m];
            *(f32x4*)xp = x;
            uint2 w; w.x = pg8::cvt_pk_bf16(x[0], x[1]); w.y = pg8::cvt_pk_bf16(x[2], x[3]);
            *(uint2*)(XB + (size_t)r * 1024 + col) = w;
            float ss = (x[0] * x[0] + x[1] * x[1]) + (x[2] * x[2] + x[3] * x[3]);
            ss += __shfl_xor(ss, 16); ss += __shfl_xor(ss, 32);
            if (fq == 0) atomicAdd(rss + r, ss);
        }
    }
};

__device__ __forceinline__ void tr_item(const float* __restrict__ W, int K, int Nsrc, bf16* __restrict__ WT, const float* __restrict__ gain, bool inmap, float* scr, int item, int nblk, int lane) {
    const int kb = item / nblk, nb = item - kb * nblk, k0 = 64 * kb, n0 = 32 * nb;
    const int n = n0 + (lane & 31);
    int ns = n;
    if (inmap) ns = n < 1536 ? n : n + 8;
    float tv[32];
    const int nsc = ns >= 0 ? ns : 0;
#pragma unroll
    for (int i = 0; i < 32; ++i) tv[i] = W[(size_t)(k0 + 2 * i + (lane >> 5)) * Nsrc + nsc];
#pragma unroll
    for (int i = 0; i < 32; ++i) {
        const int kk = 2 * i + (lane >> 5);
        float v = ns >= 0 ? tv[i] : 0.f;
        if (gain) v *= gain[k0 + kk];
        scr[kk * 33 + (lane & 31)] = v;
    }
    LDS_WAIT();
    const int c = lane & 7;
#pragma unroll
    for (int j = 0; j < 4; ++j) {
        const int nn = (lane >> 3) + 8 * j; const float* s = scr + (8 * c) * 33 + nn;
        uint4 o; o.x = pk2(s[0], s[33]); o.y = pk2(s[66], s[99]); o.z = pk2(s[132], s[165]); o.w = pk2(s[198], s[231]);
        *(uint4*)(WT + (size_t)(n0 + nn) * K + k0 + 8 * c) = o;
    }
    LDS_WAIT();
}

__device__ __forceinline__ void convert_layer(const Args& a, int l, float* scr, int gw, int NGW, int lane) {
    bf16* wb = (bf16*)(a.ws + WS_W) + (size_t)l * WL_ELEMS;
    for (int it = gw; it < 6016; it += NGW) {
        int r = it;
        if (r < 1408) tr_item(a.in[I_WIN] + (size_t)l * 1024 * 2824, 1024, 2824, wb + WOFF_IN, a.in[I_N1G] + l * 1024, true, scr, r, 88, lane);
        else if ((r -= 1408) < 512) tr_item(a.in[I_WOUT] + (size_t)l * 1024 * 1024, 1024, 1024, wb + WOFF_OUT, nullptr, false, scr, r, 32, lane);
        else if ((r -= 512) < 2048) tr_item(a.in[I_WUP] + (size_t)l * 1024 * 4096, 1024, 4096, wb + WOFF_UP, a.in[I_N2G] + l * 1024, false, scr, r, 128, lane);
        else { r -= 2048; tr_item(a.in[I_WDN] + (size_t)l * 4096 * 1024, 4096, 1024, wb + WOFF_DOWN, nullptr, false, scr, r, 32, lane); }
    }
}
__device__ __forceinline__ void phase0(const Args& a, unsigned char* lds) {
    const int tid = otid(), lane = tid & 63, wave = tid >> 6;
    const int gw = blockIdx.x * 8 + wave, NGW = gridDim.x * 8;
    float* scr = (float*)(lds + wave * 16384);
    convert_layer(a, 0, scr, gw, NGW, lane);
    if (MK_PER_PHASE || gridDim.x != 256) convert_layer(a, 1, scr, gw, NGW, lane);
    {
        bf16* BAW = (bf16*)(a.ws + WS_BAW);
        for (int i = blockIdx.x * 512 + tid; i < 2 * 16 * 1024; i += gridDim.x * 512) {
            const int l = i >> 14, n = (i >> 10) & 15, kk = i & 1023;
            const float v = n < 8 ? a.in[I_WIN][((size_t)l * 1024 + kk) * 2824 + 1536 + n] * a.in[I_N1G][l * 1024 + kk] : 0.f;
            BAW[i] = (bf16)f2bf(v);
        }
    }
    float* rowss = (float*)(a.ws + WS_ROWSS);
    bf16* xb = (bf16*)(a.ws + WS_XB);
    for (int r = gw; r < TT; r += NGW) {
        const float* src = r < T_P ? a.in[I_XP] + (size_t)r * 1024 : a.in[I_XS] + (size_t)(r - T_P) * 1024;
        float4 v[4]; float ss = 0.f;
#pragma unroll
        for (int j = 0; j < 4; ++j) { v[j] = ((const float4*)src)[lane + 64 * j]; ss += (v[j].x * v[j].x + v[j].y * v[j].y) + (v[j].z * v[j].z + v[j].w * v[j].w); }
        ss = wave_sum(ss);
        if (lane == 0) rowss[r] = ss;
        uint2* bo = (uint2*)(xb + (size_t)r * 1024);
#pragma unroll
        for (int j = 0; j < 4; ++j) { uint2 w; w.x = pk2(v[j].x, v[j].y); w.y = pk2(v[j].z, v[j].w); bo[lane + 64 * j] = w; }
    }
    for (int i = blockIdx.x * 512 + tid; i < 6 * TT; i += gridDim.x * 512) rowss[TT + i] = 0.f;
    {
        bf16* LW = (bf16*)(a.ws + WS_LW);
        for (int i = blockIdx.x * 512 + tid; i < 2 * 81920; i += gridDim.x * 512) {
            const int l = i / 81920; int r = i - l * 81920; float v;
            if (r < 16384) { const int c = r >> 6, j = r & 63; v = a.in[I_CW2][((size_t)l * 64 + j) * 256 + c]; }
            else if (r < 32768) { r -= 16384; const int c = r >> 6, j = r & 63; v = a.in[I_CA2][((size_t)l * 64 + j) * 256 + c]; }
            else if (r < 65536) { r -= 32768; const int c = r >> 7, j = r & 127; v = a.in[I_CG2][((size_t)l * 128 + j) * 256 + c]; }
            else { r -= 65536; const int c = r >> 6, cin = r & 63; v = a.in[I_DW][(((size_t)l * 4 + (c >> 6)) * 64 + cin) * 64 + (c & 63)]; }
            LW[i] = (bf16)f2bf(v);
        }
    }
}

template <int N> __device__ __forceinline__ void prev_c(const Args& a, int l, int row, int ccol, float (&o)[N]) {
    const bf16* P = (const bf16*)(a.ws + WS_P);
    bool first, smp = row >= T_P; int b = 0;
    if (!smp) first = (row & 2047) == 0; else { const int rs = row - T_P; first = (rs & 3) == 0; b = rs >> 2; }
    const int pr = row > 0 ? row - 1 : 0;
    float pv[N], sv[N];
    ldbf<N>(P + (size_t)pr * PN + PC_C + ccol, pv);
    ldf<N>(a.in[I_SCS] + ((size_t)l * 128 + b) * 1024 + ccol, sv);
#pragma unroll
    for (int i = 0; i < N; ++i) o[i] = first ? (smp ? sv[i] : 0.f) : pv[i];
}

__device__ __forceinline__ int tile_row(int tile, int i) { return i < 64 ? tile * 64 + i : T_P + tile * 2 + (i - 64); }
constexpr int XS = 264;
template <int KSTEPS> __device__ __forceinline__ void lora_mfma(const bf16* X, int joff, const bf16* __restrict__ WT, int wave, int lane, f32x4 (&acc)[5][2]) {
    const int fr = lane & 15, fq = lane >> 4;
#pragma unroll
    for (int m = 0; m < 5; ++m) { acc[m][0] = (f32x4){0.f, 0.f, 0.f, 0.f}; acc[m][1] = (f32x4){0.f, 0.f, 0.f, 0.f}; }
#pragma unroll
    for (int k = 0; k < KSTEPS; ++k) {
        pg8::bf16x8 bf[2];
#pragma unroll
        for (int n = 0; n < 2; ++n) bf[n] = *(const pg8::bf16x8*)(WT + (size_t)(wave * 32 + n * 16 + fr) * (32 * KSTEPS) + k * 32 + 8 * fq);
#pragma unroll
        for (int m = 0; m < 5; ++m) {
            const pg8::bf16x8 af = *(const pg8::bf16x8*)(X + (m * 16 + fr) * XS + joff + k * 32 + 8 * fq);
#pragma unroll
            for (int n = 0; n < 2; ++n) acc[m][n] = __builtin_amdgcn_mfma_f32_16x16x32_bf16(bf[n], af, acc[m][n], 0, 0, 0);
        }
    }
}

__device__ __forceinline__ void aux_tile(const Args& a, int l, int tile, unsigned char* lds) {
    const int tid = otid(), c = tid & 255, half = tid >> 8;
    const bf16* P = (const bf16*)(a.ws + WS_P);
    bf16* X = (bf16*)lds;
    {
        const float mu = a.in[I_CMU][l * 1024 + 768 + c];
#pragma unroll
        for (int j = 0; j < 33; ++j) {
            const int i = half * 33 + j, row = tile_row(tile, i);
            const float cur = bf2f(P[(size_t)row * PN + PC_C + 768 + c]);
            float pv[1]; prev_c<1>(a, l, row, 768 + c, pv);
            float xm = cur + (pv[0] - cur) * mu;
            if (c < 64) xm = tanh_(xm); else if (c >= 128) xm = sigm(xm);
            X[i * XS + c] = (bf16)f2bf(xm);
        }
    }
    __syncthreads();
    const int wave = tid >> 6, lane = tid & 63, fr = lane & 15, fq = lane >> 4;
    const bf16* LW = (const bf16*)(a.ws + WS_LW) + (size_t)l * 81920;
    float* auxw = (float*)(a.ws + WS_AUXW); bf16* auxa = (bf16*)(a.ws + WS_AUXA); bf16* auxg = (bf16*)(a.ws + WS_AUXG);
    f32x4 acc[5][2];
    lora_mfma<2>(X, 0, LW, wave, lane, acc);
#pragma unroll
    for (int n = 0; n < 2; ++n) {
        const int cc = wave * 32 + n * 16 + 4 * fq;
        const float4 w0c = *(const float4*)(a.in[I_CW0] + l * 256 + cc);
#pragma unroll
        for (int m = 0; m < 5; ++m) {
            const int tok = m * 16 + fr;
            if (tok < 66) {
                float4 o;
                o.x = __expf(-__expf(-softplus_(-(w0c.x + acc[m][n][0])) - 0.5f)); o.y = __expf(-__expf(-softplus_(-(w0c.y + acc[m][n][1])) - 0.5f));
                o.z = __expf(-__expf(-softplus_(-(w0c.z + acc[m][n][2])) - 0.5f)); o.w = __expf(-__expf(-softplus_(-(w0c.w + acc[m][n][3])) - 0.5f));
                *(float4*)(auxw + (size_t)tile_row(tile, tok) * 256 + cc) = o;
            }
        }
    }
    lora_mfma<2>(X, 64, LW + 16384, wave, lane, acc);
#pragma unroll
    for (int n = 0; n < 2; ++n) {
        const int cc = wave * 32 + n * 16 + 4 * fq;
        const float4 a0c = *(const float4*)(a.in[I_CA0] + l * 256 + cc);
#pragma unroll
        for (int m = 0; m < 5; ++m) {
            const int tok = m * 16 + fr;
            if (tok < 66) { uint2 o; o.x = pk2(sigm(a0c.x + acc[m][n][0]), sigm(a0c.y + acc[m][n][1])); o.y = pk2(sigm(a0c.z + acc[m][n][2]), sigm(a0c.w + acc[m][n][3])); *(uint2*)(auxa + (size_t)tile_row(tile, tok) * 256 + cc) = o; }
        }
    }
    lora_mfma<4>(X, 128, LW + 32768, wave, lane, acc);
#pragma unroll
    for (int n = 0; n < 2; ++n) {
        const int cc = wave * 32 + n * 16 + 4 * fq;
#pragma unroll
        for (int m = 0; m < 5; ++m) {
            const int tok = m * 16 + fr;
            if (tok < 66) { uint2 o; o.x = pk2(acc[m][n][0], acc[m][n][1]); o.y = pk2(acc[m][n][2], acc[m][n][3]); *(uint2*)(auxg + (size_t)tile_row(tile, tok) * 256 + cc) = o; }
        }
    }
    __syncthreads();
}

__device__ __forceinline__ void pool_tile(const Args& a, int l, int tile, unsigned char* lds) {
    bf16* X = (bf16*)lds;
    const int tid = otid(), c = tid & 255, half = tid >> 8, r0 = tile * 64;
    const bf16* P = (const bf16*)(a.ws + WS_P);
    bf16* mixed = (bf16*)(a.ws + WS_MIXED);
    const int gi = c >> 6, w = 2 << gi;
    unsigned short* Sg = (unsigned short*)(lds + 43008);
#pragma unroll
    for (int j = 0; j < 40; ++j) {
        const int k = half * 40 + j;
        if (k < 79) { const int gr = r0 - 15 + k; unsigned short v = 0; if (gr >= 0) v = P[(size_t)gr * PN + PC_D + c]; Sg[k * 256 + c] = v; }
    }
    __syncthreads();
    for (int j = 0; j < 32; ++j) {
        const int i = half * 32 + j, row = r0 + i;
        const unsigned short* sp = Sg + (15 + i) * 256 + c;
        const float xc = bf2f(sp[0]);
        const int b = row >> 11, t = row & 2047;
        const int n = t + 1 < w ? t + 1 : w;
        float sum = xc;
#pragma unroll
        for (int q = 1; q < 16; ++q) { const float hv = bf2f(sp[-q * 256]); if (q < n) sum += hv; }
        if (t >= 2033) a.out[O_PDP + (((size_t)l * 8 + b) * 15 + (t - 2033)) * 256 + c] = xc;
        X[i * XS + c] = (bf16)f2bf(sum / (float)n - xc);
    }
    {
        const int i = 64 + half, rs = tile * 2 + half, row = T_P + rs, b = rs >> 2, t = rs & 3;
        const float* sb = a.in[I_SDP] + ((size_t)l * 128 + b) * 15 * 256 + c;
        const float xc = bf2f(P[(size_t)row * PN + PC_D + c]);
        float hv[15];
#pragma unroll
        for (int q = 1; q < 16; ++q) {
            const int tq = t - q;
            const float pv = bf2f(P[(size_t)(row - (tq >= 0 ? q : 0)) * PN + PC_D + c]);
            const float sv = sb[(tq >= 0 ? 0 : 15 + tq) * 256];
            hv[q - 1] = tq >= 0 ? pv : sv;
        }
        float sum = xc;
#pragma unroll
        for (int q = 1; q < 16; ++q) if (q < w) sum += hv[q - 1];
        float* so = a.out + O_SDP + ((size_t)l * 128 + b) * 15 * 256 + c;
        so[(11 + t) * 256] = xc;
        if (t == 0) {
            float tv[11];
#pragma unroll
            for (int jj = 0; jj < 11; ++jj) tv[jj] = sb[(jj + 4) * 256];
#pragma unroll
            for (int jj = 0; jj < 11; ++jj) so[jj * 256] = tv[jj];
        }
        X[i * XS + c] = (bf16)f2bf(sum / (float)w - xc);
    }
    __syncthreads();
    {
        const int wave = tid >> 6, lane = tid & 63, fr = lane & 15, fq = lane >> 4;
        const bf16* LW = (const bf16*)(a.ws + WS_LW) + (size_t)l * 81920 + 65536;
        f32x4 acc[5][2];
        lora_mfma<2>(X, (wave >> 1) * 64, LW, wave, lane, acc);
#pragma unroll
        for (int n = 0; n < 2; ++n) {
            const int cc = wave * 32 + n * 16 + 4 * fq;
            const float4 sc = *(const float4*)(a.in[I_DSC] + l * 256 + cc);
#pragma unroll
            for (int m = 0; m < 5; ++m) {
                const int tok = m * 16 + fr;
                if (tok < 66) { uint2 o; o.x = pk2(acc[m][n][0] * sc.x, acc[m][n][1] * sc.y); o.y = pk2(acc[m][n][2] * sc.z, acc[m][n][3] * sc.w); *(uint2*)(mixed + (size_t)tile_row(tile, tok) * 1024 + 768 + cc) = o; }
            }
        }
    }
    for (int i = 0; i < 66; ++i) {
        const int row = tile_row(tile, i); int b, t, tl; bool smp;
        if (row < T_P) { b = row >> 11; t = row & 2047; tl = 2047; smp = false; } else { const int rs = row - T_P; b = rs >> 2; t = rs & 3; tl = 3; smp = true; }
        if (t == tl) {
            float* o = a.out + (smp ? O_SCS + ((size_t)l * 128 + b) * 1024 : O_PCS + ((size_t)l * 8 + b) * 1024);
            const float v0 = bf2f(P[(size_t)row * PN + PC_C + tid]), v1 = bf2f(P[(size_t)row * PN + PC_C + 512 + tid]);
            o[tid] = v0; o[512 + tid] = v1;
        }
        if (t >= tl - 2) {
            const int j = t - (tl - 2);
            float* o = a.out + (smp ? O_SBC + (((size_t)l * 128 + b) * 3 + j) * 768 : O_PBC + (((size_t)l * 8 + b) * 3 + j) * 768);
            const float v0 = bf2f(P[(size_t)row * PN + PC_BQ + tid]);
            o[tid] = v0;
            if (tid < 256) o[512 + tid] = bf2f(P[(size_t)row * PN + PC_BQ + 512 + tid]);
        }
    }
    __syncthreads();
}

__device__ __forceinline__ void gmlp_prompt_item(const Args& a, int l, int it, unsigned char* lds) {
    const int tid = otid(), t = tid >> 2, q = tid & 3;
    const int b = it >> 6, nc = (it >> 2) & 15, h = it & 3;
    const int row = b * 2048 + nc * 128 + t;
    const bf16* Pb = (const bf16*)(a.ws + WS_P);
    const bf16* Prow = Pb + (size_t)row * PN;
    bf16* mixed = (bf16*)(a.ws + WS_MIXED);
    bf16* wsb = (bf16*)lds;
    bf16* vT = (bf16*)(lds + 34816);
    const float rstd = rsqrtf(((const float*)(a.ws + WS_ROWSS))[(size_t)(5 + l) * TT + row] * (1.f / 256.f) + NORM_EPS);
    {
        const float* vg = a.in[I_AVG] + l * 256 + h * 64 + q * 16;
#pragma unroll
        for (int k = 0; k < 2; ++k) { float x[8]; ld8(Prow + 256 + h * 64 + q * 16 + k * 8, x);
#pragma unroll
            for (int e = 0; e < 8; ++e) vT[(q * 16 + k * 8 + e) * 136 + t] = (bf16)f2bf(gelu_t(x[e]) * rstd * vg[k * 8 + e]); }
    }
    {
        const float* wsrc = a.in[I_AWS] + ((size_t)l * 4 + h) * 16384;
        float4 wv[8];
#pragma unroll
        for (int j = 0; j < 8; ++j) { const int idx = tid + 512 * j; wv[j] = *(const float4*)(wsrc + (idx >> 5) * 128 + (idx & 31) * 4); }
#pragma unroll
        for (int j = 0; j < 8; ++j) {
            const int idx = tid + 512 * j, rr = idx >> 5, s0 = (idx & 31) * 4;
            uint2 o; o.x = pk2(s0 <= rr ? wv[j].x : 0.f, s0 + 1 <= rr ? wv[j].y : 0.f); o.y = pk2(s0 + 2 <= rr ? wv[j].z : 0.f, s0 + 3 <= rr ? wv[j].w : 0.f);
            *(uint2*)(wsb + rr * 136 + s0) = o;
        }
    }
    __syncthreads();
    const int wave = tid >> 6, lane = tid & 63, fr = lane & 15, fq = lane >> 4;
    f32x4 acc[4];
#pragma unroll
    for (int n = 0; n < 4; ++n) acc[n] = (f32x4){0.f, 0.f, 0.f, 0.f};
    const int nk = (wave >> 1) + 1;
#pragma unroll
    for (int k = 0; k < 4; ++k) {
        if (k < nk) {
            const pg8::bf16x8 af = *(const pg8::bf16x8*)(wsb + (wave * 16 + fr) * 136 + k * 32 + 8 * fq);
#pragma unroll
            for (int n = 0; n < 4; ++n) { const pg8::bf16x8 bfr = *(const pg8::bf16x8*)(vT + (n * 16 + fr) * 136 + k * 32 + 8 * fq); acc[n] = __builtin_amdgcn_mfma_f32_16x16x32_bf16(bfr, af, acc[n], 0, 0, 0); }
        }
    }
    {
        const int tt = wave * 16 + fr, ro = b * 2048 + nc * 128 + tt;
        const float bs = a.in[I_ABS][((size_t)l * 4 + h) * 128 + tt];
#pragma unroll
        for (int n = 0; n < 4; ++n) {
            const int cc = h * 64 + n * 16 + 4 * fq;
            float u[4]; ld4(Pb + (size_t)ro * PN + cc, u);
            uint2 o; o.x = pk2(gelu_t(u[0]) * (acc[n][0] + bs), gelu_t(u[1]) * (acc[n][1] + bs)); o.y = pk2(gelu_t(u[2]) * (acc[n][2] + bs), gelu_t(u[3]) * (acc[n][3] + bs));
            *(uint2*)(mixed + (size_t)ro * 1024 + cc) = o;
        }
    }
    __syncthreads();
}
__device__ __forceinline__ void gmlp_sample_item(const Args& a, int l, int b, float* Ls  ) {
    const int tid = otid(), lane = tid & 63, wave = tid >> 6, t = tid >> 7, c0 = (tid & 127) * 2;
    const int row = T_P + b * 4 + t;
    const bf16* Prow = (const bf16*)(a.ws + WS_P) + (size_t)row * PN;
    bf16* mixed = (bf16*)(a.ws + WS_MIXED);
    float* red = Ls + 1024;
    float x[2]; ld2(Prow + 256 + c0, x);
    const float g0 = gelu_t(x[0]), g1 = gelu_t(x[1]);
    const float ss = wave_sum(g0 * g0 + g1 * g1);
    if (lane == 0) red[wave] = ss;
    __syncthreads();
    const float rstd = rsqrtf((red[2 * t] + red[2 * t + 1]) * (1.f / 256.f) + NORM_EPS);
    const float v0 = g0 * rstd * a.in[I_AVG][l * 256 + c0], v1 = g1 * rstd * a.in[I_AVG][l * 256 + c0 + 1];
    Ls[t * 256 + c0] = v0; Ls[t * 256 + c0 + 1] = v1;
    float* sav = a.out + O_SAV + (((size_t)l * 128 + b) * 4 + t) * 256 + c0;
    sav[0] = v0; sav[1] = v1;
    __syncthreads();
    const int h = c0 >> 6;
    const float* wrow = a.in[I_AWS] + (((size_t)l * 4 + h) * 128 + t) * 128;
    const float bs = a.in[I_ABS][((size_t)l * 4 + h) * 128 + t];
    float m0 = bs, m1 = bs;
    for (int s = 0; s <= t; ++s) { const float ww = wrow[s]; m0 += ww * Ls[s * 256 + c0]; m1 += ww * Ls[s * 256 + c0 + 1]; }
    float u[2]; ld2(Prow + c0, u);
    *(unsigned*)(mixed + (size_t)row * 1024 + c0) = pk2(gelu_t(u[0]) * m0, gelu_t(u[1]) * m1);
    __syncthreads();
}

__device__ __forceinline__ void ba_tile(const Args& a, int l, int tile, unsigned char* lds) {
    const int tid = otid(), wave = tid >> 6, lane = tid & 63, fr = lane & 15, fq = lane >> 4;
    const bf16* xb = (const bf16*)(a.ws + WS_XB);
    const bf16* BAW = (const bf16*)(a.ws + WS_BAW) + (size_t)l * 16384;
    float* red = (float*)lds;
    f32x4 acc[5];
#pragma unroll
    for (int m = 0; m < 5; ++m) acc[m] = (f32x4){0.f, 0.f, 0.f, 0.f};
#pragma unroll
    for (int k = 0; k < 4; ++k) {
        const int kk = wave * 128 + k * 32 + 8 * fq;
        const pg8::bf16x8 bfr = *(const pg8::bf16x8*)(BAW + fr * 1024 + kk);
#pragma unroll
        for (int m = 0; m < 5; ++m) {
            const int tok = m * 16 + fr, row = tile_row(tile, tok < 66 ? tok : 65);
            const pg8::bf16x8 af = *(const pg8::bf16x8*)(xb + (size_t)row * 1024 + kk);
            acc[m] = __builtin_amdgcn_mfma_f32_16x16x32_bf16(bfr, af, acc[m], 0, 0, 0);
        }
    }
#pragma unroll
    for (int m = 0; m < 5; ++m) *(f32x4*)(red + ((wave * 80) + m * 16 + fr) * 16 + 4 * fq) = acc[m];
    __syncthreads();
    const float* rss = (const float*)(a.ws + WS_ROWSS) + (size_t)(2 * l) * TT;
    float* BA = (float*)(a.ws + WS_BA);
    for (int e = tid; e < 66 * 8; e += 512) {
        const int tok = e >> 3, n = e & 7, row = tile_row(tile, tok);
        float s = 0.f;
#pragma unroll
        for (int w = 0; w < 8; ++w) s += red[(w * 80 + tok) * 16 + n];
        BA[(size_t)row * 8 + n] = s * rsqrtf(rss[row] * (1.f / 1024.f) + NORM_EPS);
    }
    __syncthreads();
}

__device__ __forceinline__ void phase_pre(const Args& a, int l, unsigned char* lds, int mode = 0) {
    float* L = (float*)lds;
    const int G = gridDim.x, g = blockIdx.x;
    if (mode != 2) for (int tile = g; tile < 256; tile += G) { aux_tile(a, l, tile, lds); pool_tile(a, l, tile, lds); ba_tile(a, l, tile, lds); }
    if (mode != 1) for (int it = g; it < 512; it += G) gmlp_prompt_item(a, l, it, lds);
    if (G != 256 || MK_PER_PHASE) for (int it = g; it < 128; it += G) gmlp_sample_item(a, l, it, L);
}

struct ChunkD { int valid, mixer, h, cg, b, sample, row0, t0, n, first, last; };
__device__ __forceinline__ ChunkD get_chunk(int idx, int g, int G, int mode = 0) {
    ChunkD d; d.valid = 0; d.mixer = 0; d.h = 0; d.cg = 0; d.b = 0; d.sample = 0; d.row0 = 0; d.t0 = 0; d.n = 0; d.first = 0; d.last = 0;
    int nP = g < 256 ? (256 - g + G - 1) / G : 0;
    int nS = g < 4096 ? (4096 - g + G - 1) / G : 0;
    nS = 0;
    if (mode == 2) nP = 0;
    if (idx < nP * 64) {
        const int it = g + (idx >> 6) * G, ch = idx & 63;
        d.valid = 1; d.mixer = it & 1; d.cg = (it >> 1) & 3; d.h = (it >> 3) & 3; d.b = it >> 5; d.sample = 0; d.row0 = d.b * 2048; d.t0 = ch * 32; d.n = 32; d.first = ch == 0; d.last = ch == 63;
    } else {
        const int j = idx - nP * 64;
        if (j < nS) { const int it = g + j * G; d.valid = 1; d.mixer = it & 1; d.cg = (it >> 1) & 3; d.h = (it >> 3) & 3; d.b = it >> 5; d.sample = 1; d.row0 = T_P + d.b * 4; d.t0 = 0; d.n = 4; d.first = 1; d.last = 1; }
    }
    return d;
}
constexpr int OPB_FLOATS = 10752;

struct Raw { uint4 u[8]; unsigned s[4]; float w[2]; };
__device__ __forceinline__ void unpack8(const uint4 u, float (&o)[8]) {
    o[0] = __uint_as_float(u.x << 16); o[1] = __uint_as_float(u.x & 0xffff0000u); o[2] = __uint_as_float(u.y << 16); o[3] = __uint_as_float(u.y & 0xffff0000u);
    o[4] = __uint_as_float(u.z << 16); o[5] = __uint_as_float(u.z & 0xffff0000u); o[6] = __uint_as_float(u.w << 16); o[7] = __uint_as_float(u.w & 0xffff0000u);
}
__device__ __forceinline__ uint4 pack8f(const float* p) {
    const float4 x = *(const float4*)p, y = *(const float4*)(p + 4);
    uint4 o; o.x = pk2(x.x, x.y); o.y = pk2(x.z, x.w); o.z = pk2(y.x, y.y); o.w = pk2(y.z, y.w); return o;
}
__device__ __forceinline__ void raw_load(const Args& a, int l, const ChunkD& d, int ptid, Raw& R) {
    const int tok = ptid >> 3, sub = ptid & 7;
    if (!d.valid || tok >= d.n) return;
    const int t = d.t0 + tok, row = d.row0 + t;
    const bf16* P = (const bf16*)(a.ws + WS_P);
    const uint4 z4 = make_uint4(0u, 0u, 0u, 0u);
    if (d.mixer == 0) {
        const int cq = d.h * 64 + sub * 8, cv = 512 + d.h * 64 + d.cg * 16 + sub * 2;
#pragma unroll
        for (int k = 0; k < 4; ++k) {
            const int tt = t - 3 + k;
            if (tt >= 0) { const bf16* pr = P + (size_t)(d.row0 + tt) * PN + PC_BQ; R.u[k] = *(const uint4*)(pr + cq); R.u[4 + k] = *(const uint4*)(pr + 256 + cq); R.s[k] = *(const unsigned*)(pr + cv); }
            else if (d.sample) { const float* sp = a.in[I_SBC] + (((size_t)l * 128 + d.b) * 3 + (tt + 3)) * 768; R.u[k] = pack8f(sp + cq); R.u[4 + k] = pack8f(sp + 256 + cq); R.s[k] = pk2(sp[cv], sp[cv + 1]); }
            else { R.u[k] = z4; R.u[4 + k] = z4; R.s[k] = 0u; }
        }
        { const float* ba = (const float*)(a.ws + WS_BA) + (size_t)row * 8; R.w[0] = ba[d.h]; R.w[1] = ba[4 + d.h]; }
    } else {
        const int ch = d.h * 64 + sub * 8, vcl = 512 + d.h * 64 + d.cg * 16 + sub * 2;
        const bf16* pc = P + (size_t)row * PN + PC_C;
        R.u[0] = *(const uint4*)(pc + ch); R.u[1] = *(const uint4*)(pc + 256 + ch); R.s[0] = *(const unsigned*)(pc + vcl);
        if (t > 0) { const bf16* pp = pc - PN; R.u[2] = *(const uint4*)(pp + ch); R.u[3] = *(const uint4*)(pp + 256 + ch); R.s[1] = *(const unsigned*)(pp + vcl); }
        else if (d.sample) { const float* sp = a.in[I_SCS] + ((size_t)l * 128 + d.b) * 1024; R.u[2] = pack8f(sp + ch); R.u[3] = pack8f(sp + 256 + ch); R.s[1] = pk2(sp[vcl], sp[vcl + 1]); }
        else { R.u[2] = z4; R.u[3] = z4; R.s[1] = 0u; }
        R.u[4] = *(const uint4*)((const bf16*)(a.ws + WS_AUXA) + (size_t)row * 256 + ch);
        const float* wp = (const float*)(a.ws + WS_AUXW) + (size_t)row * 256 + ch;
        R.u[5] = *(const uint4*)wp; R.u[6] = *(const uint4*)(wp + 4);
    }
}
__device__ __forceinline__ void prep_math(const Args& a, int l, const ChunkD& d, const Raw& R, float* ob, float* CST, int ptid) {
    const int tok = ptid >> 3, sub = ptid & 7;
    if (!d.valid || tok >= d.n) return;
    const int row = d.row0 + d.t0 + tok;
    float* Rp = ob + tok * 64 + sub * 8;
    float* V = ob + 10240 + tok * 16 + sub * 2;
    float r[8], w[8], k[8], kk[8], bb[8], v[2];
    if (d.mixer == 0) {
        const int cq = d.h * 64 + sub * 8, cv = 512 + d.h * 64 + d.cg * 16 + sub * 2;
        float q[8], kr[8];
#pragma unroll
        for (int i = 0; i < 8; ++i) { q[i] = 0.f; kr[i] = 0.f; }
        v[0] = 0.f; v[1] = 0.f;
        float* cst = CST + sub * 80;
        if (d.first) {
#pragma unroll
            for (int kx = 0; kx < 4; ++kx) {
                const float* cw = a.in[I_BCW] + ((size_t)l * 4 + kx) * 768;
                *(float4*)(cst + kx * 20) = *(const float4*)(cw + cq); *(float4*)(cst + kx * 20 + 4) = *(const float4*)(cw + cq + 4);
                *(float4*)(cst + kx * 20 + 8) = *(const float4*)(cw + 256 + cq); *(float4*)(cst + kx * 20 + 12) = *(const float4*)(cw + 256 + cq + 4);
                *(float2*)(cst + kx * 20 + 16) = *(const float2*)(cw + cv);
            }
        }
#pragma unroll
        for (int kx = 0; kx < 4; ++kx) {
            float xq[8], xk[8]; unpack8(R.u[kx], xq); unpack8(R.u[4 + kx], xk);
            const float4 a0 = *(const float4*)(cst + kx * 20), a1 = *(const float4*)(cst + kx * 20 + 4), b0 = *(const float4*)(cst + kx * 20 + 8), b1 = *(const float4*)(cst + kx * 20 + 12);
            const float2 c0 = *(const float2*)(cst + kx * 20 + 16);
            q[0] += xq[0] * a0.x; q[1] += xq[1] * a0.y; q[2] += xq[2] * a0.z; q[3] += xq[3] * a0.w; q[4] += xq[4] * a1.x; q[5] += xq[5] * a1.y; q[6] += xq[6] * a1.z; q[7] += xq[7] * a1.w;
            kr[0] += xk[0] * b0.x; kr[1] += xk[1] * b0.y; kr[2] += xk[2] * b0.z; kr[3] += xk[3] * b0.w; kr[4] += xk[4] * b1.x; kr[5] += xk[5] * b1.y; kr[6] += xk[6] * b1.z; kr[7] += xk[7] * b1.w;
            v[0] += __uint_as_float(R.s[kx] << 16) * c0.x; v[1] += __uint_as_float(R.s[kx] & 0xffff0000u) * c0.y;
        }
        float sq = 0.f, sk = 0.f;
#pragma unroll
        for (int i = 0; i < 8; ++i) { q[i] = silu(q[i]); kr[i] = silu(kr[i]); sq += q[i] * q[i]; sk += kr[i] * kr[i]; }
        v[0] = silu(v[0]); v[1] = silu(v[1]);
        sq = sum8(sq); sk = sum8(sk);
        const float iq = rsqrtf(sq + 1e-6f) * 0.125f, ik = rsqrtf(sk + 1e-6f);
        const float beta = sigm(R.w[0]);
        const float gg = -__expf(a.in[I_BAL][l * 4 + d.h]) * softplus_(R.w[1] + a.in[I_BDT][l * 4 + d.h]);
        const float dec = __expf(gg);
#pragma unroll
        for (int i = 0; i < 8; ++i) { const float kn = kr[i] * ik; r[i] = q[i] * iq; w[i] = dec; kk[i] = kn; k[i] = beta * kn; bb[i] = dec * beta * kn; }
    } else {
        const int ch = d.h * 64 + sub * 8, vcl = 512 + d.h * 64 + d.cg * 16 + sub * 2;
        float cur[8], pv[8], kx[8], av[8];
        const float* mu = a.in[I_CMU] + l * 1024;
        float m0[8], m1[8], kkw[8], kaw[8], rkw[8];
        float* cst = CST + sub * 80;
        if (d.first) {
            *(float4*)(cst) = *(const float4*)(mu + ch); *(float4*)(cst + 4) = *(const float4*)(mu + ch + 4);
            *(float4*)(cst + 8) = *(const float4*)(mu + 256 + ch); *(float4*)(cst + 12) = *(const float4*)(mu + 256 + ch + 4);
            const float* p1 = a.in[I_CKK] + l * 256 + ch; *(float4*)(cst + 16) = *(const float4*)p1; *(float4*)(cst + 20) = *(const float4*)(p1 + 4);
            const float* p2 = a.in[I_CKA] + l * 256 + ch; *(float4*)(cst + 24) = *(const float4*)p2; *(float4*)(cst + 28) = *(const float4*)(p2 + 4);
            const float* p3 = a.in[I_CRK] + l * 256 + ch; *(float4*)(cst + 32) = *(const float4*)p3; *(float4*)(cst + 36) = *(const float4*)(p3 + 4);
            *(float2*)(cst + 40) = *(const float2*)(mu + vcl);
        }
        ldf<8>(cst, m0); ldf<8>(cst + 8, m1); ldf<8>(cst + 16, kkw); ldf<8>(cst + 24, kaw); ldf<8>(cst + 32, rkw);
        const float mv0 = cst[40], mv1 = cst[41];
        unpack8(R.u[0], cur); unpack8(R.u[2], pv);
#pragma unroll
        for (int i = 0; i < 8; ++i) r[i] = cur[i] + (pv[i] - cur[i]) * m0[i];
        unpack8(R.u[1], cur); unpack8(R.u[3], pv);
#pragma unroll
        for (int i = 0; i < 8; ++i) kx[i] = cur[i] + (pv[i] - cur[i]) * m1[i];
        {
            const float c0 = __uint_as_float(R.s[0] << 16), c1 = __uint_as_float(R.s[0] & 0xffff0000u), p0 = __uint_as_float(R.s[1] << 16), p1 = __uint_as_float(R.s[1] & 0xffff0000u);
            v[0] = c0 + (p0 - c0) * mv0; v[1] = c1 + (p1 - c1) * mv1;
        }
        unpack8(R.u[4], av);
        float ss = 0.f;
#pragma unroll
        for (int i = 0; i < 8; ++i) { kk[i] = kx[i] * kkw[i]; ss += kk[i] * kk[i]; }
        w[0] = __uint_as_float(R.u[5].x); w[1] = __uint_as_float(R.u[5].y); w[2] = __uint_as_float(R.u[5].z); w[3] = __uint_as_float(R.u[5].w); w[4] = __uint_as_float(R.u[6].x); w[5] = __uint_as_float(R.u[6].y); w[6] = __uint_as_float(R.u[6].z); w[7] = __uint_as_float(R.u[6].w);
        ss = sum8(ss);
        const float inv = rsqrtf(ss + 1e-6f);
        float rk = 0.f;
#pragma unroll
        for (int i = 0; i < 8; ++i) { kk[i] *= inv; k[i] = kx[i] * (1.f + (av[i] - 1.f) * kaw[i]); bb[i] = kk[i] * av[i]; rk += r[i] * k[i] * rkw[i]; }
        rk = sum8(rk);
        if (sub == 0 && d.cg == 0) ((float*)(a.ws + WS_RK))[(size_t)row * 4 + d.h] = rk;
    }
    *(float4*)(Rp) = make_float4(r[0], r[1], r[2], r[3]); *(float4*)(Rp + 4) = make_float4(r[4], r[5], r[6], r[7]);
    *(float4*)(Rp + 2048) = make_float4(w[0], w[1], w[2], w[3]); *(float4*)(Rp + 2052) = make_float4(w[4], w[5], w[6], w[7]);
    *(float4*)(Rp + 4096) = make_float4(k[0], k[1], k[2], k[3]); *(float4*)(Rp + 4100) = make_float4(k[4], k[5], k[6], k[7]);
    *(float4*)(Rp + 6144) = make_float4(kk[0], kk[1], kk[2], kk[3]); *(float4*)(Rp + 6148) = make_float4(kk[4], kk[5], kk[6], kk[7]);
    *(float4*)(Rp + 8192) = make_float4(bb[0], bb[1], bb[2], bb[3]); *(float4*)(Rp + 8196) = make_float4(bb[4], bb[5], bb[6], bb[7]);
    V[0] = v[0]; V[1] = v[1];
}

__device__ __forceinline__ void flush_y(const Args& a, const ChunkD& d, const float* Yb, int ptid) {
    if (!d.valid) return;
    float* yraw = (float*)(a.ws + WS_XB) + (size_t)d.mixer * TT * 256;
    for (int e = ptid; e < d.n * 16; e += 256) {
        const float4* yp = (const float4*)(Yb + e * 16);
        const float4 a0 = yp[0], a1 = yp[1], a2 = yp[2], a3 = yp[3];
        const float y = ((a0.x + a0.y) + (a0.z + a0.w)) + ((a1.x + a1.y) + (a1.z + a1.w)) + ((a2.x + a2.y) + (a2.z + a2.w)) + ((a3.x + a3.y) + (a3.z + a3.w));
        const int st = e >> 4, c = e & 15; yraw[(size_t)(d.row0 + d.t0 + st) * 256 + d.h * 64 + d.cg * 16 + c] = y;
    }
}

typedef float f2 __attribute__((ext_vector_type(2)));
struct Ops { f32x4 r, w, k, q, b; float v; };
__device__ __forceinline__ void ops_load(Ops& o, const float* Rb, const float* Vb, int st) {
    o.r = *(const f32x4*)(Rb + st * 64); o.w = *(const f32x4*)(Rb + 2048 + st * 64); o.k = *(const f32x4*)(Rb + 4096 + st * 64);
    o.q = *(const f32x4*)(Rb + 6144 + st * 64); o.b = *(const f32x4*)(Rb + 8192 + st * 64); o.v = Vb[st * 16];
}
__device__ __forceinline__ void scan_step(const Ops& o, f2& S01, f2& S23, float* Yp) {
    const f2 p2 = o.q.xy * S01 + o.q.zw * S23;
    const float sk = dpp_sum16(p2.x + p2.y);
    const f2 vv = {o.v, o.v}, sk2 = {sk, sk};
    const f2 t01 = o.k.xy * vv - o.b.xy * sk2, t23 = o.k.zw * vv - o.b.zw * sk2;
    S01 = o.w.xy * S01 + t01; S23 = o.w.zw * S23 + t23;
    const f2 y2 = o.r.xy * S01 + o.r.zw * S23;
    *Yp = y2.x + y2.y;
}
__device__ __forceinline__ const float* state_in_ptr(const Args& a, int l, const ChunkD& d, int kg, int cc) {
    return a.in[d.mixer ? I_SCW : I_SBS] + ((((size_t)l * 128 + d.b) * 4 + d.h) * 64 + 4 * kg) * 64 + d.cg * 16 + cc;
}
__device__ __forceinline__ void consume_chunk(const Args& a, int l, const ChunkD& d, const ChunkD& nx, const float* ob, float* Yb, f2& S01, f2& S23, float (&Sn)[4], int wave, int lane) {
    const int kg = lane & 15, cc = wave * 4 + (lane >> 4);
    if (d.first) {
        if (d.sample) { S01.x = Sn[0]; S01.y = Sn[1]; S23.x = Sn[2]; S23.y = Sn[3]; }
        else { S01.x = 0.f; S01.y = 0.f; S23.x = 0.f; S23.y = 0.f; }
    }
    if (nx.valid && nx.first && nx.sample) { const float* sp = state_in_ptr(a, l, nx, kg, cc); Sn[0] = sp[0]; Sn[1] = sp[64]; Sn[2] = sp[128]; Sn[3] = sp[192]; }
    const float* Rb = ob + 4 * kg; const float* Vb = ob + 10240 + cc; float* Yp = Yb + cc * 16 + kg;
    Ops o0, o1, o2;
    ops_load(o0, Rb, Vb, 0); ops_load(o1, Rb, Vb, 1);
    for (int st = 0; st < d.n; st += 4) {
        ops_load(o2, Rb, Vb, st + 2); scan_step(o0, S01, S23, Yp + st * 256);
        ops_load(o0, Rb, Vb, st + 3); scan_step(o1, S01, S23, Yp + (st + 1) * 256);
        ops_load(o1, Rb, Vb, st + 4); scan_step(o2, S01, S23, Yp + (st + 2) * 256);
        ops_load(o2, Rb, Vb, st + 5); scan_step(o0, S01, S23, Yp + (st + 3) * 256);
        o0 = o1; o1 = o2;
    }
    if (d.last) {
        size_t off;
        if (d.sample) off = (d.mixer ? O_SCW : O_SBS) + ((((size_t)l * 128 + d.b) * 4 + d.h) * 64 + 4 * kg) * 64 + d.cg * 16 + cc;
        else off = (d.mixer ? O_PCW : O_PBS) + ((((size_t)l * 8 + d.b) * 4 + d.h) * 64 + 4 * kg) * 64 + d.cg * 16 + cc;
        float* sp = a.out + off;
        sp[0] = S01.x; sp[64] = S01.y; sp[128] = S23.x; sp[192] = S23.y;
    }
}

__device__ __forceinline__ void sample_item(const Args& a, int l, int it, float* wl  , int lane) {
    const int mixer = it & 1, h = (it >> 1) & 3, b = it >> 3;
    const bf16* P = (const bf16*)(a.ws + WS_P);
    const int row0 = T_P + b * 4;
    float S[64];
    {
        const float* sp = a.in[mixer ? I_SCW : I_SBS] + (((size_t)l * 128 + b) * 4 + h) * 4096 + lane;
#pragma unroll
        for (int k = 0; k < 64; ++k) S[k] = sp[k * 64];
    }
    float* yraw = (float*)(a.ws + WS_XB) + (size_t)mixer * TT * 256;
    const int ch = h * 64 + lane;
    float cq[4], ck[4], cv[4], mur = 0.f, muk = 0.f, muv = 0.f, kkw = 0.f, kaw = 0.f, rkw = 0.f, alog = 0.f, dtb = 0.f;
    if (mixer == 0) {
#pragma unroll
        for (int k = 0; k < 4; ++k) { const float* cw = a.in[I_BCW] + ((size_t)l * 4 + k) * 768; cq[k] = cw[ch]; ck[k] = cw[256 + ch]; cv[k] = cw[512 + ch]; }
        alog = a.in[I_BAL][l * 4 + h]; dtb = a.in[I_BDT][l * 4 + h];
    } else {
#pragma unroll
        for (int k = 0; k < 4; ++k) { cq[k] = 0.f; ck[k] = 0.f; cv[k] = 0.f; }
        const float* mu = a.in[I_CMU] + l * 1024; mur = mu[ch]; muk = mu[256 + ch]; muv = mu[512 + ch];
        kkw = a.in[I_CKK][l * 256 + ch]; kaw = a.in[I_CKA][l * 256 + ch]; rkw = a.in[I_CRK][l * 256 + ch];
    }
    float xq[7], xk[7], xv[7];
    if (mixer == 0) {
        const float* sb = a.in[I_SBC] + ((size_t)l * 128 + b) * 3 * 768;
#pragma unroll
        for (int j = 0; j < 3; ++j) { xq[j] = sb[j * 768 + ch]; xk[j] = sb[j * 768 + 256 + ch]; xv[j] = sb[j * 768 + 512 + ch]; }
#pragma unroll
        for (int j = 0; j < 4; ++j) { const bf16* pr = P + (size_t)(row0 + j) * PN + PC_BQ; xq[3 + j] = bf2f(pr[ch]); xk[3 + j] = bf2f(pr[256 + ch]); xv[3 + j] = bf2f(pr[512 + ch]); }
    } else {
        const float* sc = a.in[I_SCS] + ((size_t)l * 128 + b) * 1024;
        xq[0] = 0.f; xk[0] = 0.f; xv[0] = 0.f; xq[1] = 0.f; xk[1] = 0.f; xv[1] = 0.f;
        xq[2] = sc[ch]; xk[2] = sc[256 + ch]; xv[2] = sc[512 + ch];
#pragma unroll
        for (int j = 0; j < 4; ++j) { const bf16* pr = P + (size_t)(row0 + j) * PN + PC_C; xq[3 + j] = bf2f(pr[ch]); xk[3 + j] = bf2f(pr[256 + ch]); xv[3 + j] = bf2f(pr[512 + ch]); }
    }
#pragma unroll
    for (int t = 0; t < 4; ++t) {
        const int row = row0 + t;
        float r, w, k, kk, bb, v;
        if (mixer == 0) {
            const float q0 = silu(xq[t] * cq[0] + xq[t + 1] * cq[1] + xq[t + 2] * cq[2] + xq[t + 3] * cq[3]);
            const float k0 = silu(xk[t] * ck[0] + xk[t + 1] * ck[1] + xk[t + 2] * ck[2] + xk[t + 3] * ck[3]);
            v = silu(xv[t] * cv[0] + xv[t + 1] * cv[1] + xv[t + 2] * cv[2] + xv[t + 3] * cv[3]);
            const float iq = rsqrtf(wave_sum(q0 * q0) + 1e-6f) * 0.125f, ik = rsqrtf(wave_sum(k0 * k0) + 1e-6f);
            const float* ba = (const float*)(a.ws + WS_BA) + (size_t)row * 8;
            const float beta = sigm(ba[h]);
            const float dec = __expf(-__expf(alog) * softplus_(ba[4 + h] + dtb));
            const float kn = k0 * ik; r = q0 * iq; w = dec; kk = kn; k = beta * kn; bb = dec * beta * kn;
        } else {
            r = xq[3 + t] + (xq[2 + t] - xq[3 + t]) * mur;
            const float kx = xk[3 + t] + (xk[2 + t] - xk[3 + t]) * muk;
            v = xv[3 + t] + (xv[2 + t] - xv[3 + t]) * muv;
            w = ((const float*)(a.ws + WS_AUXW))[(size_t)row * 256 + ch];
            const float av = bf2f(((const bf16*)(a.ws + WS_AUXA))[(size_t)row * 256 + ch]);
            const float kr = kx * kkw;
            kk = kr * rsqrtf(wave_sum(kr * kr) + 1e-6f);
            k = kx * (1.f + (av - 1.f) * kaw); bb = kk * av;
            const float rk = wave_sum(r * k * rkw);
            if (lane == 0) ((float*)(a.ws + WS_RK))[(size_t)row * 4 + h] = rk;
        }
        wl[lane] = r; wl[64 + lane] = w; wl[128 + lane] = k; wl[192 + lane] = kk; wl[256 + lane] = bb;
        LDS_WAIT();
        float sk = 0.f;
#pragma unroll
        for (int k4 = 0; k4 < 16; ++k4) { const float4 x = *(const float4*)(wl + 192 + 4 * k4); sk += (x.x * S[4 * k4] + x.y * S[4 * k4 + 1]) + (x.z * S[4 * k4 + 2] + x.w * S[4 * k4 + 3]); }
        float y = 0.f;
#pragma unroll
        for (int k4 = 0; k4 < 16; ++k4) {
            const float4 ww = *(const float4*)(wl + 64 + 4 * k4), kx4 = *(const float4*)(wl + 128 + 4 * k4), b4 = *(const float4*)(wl + 256 + 4 * k4), r4 = *(const float4*)(wl + 4 * k4);
            S[4 * k4 + 0] = ww.x * S[4 * k4 + 0] + (kx4.x * v - b4.x * sk); S[4 * k4 + 1] = ww.y * S[4 * k4 + 1] + (kx4.y * v - b4.y * sk);
            S[4 * k4 + 2] = ww.z * S[4 * k4 + 2] + (kx4.z * v - b4.z * sk); S[4 * k4 + 3] = ww.w * S[4 * k4 + 3] + (kx4.w * v - b4.w * sk);
            y += (r4.x * S[4 * k4 + 0] + r4.y * S[4 * k4 + 1]) + (r4.z * S[4 * k4 + 2] + r4.w * S[4 * k4 + 3]);
        }
        yraw[(size_t)row * 256 + ch] = y;
        LDS_WAIT();
    }
    {
        float* sp = a.out + (mixer ? O_SCW : O_SBS) + (((size_t)l * 128 + b) * 4 + h) * 4096 + lane;
#pragma unroll
        for (int k = 0; k < 64; ++k) sp[k * 64] = S[k];
    }
}

__device__ __forceinline__ void phase_scan(const Args& a, int l, unsigned char* lds, int mode = 0) {
    const int tid = otid(), lane = tid & 63, wave = __builtin_amdgcn_readfirstlane(tid >> 6);
    const int G = gridDim.x, g = blockIdx.x;
    float* OB = (float*)lds;
    float* YB = OB + 2 * OPB_FLOATS + 512;
    float* CST = YB + 2 * 8192;
    const bool prod = wave >= 4; const int ptid = tid - 256;
    ChunkD cp = get_chunk(0, g, G, mode), c0 = cp, c1 = get_chunk(1, g, G, mode), c2 = get_chunk(2, g, G, mode);
    Raw RA, RB;
    f2 S01 = {0.f, 0.f}, S23 = {0.f, 0.f}; float Sn[4] = {0.f, 0.f, 0.f, 0.f};
    if (prod) { raw_load(a, l, c0, ptid, RA); prep_math(a, l, c0, RA, OB, CST, ptid); raw_load(a, l, c1, ptid, RA); }
    else if (c0.valid && c0.first && c0.sample) { const float* sp = state_in_ptr(a, l, c0, lane & 15, wave * 4 + (lane >> 4)); Sn[0] = sp[0]; Sn[1] = sp[64]; Sn[2] = sp[128]; Sn[3] = sp[192]; }
    __syncthreads();
    int idx = 0;
    while (c0.valid) {
        if (!prod) consume_chunk(a, l, c0, c1, OB + (idx & 1) * OPB_FLOATS, YB + (idx & 1) * 8192, S01, S23, Sn, wave, lane);
        else { raw_load(a, l, c2, ptid, RB); prep_math(a, l, c1, RA, OB + ((idx + 1) & 1) * OPB_FLOATS, CST, ptid); if (idx > 0) flush_y(a, cp, YB + ((idx - 1) & 1) * 8192, ptid); }
        __syncthreads();
        cp = c0; c0 = c1; c1 = c2; c2 = get_chunk(idx + 3, g, G, mode); ++idx;
        if (!c0.valid) break;
        if (!prod) consume_chunk(a, l, c0, c1, OB + (idx & 1) * OPB_FLOATS, YB + (idx & 1) * 8192, S01, S23, Sn, wave, lane);
        else { raw_load(a, l, c2, ptid, RA); prep_math(a, l, c1, RB, OB + ((idx + 1) & 1) * OPB_FLOATS, CST, ptid); flush_y(a, cp, YB + ((idx - 1) & 1) * 8192, ptid); }
        __syncthreads();
        cp = c0; c0 = c1; c1 = c2; c2 = get_chunk(idx + 3, g, G, mode); ++idx;
    }
    if (prod && idx > 0) flush_y(a, cp, YB + ((idx - 1) & 1) * 8192, ptid);
    __syncthreads();
    if (mode != 1) {
        float* wl = (float*)lds + wave * 320;
        if ((G & 1) == 0) { if (g & 1) for (int it = (g >> 1) * 8 + wave; it < 1024; it += (G >> 1) * 8) sample_item(a, l, it, wl, lane); }
        else for (int it = g * 8 + wave; it < 1024; it += G * 8) sample_item(a, l, it, wl, lane);
        __syncthreads();
        if (G == 256 && !MK_PER_PHASE && (g & 1)) gmlp_sample_item(a, l, g >> 1, (float*)lds);
    }
}

__device__ __forceinline__ void phase_post(const Args& a, int l) {
    const int tid = otid(), lane = tid & 63, wave = tid >> 6;
    const int gw = blockIdx.x * 8 + wave, NGW = gridDim.x * 8;
    const bf16* P = (const bf16*)(a.ws + WS_P);
    bf16* mixed = (bf16*)(a.ws + WS_MIXED);
    const float* yraw = (const float*)(a.ws + WS_XB);
    const int h = lane >> 4, col = lane * 4;
    for (int r = gw; r < TT; r += NGW) {
        const bf16* Prow = P + (size_t)r * PN;
        {
            const float4 o = *(const float4*)(yraw + (size_t)r * 256 + col);
            const float ss = sum16((o.x * o.x + o.y * o.y) + (o.z * o.z + o.w * o.w));
            const float rstd = rsqrtf(ss * (1.f / 64.f) + NORM_EPS);
            float gt[4]; ld4(Prow + PC_BG + col, gt);
            const float* on = a.in[I_BON] + l * 64 + (col & 63);
            uint2 w; w.x = pk2(o.x * rstd * on[0] * silu(gt[0]), o.y * rstd * on[1] * silu(gt[1])); w.y = pk2(o.z * rstd * on[2] * silu(gt[2]), o.w * rstd * on[3] * silu(gt[3]));
            *(uint2*)(mixed + (size_t)r * 1024 + 256 + col) = w;
        }
        {
            const float4 y = *(const float4*)(yraw + (size_t)TT * 256 + (size_t)r * 256 + col);
            const float mean = sum16((y.x + y.y) + (y.z + y.w)) * (1.f / 64.f);
            const float d0 = y.x - mean, d1 = y.y - mean, d2 = y.z - mean, d3 = y.w - mean;
            const float var = sum16((d0 * d0 + d1 * d1) + (d2 * d2 + d3 * d3)) * (1.f / 64.f);
            const float rstd = rsqrtf(var + 64e-5f);
            float vc[4], vp[4], gg[4]; ld4(Prow + PC_C + 512 + col, vc); prev_c<4>(a, l, r, 512 + col, vp);
            ld4((const bf16*)(a.ws + WS_AUXG) + (size_t)r * 256 + col, gg);
            const float* mu = a.in[I_CMU] + l * 1024 + 512 + col;
            const float* lg = a.in[I_CLG] + l * 256 + col; const float* lb = a.in[I_CLB] + l * 256 + col;
            const float rk = ((const float*)(a.ws + WS_RK))[(size_t)r * 4 + h];
            const float dd[4] = {d0, d1, d2, d3}; float o[4];
#pragma unroll
            for (int i = 0; i < 4; ++i) { const float v = vc[i] + (vp[i] - vc[i]) * mu[i]; o[i] = (dd[i] * rstd * lg[i] + lb[i] + rk * v) * gg[i]; }
            uint2 w; w.x = pk2(o[0], o[1]); w.y = pk2(o[2], o[3]);
            *(uint2*)(mixed + (size_t)r * 1024 + 512 + col) = w;
        }
    }
}

__device__ __forceinline__ void phase_final(const Args& a) {
    const int tid = otid(), lane = tid & 63, wave = tid >> 6;
    const int gw = blockIdx.x * 8 + wave, NGW = gridDim.x * 8;
    const float* rss = (const float*)(a.ws + WS_ROWSS) + 4 * TT;
    for (int r = gw; r < TT; r += NGW) {
        const float rs = rsqrtf(rss[r] * (1.f / 1024.f) + NORM_EPS);
        float4* xo = (float4*)(a.out + (size_t)r * 1024);
#pragma unroll
        for (int j = 0; j < 4; ++j) { float4 v = xo[lane + 64 * j]; const float4 g = ((const float4*)a.in[I_FG])[lane + 64 * j]; v.x *= rs * g.x; v.y *= rs * g.y; v.z *= rs * g.z; v.w *= rs * g.w; xo[lane + 64 * j] = v; }
    }
}

#ifndef MK_PER_PHASE
#define MK_PER_PHASE 0
#endif
#ifndef USE_SKINNY
#define USE_SKINNY 0
#endif
constexpr int GM = USE_SKINNY ? T_P : TT;
#ifndef SCAN_PROBE_MODE
#define SCAN_PROBE_MODE 0
#endif
#ifndef PRE_PROBE_MODE
#define PRE_PROBE_MODE 0
#endif
#ifndef REP_P0
#define REP_P0 1
#endif
#ifndef REP_GIN
#define REP_GIN 1
#endif
#ifndef REP_PRE
#define REP_PRE 1
#endif
#ifndef REP_SCAN
#define REP_SCAN 1
#endif
#ifndef REP_POST
#define REP_POST 1
#endif
#ifndef REP_GUP
#define REP_GUP 1
#endif
__global__ void __launch_bounds__(512, 2) mk_fwd(Args a) {
    extern __shared__ __attribute__((aligned(16))) unsigned char lds[];
    cg::grid_group grid = cg::this_grid();
    const int lo = a.ph_lo, hi = a.ph_hi, G = gridDim.x;
    volatile LAS unsigned* bst = (volatile LAS unsigned*)((LAS unsigned char*)lds + (LDS_BYTES - 16));
    if (threadIdx.x < 4) bst[threadIdx.x] = 0u;
    __syncthreads();
    XcdBarrier xbar; xbar.bar = (unsigned*)(a.ws + WS_BAR); xbar.x = 0; xbar.st = nullptr;
    if (!MK_PER_PHASE) xbar = xcd_barrier_post((unsigned*)(a.ws + WS_BAR), bst);
#define IN(k) (lo <= (k) && (k) < hi)
#define SEAM(k) do { if (lo <= (k) && (k) + 1 < hi) { if ((k) == 0) grid.sync(); else xcd_barrier(xbar); } } while (0)
#define REPEAT(n) for (int rep_ = 0; rep_ < (n); ++rep_, (rep_ < (n) ? xcd_barrier(xbar) : (void)0))
    float* rowss = (float*)(a.ws + WS_ROWSS);
    bf16* xb = (bf16*)(a.ws + WS_XB); bf16* P = (bf16*)(a.ws + WS_P); bf16* mixed = (bf16*)(a.ws + WS_MIXED); bf16* hid = (bf16*)(a.ws + WS_HID);
    if (IN(0)) REPEAT(REP_P0) phase0(a, lds);
    SEAM(0);
    for (int l = 0; l < 2; ++l) {
        const int pb = 1 + 7 * l;
        const bf16* wb = (const bf16*)(a.ws + WS_W) + (size_t)l * WL_ELEMS;
        if (IN(pb + 0)) REPEAT(REP_GIN) {
            pg8::Gemm g{xb, wb + WOFF_IN, GM, NIN, 1024}; pg8::StaticOrder S; S.init(GM, NIN, G, (int)blockIdx.x);
            EpiScale<false> E{P, PN, rowss + (2 * l) * TT, rowss + (5 + l) * TT};
            pg8::gemm_phase<EpiScale<false>, pg8::StaticOrder, true, true>((PG8_LAS unsigned char*)lds, g, S, E);
#if USE_SKINNY
            SkScale<false> E2{P, PN, rowss + (2 * l) * TT};
            skinny_gemm(xb + (size_t)T_P * 1024, wb + WOFF_IN, PN, 1024, E2);
#endif
        }
        SEAM(pb + 0);
        if (IN(pb + 1)) REPEAT(REP_PRE) phase_pre(a, l, lds, rep_ == 0 ? 0 : PRE_PROBE_MODE);
        SEAM(pb + 1);
        if (IN(pb + 2)) REPEAT(REP_SCAN) phase_scan(a, l, lds, rep_ == 0 ? 0 : SCAN_PROBE_MODE);
        SEAM(pb + 2);
        if (IN(pb + 3)) REPEAT(REP_POST) phase_post(a, l);
        SEAM(pb + 3);
        if (IN(pb + 4)) {
            pg8::Gemm g{mixed, wb + WOFF_OUT, GM, 1024, 1024};
            if (G == 256 && !USE_SKINNY && !MK_PER_PHASE) {
                DownOrder S; S.c = (int)blockIdx.x; S.snt = 2;
                EpiResSplit E{a.out, xb, rowss + (2 * l + 1) * TT, (float*)(a.ws + WS_AUXW), l == 0 ? a.in[I_XP] : nullptr, l == 0 ? a.in[I_XS] : nullptr};
                pg8::gemm_phase<EpiResSplit, DownOrder, true, true>((PG8_LAS unsigned char*)lds, g, S, E);
                xcd_barrier(xbar);
                sample_fix(a, rowss + (2 * l + 1) * TT, (const float*)(a.ws + WS_AUXW), l == 0 ? a.in[I_XS] : nullptr);
            } else {
                pg8::StaticOrder S; S.init(GM, 1024, G, (int)blockIdx.x);
                EpiRes E{a.out, xb, rowss + (2 * l + 1) * TT, l == 0 ? a.in[I_XP] : nullptr, l == 0 ? a.in[I_XS] : nullptr};
                pg8::gemm_phase<EpiRes, pg8::StaticOrder, true, true>((PG8_LAS unsigned char*)lds, g, S, E);
#if USE_SKINNY
                SkRes E2{a.out, xb, rowss + (2 * l + 1) * TT};
                skinny_gemm(mixed + (size_t)T_P * 1024, wb + WOFF_OUT, 1024, 1024, E2);
#endif
            }
        }
        SEAM(pb + 4);
        if (IN(pb + 5)) REPEAT(REP_GUP) {
            pg8::Gemm g{xb, wb + WOFF_UP, GM, FF, 1024}; pg8::StaticOrder S; S.init(GM, FF, G, (int)blockIdx.x);
            EpiScale<true> E{hid, FF, rowss + (2 * l + 1) * TT};
            pg8::gemm_phase<EpiScale<true>, pg8::StaticOrder, true, true>((PG8_LAS unsigned char*)lds, g, S, E);
            if (l == 0 && !MK_PER_PHASE && G == 256 && blockIdx.x >= 32) {
                const int tid_ = otid();
                convert_layer(a, 1, (float*)(lds + (tid_ >> 6) * 16384), ((int)blockIdx.x - 32) * 8 + (tid_ >> 6), (G - 32) * 8, tid_ & 63);
            }
#if USE_SKINNY
            SkScale<true> E2{hid, FF, rowss + (2 * l + 1) * TT};
            skinny_gemm(xb + (size_t)T_P * 1024, wb + WOFF_UP, FF, 1024, E2);
#endif
        }
        SEAM(pb + 5);
        if (IN(pb + 6)) {
            pg8::Gemm g{hid, wb + WOFF_DOWN, GM, 1024, FF};
            if (G == 256 && !USE_SKINNY && !MK_PER_PHASE) {
                DownOrder S; S.c = (int)blockIdx.x; S.snt = 8;
                if (l == 1) {
                    EpiResFinal E{a.out, rowss + 4 * TT, (float*)(a.ws + WS_AUXW), a.in[I_FG], (unsigned*)(a.ws + WS_PCNT)};
                    pg8::gemm_phase<EpiResFinal, DownOrder, true, true>((PG8_LAS unsigned char*)lds, g, S, E);
                    xcd_barrier(xbar);
                    sample_fix_final(a, (const float*)(a.ws + WS_AUXW));
                } else {
                EpiResSplit E{a.out, xb, rowss + (2 * l + 2) * TT, (float*)(a.ws + WS_AUXW), nullptr, nullptr};
                pg8::gemm_phase<EpiResSplit, DownOrder, true, true>((PG8_LAS unsigned char*)lds, g, S, E);
                xcd_barrier(xbar);
                sample_fix(a, rowss + (2 * l + 2) * TT, (const float*)(a.ws + WS_AUXW));
                }
            } else {
                pg8::StaticOrder S; S.init(GM, 1024, G, (int)blockIdx.x);
                EpiRes E{a.out, xb, rowss + (2 * l + 2) * TT, nullptr, nullptr};
                pg8::gemm_phase<EpiRes, pg8::StaticOrder, true, true>((PG8_LAS unsigned char*)lds, g, S, E);
#if USE_SKINNY
                SkRes E2{a.out, xb, rowss + (2 * l + 2) * TT};
                skinny_gemm(hid + (size_t)T_P * FF, wb + WOFF_DOWN, 1024, FF, E2);
#endif
            }
        }
        if (!(l == 1 && G == 256 && !USE_SKINNY && !MK_PER_PHASE)) SEAM(pb + 6);
    }
    if (IN(15) && !(G == 256 && !USE_SKINNY && !MK_PER_PHASE)) phase_final(a);
#undef IN
#undef SEAM
}

extern "C" void kernel_launch(void* const* d_in, const int* in_sizes, int n_in, void* d_out, int out_size, void* d_ws, size_t ws_size, hipStream_t stream) {
    static int grid = 0;
    if (grid == 0) {
        int dev = 0, cus = 0, per_cu = 0;
        (void)hipGetDevice(&dev);
        (void)hipDeviceGetAttribute(&cus, hipDeviceAttributeMultiprocessorCount, dev);
        if (hipFuncSetAttribute((const void*)mk_fwd, hipFuncAttributeMaxDynamicSharedMemorySize, LDS_BYTES) != hipSuccess) { fprintf(stderr, "kernel_launch: hipFuncSetAttribute failed\n"); }
        if (hipOccupancyMaxActiveBlocksPerMultiprocessor(&per_cu, (const void*)mk_fwd, 512, LDS_BYTES) != hipSuccess || per_cu < 1) { fprintf(stderr, "kernel_launch: occupancy query reports %d\n", per_cu); per_cu = 1; }
        (void)hipGetLastError();
        if (per_cu > 1) per_cu = 1;
        if (cus <= 0) cus = 256;
        grid = cus * per_cu;
    }
    Args a{};
    for (int i = 0; i < 34; ++i) a.in[i] = (const float*)d_in[i];
    a.out = (float*)d_out; a.ws = (unsigned char*)d_ws;
    (void)hipMemsetAsync((unsigned char*)d_ws + WS_BAR, 0, BAR_ZERO_BYTES, stream);
#if MK_PER_PHASE
    for (int ph = 0; ph < NPHASE; ++ph) { a.ph_lo = ph; a.ph_hi = ph + 1; hipLaunchKernelGGL(mk_fwd, dim3(grid), dim3(512), LDS_BYTES, stream, a); }
#else
    a.ph_lo = 0; a.ph_hi = NPHASE;
    void* args[] = {&a};
    const hipError_t e = hipLaunchCooperativeKernel((const void*)mk_fwd, dim3(grid), dim3(512), args, LDS_BYTES, stream);
    if (e != hipSuccess) fprintf(stderr, "cooperative launch failed: %s (grid %d)\n", hipGetErrorString(e), grid);
#endif
}
```

```cpp
#include <hip/hip_runtime.h>
#include <hip/hip_cooperative_groups.h>
#include <cstdio>
#include <cstdint>
namespace cg = cooperative_groups;
#define MK_PER_PHASE 0
namespace pg8 {
#define PG8_LAS __attribute__((address_space(3)))
typedef unsigned short bf16_t;
typedef short bf16x8 __attribute__((ext_vector_type(8)));
typedef float f32x4 __attribute__((ext_vector_type(4)));
typedef unsigned u32x4 __attribute__((ext_vector_type(4)));
constexpr int BM = 256, BK = 64, HALF = 128, HTB = HALF * BK * 2  , STAGE_BYTES = 8 * HTB, NXCD = 8, WGM = 8;

__host__ __device__ __forceinline__ int lds_byte(int r, int c) { const int st = (r >> 4) * 2 + (c >> 5), rr = r & 15, cc = c & 31, ob = rr * 64 + cc * 2; return st * 1024 + (ob ^ (((ob >> 9) & 1) << 5)); }
__host__ __device__ __forceinline__ void stage_rc(int b, int& R, int& C) { const int st = b / 1024, sb = b % 1024, swz = sb ^ (((sb >> 9) & 1) << 5); R = (st >> 1) * 16 + swz / 64; C = (st & 1) * 32 + (swz % 64) / 2; }
__host__ __device__ __forceinline__ int perm32(int rho) { const int n = rho >> 4, i = rho & 15; return 8 * (i >> 2) + 4 * n + (i & 3); }

struct Unit { int pm, pn, kofs, nt, part; };
struct Gemm { const bf16_t* A; const bf16_t* Bt; int M, N, K; };

struct StaticOrder {
    int nM, nN, nwg, G, c;
    __host__ __device__ void init(int M, int N, int G_, int c_) { nM = M / BM; nN = N / BM; nwg = nM * nN; G = G_; c = c_; }
    __host__ __device__ bool next(int i, Unit& u) const {
        const long L = (long)i * G + c; if (L >= nwg) return false;
        int wgid = (int)L; { const int q = nwg / NXCD, r = nwg % NXCD, xcd = wgid % NXCD, off = wgid / NXCD; wgid = (xcd < r ? xcd * (q + 1) : r * (q + 1) + (xcd - r) * q) + off; }
        const int nig = WGM * nN, gid = wgid / nig, fm = gid * WGM, gsz = (nM - fm) < WGM ? (nM - fm) : WGM;
        u.pm = fm + ((wgid % nig) % gsz); u.pn = (wgid % nig) / gsz; u.kofs = 0; u.nt = 0; u.part = -1; return true;
    }
    __device__ __forceinline__ void a_ready(const Unit&) const {}
    __device__ __forceinline__ void done(const Unit&) const {}
};

__device__ __forceinline__ unsigned cvt_pk_bf16(float lo, float hi) { unsigned r; asm volatile("v_cvt_pk_bf16_f32 %0, %1, %2" : "=v"(r) : "v"(lo), "v"(hi)); return r; }
typedef float f32x2 __attribute__((ext_vector_type(2)));
template <class Epi, class Sched, bool ALIGN_EPI = false, bool SP2 = false>
__device__ __forceinline__ void gemm_phase(PG8_LAS unsigned char* lds, const Gemm g, const Sched& S, const Epi& E) {
    int tid_ = threadIdx.x; asm volatile("" : "+v"(tid_)); const int tid = tid_, wid = __builtin_amdgcn_readfirstlane(tid >> 6), lane = tid & 63, wr = wid >> 2, wc = wid & 3, fr = lane & 15, fq = lane >> 4;
    const int K = g.K, nt = K / BK;
    unsigned voffA[2], voffB[2];
#pragma unroll
    for (int i = 0; i < 2; ++i) { int R, C; stage_rc(tid * 16 + i * 8192, R, C); const int Rb = Epi::PERM ? ((R & ~31) + perm32(R & 31)) : R;
        voffA[i] = (unsigned)(R * K + C) * 2u; voffB[i] = (unsigned)(Rb * K + C) * 2u; }
    const size_t kstep = (size_t)(BK * 2);
    const size_t hstep = (size_t)HALF * K * 2;
    const size_t tstep = 2 * hstep;
    const unsigned ldsw = (unsigned)wid * 1024u;
    const int aoff = lds_byte(wr * 64 + fr, fq * 8), boff = lds_byte(wc * 32 + fr, fq * 8);
#define PG8_SA(b, h) (((b) * 2 + (h)) * HTB)
#define PG8_SB(b, h) ((4 + (b) * 2 + (h)) * HTB)
#define PG8_STAGE(bufoff, gbase, voff) do { _Pragma("unroll") for (int _i = 0; _i < 2; ++_i) \
        __builtin_amdgcn_global_load_lds((const unsigned*)((const char*)(gbase) + (voff)[_i]), (PG8_LAS unsigned*)(lds + (bufoff) + ldsw + _i * 8192), 16, 0, 0); } while (0)
#define PG8_LDA(dst, b, h) do { _Pragma("unroll") for (int m = 0; m < 4; ++m) _Pragma("unroll") for (int k = 0; k < 2; ++k) dst[m][k] = *(const PG8_LAS bf16x8*)(lds + PG8_SA(b, h) + aoff + m * 2048 + k * 1024); } while (0)
#define PG8_LDB(dst, b, h) do { _Pragma("unroll") for (int n = 0; n < 2; ++n) _Pragma("unroll") for (int k = 0; k < 2; ++k) dst[n][k] = *(const PG8_LAS bf16x8*)(lds + PG8_SB(b, h) + boff + n * 2048 + k * 1024); } while (0)
#define PG8_MMA(ai, bj, At, Bt) do { __builtin_amdgcn_s_setprio(1); _Pragma("unroll") for (int m = 0; m < 4; ++m) _Pragma("unroll") for (int n = 0; n < 2; ++n) _Pragma("unroll") for (int k = 0; k < 2; ++k) \
        acc[ai][bj][m][n] = __builtin_amdgcn_mfma_f32_16x16x32_bf16(Bt[n][k], At[m][k], acc[ai][bj][m][n], 0, 0, 0); __builtin_amdgcn_s_setprio(0); } while (0)
#define PG8_WAIT_V(n) asm volatile("s_waitcnt vmcnt(" #n ")" ::: "memory")
#define PG8_WAIT_L(n) asm volatile("s_waitcnt lgkmcnt(" #n ")" ::: "memory")
#define PG8_BAR __builtin_amdgcn_s_barrier()
#define PG8_SCHED __builtin_amdgcn_sched_barrier(0)
    Unit cur, nxt; int ui = 0;
    if (!S.next(0, cur)) return;
    f32x4 acc[2][2][4][2];
#pragma unroll
    for (int a = 0; a < 2; ++a)
#pragma unroll
        for (int b = 0; b < 2; ++b)
#pragma unroll
            for (int m = 0; m < 4; ++m)
#pragma unroll
                for (int n = 0; n < 2; ++n) acc[a][b][m][n] = (f32x4){0.f, 0.f, 0.f, 0.f};
    bf16x8 At[4][2], B0[2][2], B1[2][2];
    const char* cA = (const char*)g.A + (size_t)cur.pm * tstep + cur.kofs; const char* cB = (const char*)g.Bt + (size_t)cur.pn * tstep + cur.kofs;
    S.a_ready(cur);
    if constexpr (SP2) {
        PG8_STAGE(PG8_SB(0, 0), cB, voffB); PG8_STAGE(PG8_SB(0, 1), cB + hstep, voffB); PG8_STAGE(PG8_SA(0, 0), cA, voffA); PG8_STAGE(PG8_SA(0, 1), cA + hstep, voffA);
        if (wr == 1) PG8_BAR;
        PG8_WAIT_V(2); PG8_BAR;
        PG8_STAGE(PG8_SB(1, 0), cB + kstep, voffB); PG8_STAGE(PG8_SA(1, 0), cA + kstep, voffA); PG8_STAGE(PG8_SB(1, 1), cB + hstep + kstep, voffB);
        PG8_WAIT_V(6); PG8_BAR;
    } else {
        PG8_STAGE(PG8_SB(0, 0), cB, voffB); PG8_STAGE(PG8_SA(0, 0), cA, voffA); PG8_STAGE(PG8_SB(0, 1), cB + hstep, voffB); PG8_STAGE(PG8_SA(0, 1), cA + hstep, voffA);
        if (wr == 1) PG8_BAR;
        PG8_WAIT_V(4); PG8_BAR;
        PG8_STAGE(PG8_SB(1, 0), cB + kstep, voffB); PG8_STAGE(PG8_SA(1, 0), cA + kstep, voffA); PG8_STAGE(PG8_SB(1, 1), cB + hstep + kstep, voffB);
        PG8_WAIT_V(6); PG8_BAR;
    }
    for (;;) {
        const bool has_next = S.next(ui + 1, nxt);
        const char* nA = has_next ? (const char*)g.A + (size_t)nxt.pm * tstep + nxt.kofs : cA; const char* nB = has_next ? (const char*)g.Bt + (size_t)nxt.pn * tstep + nxt.kofs : cB;
        const int cnt = cur.nt ? cur.nt : nt;
        for (int t = 0; t < cnt; t += 2) {
            const bool last = (t == cnt - 2);
            const char* a1 = cA + (size_t)(t + 1) * kstep;
            const char* a2 = last ? nA : cA + (size_t)(t + 2) * kstep; const char* b2 = last ? nB : cB + (size_t)(t + 2) * kstep;
            const char* a3 = a2 + kstep; const char* b3 = b2 + kstep;
            if (last && has_next) S.a_ready(nxt);
            if constexpr (SP2) {
            PG8_LDB(B0, 0, 0); PG8_LDB(B1, 0, 1); PG8_SCHED; PG8_LDA(At, 0, 0); PG8_STAGE(PG8_SA(1, 1), a1 + hstep, voffA);
            PG8_WAIT_V(8); PG8_WAIT_L(0); PG8_BAR; PG8_MMA(0, 0, At, B0); PG8_MMA(0, 1, At, B1); PG8_BAR; PG8_SCHED;
            PG8_LDA(At, 0, 1); PG8_STAGE(PG8_SB(0, 0), b2, voffB); PG8_STAGE(PG8_SB(0, 1), b2 + hstep, voffB); PG8_STAGE(PG8_SA(0, 0), a2, voffA);
            PG8_WAIT_V(8); PG8_WAIT_L(0); PG8_BAR; PG8_MMA(1, 0, At, B0); PG8_MMA(1, 1, At, B1); PG8_BAR; PG8_SCHED;
            PG8_LDB(B0, 1, 0); PG8_LDB(B1, 1, 1); PG8_SCHED; PG8_LDA(At, 1, 0); PG8_STAGE(PG8_SA(0, 1), a2 + hstep, voffA);
            PG8_WAIT_V(8); PG8_WAIT_L(0); PG8_BAR; PG8_MMA(0, 0, At, B0); PG8_MMA(0, 1, At, B1); PG8_BAR; PG8_SCHED;
            PG8_LDA(At, 1, 1); PG8_STAGE(PG8_SB(1, 0), b3, voffB); PG8_STAGE(PG8_SB(1, 1), b3 + hstep, voffB); PG8_STAGE(PG8_SA(1, 0), a3, voffA);
            PG8_WAIT_V(8); PG8_WAIT_L(0); PG8_BAR; PG8_MMA(1, 0, At, B0); PG8_MMA(1, 1, At, B1); PG8_BAR; PG8_SCHED;
            } else {
            PG8_LDB(B0, 0, 0); PG8_SCHED; PG8_LDA(At, 0, 0); PG8_STAGE(PG8_SA(1, 1), a1 + hstep, voffA);
            PG8_WAIT_L(8); PG8_BAR; PG8_WAIT_L(0); PG8_MMA(0, 0, At, B0); PG8_BAR; PG8_SCHED;
            PG8_LDB(B1, 0, 1); PG8_STAGE(PG8_SB(0, 0), b2, voffB);
            PG8_BAR; PG8_WAIT_L(0); PG8_MMA(0, 1, At, B1); PG8_BAR;
            PG8_LDA(At, 0, 1); PG8_STAGE(PG8_SA(0, 0), a2, voffA);
            PG8_BAR; PG8_WAIT_L(0); PG8_MMA(1, 0, At, B0); PG8_BAR; PG8_SCHED;
            PG8_STAGE(PG8_SB(0, 1), b2 + hstep, voffB);
            PG8_WAIT_V(6); PG8_BAR; PG8_MMA(1, 1, At, B1); PG8_BAR;
            PG8_LDB(B0, 1, 0); PG8_SCHED; PG8_LDA(At, 1, 0); PG8_STAGE(PG8_SA(0, 1), a2 + hstep, voffA);
            PG8_WAIT_L(8); PG8_BAR; PG8_WAIT_L(0); PG8_MMA(0, 0, At, B0); PG8_BAR; PG8_SCHED;
            PG8_LDB(B1, 1, 1); PG8_STAGE(PG8_SB(1, 0), b3, voffB);
            PG8_BAR; PG8_WAIT_L(0); PG8_MMA(0, 1, At, B1); PG8_BAR;
            PG8_LDA(At, 1, 1); PG8_STAGE(PG8_SA(1, 0), a3, voffA);
            PG8_BAR; PG8_WAIT_L(0); PG8_MMA(1, 0, At, B0); PG8_BAR; PG8_SCHED;
            PG8_STAGE(PG8_SB(1, 1), b3 + hstep, voffB);
            PG8_WAIT_V(6); PG8_BAR; PG8_MMA(1, 1, At, B1); PG8_BAR;
            }
        }
        if constexpr (ALIGN_EPI) { if (wr == 0) PG8_BAR; }
        if constexpr (!Epi::AFTER_DRAIN) { E(acc, cur, wr, wc, fr, fq); S.done(cur); }
        if (!has_next) break;
#pragma unroll
        for (int a = 0; a < 2; ++a)
#pragma unroll
            for (int b = 0; b < 2; ++b)
#pragma unroll
                for (int m = 0; m < 4; ++m)
#pragma unroll
                    for (int n = 0; n < 2; ++n) acc[a][b][m][n] = (f32x4){0.f, 0.f, 0.f, 0.f};
        cur = nxt; cA = nA; cB = nB; ++ui;
        if constexpr (ALIGN_EPI) { if (wr == 1) PG8_BAR; }
    }
    PG8_WAIT_V(0);
    if constexpr (!ALIGN_EPI) { if (wr == 0) PG8_BAR; }
    PG8_BAR;
    if constexpr (Epi::AFTER_DRAIN) { E.fused(acc, cur, wr, wc, fr, fq, lds, wid, lane); S.done(cur); }
#undef PG8_SA
#undef PG8_SB
#undef PG8_STAGE
#undef PG8_LDA
#undef PG8_LDB
#undef PG8_MMA
#undef PG8_WAIT_V
#undef PG8_WAIT_L
#undef PG8_BAR
#undef PG8_SCHED
}
}

#define LAS __attribute__((address_space(3)))

#define XB_TMO      128
#define XB_XCNT(j)  (256  + 64 * (j))
#define XB_XSUB(j)  (1280 + 64 * (j))
#define XB_XGEN(j)  (2304 + 64 * (j))
#define XB_TOP      3328
#define XB_TOPGEN   3392
#define XCD_BAR_WORDS 3456
#define XB_SPIN_CAP (1u << 18)

__device__ __forceinline__ unsigned xb_ld(unsigned* p)              { return __hip_atomic_load(p, __ATOMIC_RELAXED, __HIP_MEMORY_SCOPE_AGENT); }
__device__ __forceinline__ unsigned xb_add(unsigned* p, unsigned v) { return __hip_atomic_fetch_add(p, v, __ATOMIC_RELAXED, __HIP_MEMORY_SCOPE_AGENT); }
__device__ __forceinline__ unsigned xb_xcc_id() { return (unsigned)__builtin_amdgcn_s_getreg((3 << 11) | 20) & 0xFu; }
#define XB_SPIN(cond, bar) do { unsigned _sp = 0; while (cond) { __builtin_amdgcn_s_sleep(1); \
    if ((++_sp & 255u) == 0u) { if (xb_ld(&(bar)[XB_TMO])) break; if (_sp > XB_SPIN_CAP) { atomicAdd(&(bar)[XB_TMO], 1u); break; } } } } while (0)

struct XcdBarrier {
    unsigned* bar; unsigned x;
    volatile LAS unsigned* st;
};

__device__ __forceinline__ XcdBarrier xcd_barrier_post(unsigned* bar, volatile LAS unsigned* st) {
    XcdBarrier b; b.bar = bar; b.x = xb_xcc_id(); b.st = st;
    if (threadIdx.x == 0) (void)xb_add(&bar[XB_XCNT(b.x)], 1u);
    return b;
}
__device__ __forceinline__ void xcd_barrier_complete(unsigned* bar, unsigned x, unsigned& nloc, unsigned& nx) {
    const unsigned G = gridDim.x * gridDim.y * gridDim.z;
    unsigned sum, cnt, mine, sp = 0u;
    for (;;) {
        sum = 0u; cnt = 0u; mine = 0u;
#pragma unroll
        for (unsigned j = 0; j < 16; ++j) { const unsigned c = xb_ld(&bar[XB_XCNT(j)]); sum += c; cnt += (c > 0u) ? 1u : 0u; mine = (j == x) ? c : mine; }
        if (sum == G) break;
        __builtin_amdgcn_s_sleep(1);
        if ((++sp & 255u) == 0u) { if (xb_ld(&bar[XB_TMO])) break; if (sp > XB_SPIN_CAP) { atomicAdd(&bar[XB_TMO], 1u); break; } }
    }
    nloc = mine > 0u ? mine : 1u; nx = cnt > 0u ? cnt : 1u;
}

__device__ __forceinline__ void xcd_barrier(const XcdBarrier& b) {
    asm volatile("s_waitcnt vmcnt(0)" ::: "memory");
    __syncthreads();
    if (threadIdx.x == 0) {
        unsigned* bar = b.bar;
        __builtin_amdgcn_s_waitcnt(0);
        unsigned nloc = b.st[0], nx = b.st[1];
        if (nloc == 0u) { xcd_barrier_complete(bar, b.x, nloc, nx); b.st[0] = nloc; b.st[1] = nx; }
        const unsigned old = xb_add(&bar[XB_XSUB(b.x)], 1u);
        const unsigned gen = old / nloc;
        if (old + 1u == (gen + 1u) * nloc) {
            __builtin_amdgcn_fence(__ATOMIC_RELEASE, "agent");
            asm volatile("s_waitcnt vmcnt(0)" ::: "memory");
            const unsigned og = xb_add(&bar[XB_TOP], 1u);
            const unsigned tg = og / nx;
            if (og + 1u == (tg + 1u) * nx) xb_add(&bar[XB_TOPGEN], 1u);
            else XB_SPIN(xb_ld(&bar[XB_TOPGEN]) == tg, bar);
            __builtin_amdgcn_fence(__ATOMIC_ACQUIRE, "agent");
            xb_add(&bar[XB_XGEN(b.x)], 1u);
            asm volatile("s_waitcnt vmcnt(0)" ::: "memory");
        } else {
            XB_SPIN(xb_ld(&bar[XB_XGEN(b.x)]) == gen, bar);
            __builtin_amdgcn_fence(__ATOMIC_ACQUIRE, "agent");
            asm volatile("s_waitcnt vmcnt(0)" ::: "memory");
        }
    }
    __syncthreads();
}

typedef unsigned short bf16;
typedef pg8::f32x4 f32x4;
typedef pg8::u32x4 u32x4;
constexpr int DM = 1024, T_P = 16384, T_S = 512, TT = 16896, PN = 3072, NIN = 2816, FF = 4096;
constexpr float NORM_EPS = 1e-6f;
constexpr int PC_A = 0, PC_BQ = 512, PC_BK = 768, PC_BV = 1024, PC_BG = 1280, PC_C = 1536, PC_D = 2560, PC_BA = 2816;
constexpr size_t MiB = 1u << 20;
constexpr size_t WS_ROWSS = 0;
constexpr size_t WS_RK = 512 * 1024;
constexpr size_t WS_BAR = 800 * 1024;
constexpr size_t WS_PCNT = WS_BAR + 14336;
constexpr size_t BAR_ZERO_BYTES = 14336 + 64 * 256;
constexpr size_t WS_W = 1 * MiB;
constexpr size_t WS_XB = 49 * MiB;
constexpr size_t WS_P = 82 * MiB;
constexpr size_t WS_MIXED = 181 * MiB;
constexpr size_t WS_HID = 82 * MiB;
constexpr size_t WS_AUXW = 214 * MiB;
constexpr size_t WS_AUXA = WS_AUXW + (size_t)TT * 256 * 4;
constexpr size_t WS_AUXG = WS_AUXA + (size_t)TT * 256 * 2;
constexpr size_t WS_LW = WS_AUXG + (size_t)TT * 256 * 2;
constexpr size_t WS_BAW = WS_LW + 2 * 81920 * 2;
constexpr size_t WS_BA = WS_BAW + 2 * 16 * 1024 * 2;
constexpr size_t WS_END = WS_BA + (size_t)TT * 8 * 4;
static_assert(WS_END <= 256 * MiB, "ws map");
constexpr size_t WOFF_IN = 0, WOFF_OUT = 3145728, WOFF_UP = 4194304, WOFF_DOWN = 8388608, WL_ELEMS = 12582912;
constexpr size_t O_YP = 0, O_YS = O_YP + (size_t)T_P * DM, O_PBC = O_YS + (size_t)T_S * DM, O_PBS = O_PBC + 2 * 8 * 3 * 768, O_PCS = O_PBS + 2 * 8 * 4 * 4096,
                 O_PCW = O_PCS + 2 * 8 * 1024, O_PDP = O_PCW + 2 * 8 * 4 * 4096, O_SAV = O_PDP + 2 * 8 * 15 * 256, O_SBC = O_SAV + 2 * 128 * 4 * 256,
                 O_SBS = O_SBC + 2 * 128 * 3 * 768, O_SCS = O_SBS + 2 * 128 * 4 * 4096, O_SCW = O_SCS + 2 * 128 * 1024, O_SDP = O_SCW + 2 * 128 * 4 * 4096,
                 O_END = O_SDP + 2 * 128 * 15 * 256;
static_assert(O_END == 28426240, "d_out map");
constexpr int LDS_BYTES = 163840;
constexpr int NPHASE = 16;

struct Args { const float* in[34]; float* out; unsigned char* ws; int ph_lo, ph_hi; };
enum { I_XP = 0, I_XS, I_SBC, I_SBS, I_SCS, I_SCW, I_SDP, I_N1G, I_WIN, I_AWS, I_ABS, I_AVG, I_BCW, I_BAL, I_BDT, I_BON, I_CMU, I_CW0, I_CW2, I_CA0, I_CA2, I_CG2,
       I_CKK, I_CKA, I_CRK, I_CLG, I_CLB, I_DW, I_DSC, I_WOUT, I_N2G, I_WUP, I_WDN, I_FG };

#define LDS_WAIT() asm volatile("s_waitcnt lgkmcnt(0)" ::: "memory")

__device__ __forceinline__ int otid() { int t = threadIdx.x; asm volatile("" : "+v"(t)); return t; }
__device__ __forceinline__ float bf2f(unsigned h) { return __uint_as_float(h << 16); }
__device__ __forceinline__ unsigned f2bf(float f) { unsigned u = __float_as_uint(f); return (u + 0x7fffu + ((u >> 16) & 1u)) >> 16; }
__device__ __forceinline__ unsigned pk2(float lo, float hi) { return f2bf(lo) | (f2bf(hi) << 16); }
__device__ __forceinline__ void ld8(const bf16* p, float (&o)[8]) {
    const uint4 u = *(const uint4*)p;
    o[0] = __uint_as_float(u.x << 16); o[1] = __uint_as_float(u.x & 0xffff0000u); o[2] = __uint_as_float(u.y << 16); o[3] = __uint_as_float(u.y & 0xffff0000u);
    o[4] = __uint_as_float(u.z << 16); o[5] = __uint_as_float(u.z & 0xffff0000u); o[6] = __uint_as_float(u.w << 16); o[7] = __uint_as_float(u.w & 0xffff0000u);
}
__device__ __forceinline__ void ld4(const bf16* p, float (&o)[4]) {
    const uint2 u = *(const uint2*)p;
    o[0] = __uint_as_float(u.x << 16); o[1] = __uint_as_float(u.x & 0xffff0000u); o[2] = __uint_as_float(u.y << 16); o[3] = __uint_as_float(u.y & 0xffff0000u);
}
__device__ __forceinline__ void ld2(const bf16* p, float (&o)[2]) { const unsigned u = *(const unsigned*)p; o[0] = __uint_as_float(u << 16); o[1] = __uint_as_float(u & 0xffff0000u); }
template <int N> __device__ __forceinline__ void ldbf(const bf16* p, float (&o)[N]);
template <> __device__ __forceinline__ void ldbf<8>(const bf16* p, float (&o)[8]) { ld8(p, o); }
template <> __device__ __forceinline__ void ldbf<4>(const bf16* p, float (&o)[4]) { ld4(p, o); }
template <> __device__ __forceinline__ void ldbf<2>(const bf16* p, float (&o)[2]) { ld2(p, o); }
template <> __device__ __forceinline__ void ldbf<1>(const bf16* p, float (&o)[1]) { o[0] = bf2f(*p); }
template <int N> __device__ __forceinline__ void ldf(const float* p, float (&o)[N]) {
#pragma unroll
    for (int i = 0; i < N; ++i) o[i] = p[i];
}
__device__ __forceinline__ float sigm(float x) { return __builtin_amdgcn_rcpf(1.f + __expf(-x)); }
__device__ __forceinline__ float silu(float x) { return x * sigm(x); }
__device__ __forceinline__ float tanh_(float y) { return 1.f - 2.f * __builtin_amdgcn_rcpf(1.f + __expf(2.f * y)); }
__device__ __forceinline__ float gelu_t(float x) { return 0.5f * x * (1.f + tanh_(0.7978845608028654f * (x + 0.044715f * x * x * x))); }
__device__ __forceinline__ float softplus_(float x) { const float u = __expf(-fabsf(x)); return fmaxf(x, 0.f) + (u < 1e-3f ? u * (1.f - 0.5f * u) : __logf(1.f + u)); }
__device__ __forceinline__ float wave_sum(float v) {
#pragma unroll
    for (int o = 1; o < 64; o <<= 1) v += __shfl_xor(v, o);
    return v;
}
__device__ __forceinline__ float sum8(float v) { v += __shfl_xor(v, 1); v += __shfl_xor(v, 2); v += __shfl_xor(v, 4); return v; }
__device__ __forceinline__ float sum16(float v) { v = sum8(v); v += __shfl_xor(v, 8); return v; }
__device__ __forceinline__ float dpp_sum16(float x) {
    x += __int_as_float(__builtin_amdgcn_update_dpp(0, __float_as_int(x), 0xB1, 0xF, 0xF, false));
    x += __int_as_float(__builtin_amdgcn_update_dpp(0, __float_as_int(x), 0x4E, 0xF, 0xF, false));
    x += __int_as_float(__builtin_amdgcn_update_dpp(0, __float_as_int(x), 0x141, 0xF, 0xF, false));
    x += __int_as_float(__builtin_amdgcn_update_dpp(0, __float_as_int(x), 0x140, 0xF, 0xF, false));
    return x;
}

template <bool RELU2> struct EpiScale {
    static constexpr bool PERM = true, AFTER_DRAIN = false;
    bf16* O; int ldc; const float* rss; float* vss;
    __device__ __forceinline__ void operator()(const f32x4 (&acc)[2][2][4][2], const pg8::Unit& u, int wr, int wc, int fr, int fq) const {
        const int row0 = u.pm * 256 + wr * 64 + fr, col0 = u.pn * 256 + wc * 32 + 8 * fq;
        const bool dov = !RELU2 && vss != nullptr && u.pn == 1;
#pragma unroll
        for (int ai = 0; ai < 2; ++ai)
#pragma unroll
            for (int m = 0; m < 4; ++m) {
                const int r = row0 + ai * 128 + m * 16;
                const float rs = rsqrtf(rss[r] * (1.f / 1024.f) + NORM_EPS);
                bf16* rowp = O + (size_t)r * ldc + col0;
                float gs = 0.f;
#pragma unroll
                for (int bj = 0; bj < 2; ++bj) {
                    f32x4 v0 = acc[ai][bj][m][0] * rs, v1 = acc[ai][bj][m][1] * rs;
                    if (dov) {
#pragma unroll
                        for (int e = 0; e < 4; ++e) { const float g0 = gelu_t(v0[e]), g1 = gelu_t(v1[e]); gs += g0 * g0 + g1 * g1; }
                    }
                    if (RELU2) {
#pragma unroll
                        for (int e = 0; e < 4; ++e) { const float p0 = fmaxf(v0[e], 0.f), p1 = fmaxf(v1[e], 0.f); v0[e] = p0 * p0; v1[e] = p1 * p1; }
                    }
                    u32x4 w; w.x = pg8::cvt_pk_bf16(v0[0], v0[1]); w.y = pg8::cvt_pk_bf16(v0[2], v0[3]); w.z = pg8::cvt_pk_bf16(v1[0], v1[1]); w.w = pg8::cvt_pk_bf16(v1[2], v1[3]);
                    *(u32x4*)(rowp + bj * 128) = w;
                }
                if (dov) { gs += __shfl_xor(gs, 16); gs += __shfl_xor(gs, 32); if (fq == 0) atomicAdd(vss + r, gs); }
            }
    }
};
struct EpiRes {
    static constexpr bool PERM = true, AFTER_DRAIN = false;
    float* X; bf16* XB; float* rss; const float* Sp; const float* Ss;
    __device__ __forceinline__ void operator()(const f32x4 (&acc)[2][2][4][2], const pg8::Unit& u, int wr, int wc, int fr, int fq) const {
        const int row0 = u.pm * 256 + wr * 64 + fr, col0 = u.pn * 256 + wc * 32 + 8 * fq;
#pragma unroll
        for (int ai = 0; ai < 2; ++ai)
#pragma unroll
            for (int m = 0; m < 4; ++m) {
                const int r = row0 + ai * 128 + m * 16;
                const float* srow = Sp ? (r < T_P ? Sp + (size_t)r * 1024 : Ss + (size_t)(r - T_P) * 1024) : X + (size_t)r * 1024;
                float ss = 0.f;
#pragma unroll
                for (int bj = 0; bj < 2; ++bj) {
                    float* xp = X + (size_t)r * 1024 + col0 + bj * 128;
                    const float* sp = srow + col0 + bj * 128;
                    const f32x4 x0 = *(const f32x4*)sp + acc[ai][bj][m][0], x1 = *(const f32x4*)(sp + 4) + acc[ai][bj][m][1];
                    *(f32x4*)xp = x0; *(f32x4*)(xp + 4) = x1;
                    u32x4 w; w.x = pg8::cvt_pk_bf16(x0[0], x0[1]); w.y = pg8::cvt_pk_bf16(x0[2], x0[3]); w.z = pg8::cvt_pk_bf16(x1[0], x1[1]); w.w = pg8::cvt_pk_bf16(x1[2], x1[3]);
                    *(u32x4*)(XB + (size_t)r * 1024 + col0 + bj * 128) = w;
                    ss += (x0[0] * x0[0] + x0[1] * x0[1]) + (x0[2] * x0[2] + x0[3] * x0[3]) + (x1[0] * x1[0] + x1[1] * x1[1]) + (x1[2] * x1[2] + x1[3] * x1[3]);
                }
                ss += __shfl_xor(ss, 16); ss += __shfl_xor(ss, 32);
                if (fq == 0) atomicAdd(rss + r, ss);
            }
    }
};

struct EpiResFinal {
    static constexpr bool PERM = true, AFTER_DRAIN = false;
    float* X; float* rss; float* part; const float* fg; unsigned* pcnt;
    __device__ __forceinline__ void operator()(const f32x4 (&acc)[2][2][4][2], const pg8::Unit& u, int wr, int wc, int fr, int fq) const {
        if (u.part >= 0) {
            const int row0 = (u.pm - 64) * 256 + wr * 64 + fr, col0 = u.pn * 256 + wc * 32 + 8 * fq;
            float* pp = part + (size_t)u.part * 512 * 1024;
#pragma unroll
            for (int ai = 0; ai < 2; ++ai)
#pragma unroll
                for (int m = 0; m < 4; ++m)
#pragma unroll
                    for (int bj = 0; bj < 2; ++bj) { float* xp = pp + (size_t)(row0 + ai * 128 + m * 16) * 1024 + col0 + bj * 128; *(f32x4*)xp = acc[ai][bj][m][0]; *(f32x4*)(xp + 4) = acc[ai][bj][m][1]; }
            return;
        }
        const int row0 = u.pm * 256 + wr * 64 + fr, col0 = u.pn * 256 + wc * 32 + 8 * fq;
        float dummy = 0.f;
#pragma unroll
        for (int ai = 0; ai < 2; ++ai)
#pragma unroll
            for (int m = 0; m < 4; ++m) {
                const int r = row0 + ai * 128 + m * 16;
                float ss = 0.f;
#pragma unroll
                for (int bj = 0; bj < 2; ++bj) {
                    const float* sp = X + (size_t)r * 1024 + col0 + bj * 128;
                    const f32x4 x0 = *(const f32x4*)sp + acc[ai][bj][m][0], x1 = *(const f32x4*)(sp + 4) + acc[ai][bj][m][1];
                    ss += (x0[0] * x0[0] + x0[1] * x0[1]) + (x0[2] * x0[2] + x0[3] * x0[3]) + (x1[0] * x1[0] + x1[1] * x1[1]) + (x1[2] * x1[2] + x1[3] * x1[3]);
                }
                ss += __shfl_xor(ss, 16); ss += __shfl_xor(ss, 32);
                if (fq == 0) dummy += atomicAdd(rss + r, ss);
            }
        asm volatile("s_waitcnt vmcnt(0)" :: "v"(dummy) : "memory");
        unsigned* cnt = pcnt + 64 * u.pm;
        if ((threadIdx.x & 63) == 0) __hip_atomic_fetch_add(cnt, 1u, __ATOMIC_RELAXED, __HIP_MEMORY_SCOPE_AGENT);
        { unsigned sp_ = 0; while (__hip_atomic_load(cnt, __ATOMIC_RELAXED, __HIP_MEMORY_SCOPE_AGENT) < 32u) { __builtin_amdgcn_s_sleep(2); if (++sp_ > (1u << 22)) break; } }
        asm volatile("" ::: "memory");
#pragma unroll
        for (int ai = 0; ai < 2; ++ai)
#pragma unroll
            for (int m = 0; m < 4; ++m) {
                const int r = row0 + ai * 128 + m * 16;
                const float rs = rsqrtf(__hip_atomic_load(rss + r, __ATOMIC_RELAXED, __HIP_MEMORY_SCOPE_AGENT) * (1.f / 1024.f) + NORM_EPS);
#pragma unroll
                for (int bj = 0; bj < 2; ++bj) {
                    float* xp = X + (size_t)r * 1024 + col0 + bj * 128;
                    const f32x4 g0 = *(const f32x4*)(fg + col0 + bj * 128), g1 = *(const f32x4*)(fg + col0 + bj * 128 + 4);
                    const f32x4 x0 = *(const f32x4*)xp + acc[ai][bj][m][0], x1 = *(const f32x4*)(xp + 4) + acc[ai][bj][m][1];
                    *(f32x4*)xp = x0 * rs * g0; *(f32x4*)(xp + 4) = x1 * rs * g1;
                }
            }
    }
};
__device__ __forceinline__ void sample_fix_final(const Args& a, const float* part) {
    const int tid = otid(), lane = tid & 63, wave = tid >> 6;
    for (int r = T_P + blockIdx.x * 8 + wave; r < TT; r += gridDim.x * 8) {
        float4* xi = (float4*)(a.out + (size_t)r * 1024);
        float4 v[4]; float ss = 0.f;
#pragma unroll
        for (int j = 0; j < 4; ++j) {
            v[j] = xi[lane + 64 * j];
#pragma unroll
            for (int s = 0; s < 8; ++s) { const float4 p = ((const float4*)(part + ((size_t)s * 512 + (r - T_P)) * 1024))[lane + 64 * j]; v[j].x += p.x; v[j].y += p.y; v[j].z += p.z; v[j].w += p.w; }
            ss += (v[j].x * v[j].x + v[j].y * v[j].y) + (v[j].z * v[j].z + v[j].w * v[j].w);
        }
        const float rs = rsqrtf(wave_sum(ss) * (1.f / 1024.f) + NORM_EPS);
#pragma unroll
        for (int j = 0; j < 4; ++j) { const float4 g = ((const float4*)a.in[I_FG])[lane + 64 * j]; float4 o = v[j]; o.x *= rs * g.x; o.y *= rs * g.y; o.z *= rs * g.z; o.w *= rs * g.w; xi[lane + 64 * j] = o; }
    }
}

struct DownOrder {
    int c, snt;
    __device__ __forceinline__ bool next(int i, pg8::Unit& u) const {
        if (i == 0) { const int v = (c & 7) * 32 + (c >> 3); u.pm = v >> 2; u.pn = v & 3; u.kofs = 0; u.nt = 0; u.part = -1; return true; }
        if (i == 1 && c < 64) { const int su = c >> 3, sl = c & 7; u.pm = 64 + (su >> 2); u.pn = su & 3; u.kofs = sl * snt * 64 * 2; u.nt = snt; u.part = sl; return true; }
        return false;
    }
    __device__ __forceinline__ void a_ready(const pg8::Unit&) const {}
    __device__ __forceinline__ void done(const pg8::Unit&) const {}
};
struct EpiResSplit {
    static constexpr bool PERM = true, AFTER_DRAIN = false;
    float* X; bf16* XB; float* rss; float* part; const float* Sp; const float* Ss;
    __device__ __forceinline__ void operator()(const f32x4 (&acc)[2][2][4][2], const pg8::Unit& u, int wr, int wc, int fr, int fq) const {
        if (u.part < 0) { EpiRes E{X, XB, rss, Sp, Ss}; E(acc, u, wr, wc, fr, fq); return; }
        const int row0 = (u.pm - 64) * 256 + wr * 64 + fr, col0 = u.pn * 256 + wc * 32 + 8 * fq;
        float* pp = part + (size_t)u.part * 512 * 1024;
#pragma unroll
        for (int ai = 0; ai < 2; ++ai)
#pragma unroll
            for (int m = 0; m < 4; ++m)
#pragma unroll
                for (int bj = 0; bj < 2; ++bj) {
                    float* xp = pp + (size_t)(row0 + ai * 128 + m * 16) * 1024 + col0 + bj * 128;
                    *(f32x4*)xp = acc[ai][bj][m][0]; *(f32x4*)(xp + 4) = acc[ai][bj][m][1];
                }
    }
};
__device__ __forceinline__ void sample_fix(const Args& a, float* rss, const float* part, const float* Ss = nullptr) {
    const int tid = otid(), lane = tid & 63, wave = tid >> 6;
    bf16* xb = (bf16*)(a.ws + WS_XB);
    for (int r = T_P + blockIdx.x * 8 + wave; r < TT; r += gridDim.x * 8) {
        float4* xi = (float4*)(a.out + (size_t)r * 1024);
        const float4* xs = Ss ? (const float4*)(Ss + (size_t)(r - T_P) * 1024) : (const float4*)xi;
        uint2* bo = (uint2*)(xb + (size_t)r * 1024);
        float ss = 0.f;
#pragma unroll
        for (int j = 0; j < 4; ++j) {
            float4 v = xs[lane + 64 * j];
#pragma unroll
            for (int s = 0; s < 8; ++s) { const float4 p = ((const float4*)(part + ((size_t)s * 512 + (r - T_P)) * 1024))[lane + 64 * j]; v.x += p.x; v.y += p.y; v.z += p.z; v.w += p.w; }
            xi[lane + 64 * j] = v;
            ss += (v.x * v.x + v.y * v.y) + (v.z * v.z + v.w * v.w); uint2 w; w.x = pk2(v.x, v.y); w.y = pk2(v.z, v.w); bo[lane + 64 * j] = w;
        }
        ss = wave_sum(ss);
        if (lane == 0) rss[r] = ss;
    }
}

template <class Epi> __device__ __forceinline__ void skinny_gemm(const bf16* __restrict__ A  , const bf16* __restrict__ Bt, int N, int K, const Epi& E) {
    const int tid = otid(), wave = tid >> 6, lane = tid & 63, fr = lane & 15, fq = lane >> 4;
    const int nN = N >> 7, nU = 8 * nN;
    for (int u = blockIdx.x; u < nU; u += gridDim.x) {
        const int mb = u / nN, nb = u - mb * nN, n0 = nb * 128 + wave * 16;
        const bf16* ap = A + (size_t)(mb * 64 + fr) * K + 8 * fq;
        const bf16* bp = Bt + (size_t)(n0 + fr) * K + 8 * fq;
        f32x4 acc[4];
#pragma unroll
        for (int m = 0; m < 4; ++m) acc[m] = (f32x4){0.f, 0.f, 0.f, 0.f};
#pragma unroll 4
        for (int k = 0; k < K; k += 32) {
            const pg8::bf16x8 bfr = *(const pg8::bf16x8*)(bp + k);
#pragma unroll
            for (int m = 0; m < 4; ++m) { const pg8::bf16x8 af = *(const pg8::bf16x8*)(ap + (size_t)m * 16 * K + k); acc[m] = __builtin_amdgcn_mfma_f32_16x16x32_bf16(bfr, af, acc[m], 0, 0, 0); }
        }
        E(acc, T_P + mb * 64 + fr, n0 + 4 * fq, fq);
    }
}
template <bool RELU2> struct SkScale {
    bf16* O; int ldc; const float* rss;
    __device__ __forceinline__ void operator()(const f32x4 (&acc)[4], int row, int col, int fq) const {
#pragma unroll
        for (int m = 0; m < 4; ++m) {
            const int r = row + 16 * m;
            const float rs = rsqrtf(rss[r] * (1.f / 1024.f) + NORM_EPS);
            f32x4 v = acc[m] * rs;
            if (RELU2) {
#pragma unroll
                for (int e = 0; e < 4; ++e) { const float p = fmaxf(v[e], 0.f); v[e] = p * p; }
            }
            uint2 w; w.x = pg8::cvt_pk_bf16(v[0], v[1]); w.y = pg8::cvt_pk_bf16(v[2], v[3]);
            *(uint2*)(O + (size_t)r * ldc + col) = w;
        }
    }
};
struct SkRes {
    float* X; bf16* XB; float* rss;
    __device__ __forceinline__ void operator()(const f32x4 (&acc)[4], int row, int col, int fq) const {
#pragma unroll
        for (int m = 0; m < 4; ++m) {
            const int r = row + 16 * m;
            float* xp = X + (size_t)r * 1024 + col;
            const f32x4 x = *(const f32x4*)xp + acc[m];
            *(f32x4*)xp = x;
            uint2 w; w.x = pg8::cvt_pk_bf16(x[0], x[1]); w.y = pg8::cvt_pk_bf16(x[2], x[3]);
            *(uint2*)(XB + (size_t)r * 1024 + col) = w;
            float ss = (x[0] * x[0] + x[1] * x[1]) + (x[2] * x[2] + x[3] * x[3]);
            ss += __shfl_xor(ss, 16); ss += __shfl_xor(ss, 32);
            if (fq == 0) atomicAdd(rss + r, ss);
        }
    }
};

__device__ __forceinline__ void tr_item(const float* __restrict__ W, int K, int Nsrc, bf16* __restrict__ WT, const float* __restrict__ gain, bool inmap, float* scr, int item, int nblk, int lane) {
    const int kb = item / nblk, nb = item - kb * nblk, k0 = 64 * kb, n0 = 32 * nb;
    const int n = n0 + (lane & 31);
    int ns = n;
    if (inmap) ns = n < 1536 ? n : n + 8;
    float tv[32];
    const int nsc = ns >= 0 ? ns : 0;
#pragma unroll
    for (int i = 0; i < 32; ++i) tv[i] = W[(size_t)(k0 + 2 * i + (lane >> 5)) * Nsrc + nsc];
#pragma unroll
    for (int i = 0; i < 32; ++i) {
        const int kk = 2 * i + (lane >> 5);
        float v = ns >= 0 ? tv[i] : 0.f;
        if (gain) v *= gain[k0 + kk];
        scr[kk * 33 + (lane & 31)] = v;
    }
    LDS_WAIT();
    const int c = lane & 7;
#pragma unroll
    for (int j = 0; j < 4; ++j) {
        const int nn = (lane >> 3) + 8 * j; const float* s = scr + (8 * c) * 33 + nn;
        uint4 o; o.x = pk2(s[0], s[33]); o.y = pk2(s[66], s[99]); o.z = pk2(s[132], s[165]); o.w = pk2(s[198], s[231]);
        *(uint4*)(WT + (size_t)(n0 + nn) * K + k0 + 8 * c) = o;
    }
    LDS_WAIT();
}

__device__ __forceinline__ void convert_layer(const Args& a, int l, float* scr, int gw, int NGW, int lane) {
    bf16* wb = (bf16*)(a.ws + WS_W) + (size_t)l * WL_ELEMS;
    for (int it = gw; it < 6016; it += NGW) {
        int r = it;
        if (r < 1408) tr_item(a.in[I_WIN] + (size_t)l * 1024 * 2824, 1024, 2824, wb + WOFF_IN, a.in[I_N1G] + l * 1024, true, scr, r, 88, lane);
        else if ((r -= 1408) < 512) tr_item(a.in[I_WOUT] + (size_t)l * 1024 * 1024, 1024, 1024, wb + WOFF_OUT, nullptr, false, scr, r, 32, lane);
        else if ((r -= 512) < 2048) tr_item(a.in[I_WUP] + (size_t)l * 1024 * 4096, 1024, 4096, wb + WOFF_UP, a.in[I_N2G] + l * 1024, false, scr, r, 128, lane);
        else { r -= 2048; tr_item(a.in[I_WDN] + (size_t)l * 4096 * 1024, 4096, 1024, wb + WOFF_DOWN, nullptr, false, scr, r, 32, lane); }
    }
}
__device__ __forceinline__ void phase0(const Args& a, unsigned char* lds) {
    const int tid = otid(), lane = tid & 63, wave = tid >> 6;
    const int gw = blockIdx.x * 8 + wave, NGW = gridDim.x * 8;
    float* scr = (float*)(lds + wave * 16384);
    convert_layer(a, 0, scr, gw, NGW, lane);
    if (MK_PER_PHASE || gridDim.x != 256) convert_layer(a, 1, scr, gw, NGW, lane);
    {
        bf16* BAW = (bf16*)(a.ws + WS_BAW);
        for (int i = blockIdx.x * 512 + tid; i < 2 * 16 * 1024; i += gridDim.x * 512) {
            const int l = i >> 14, n = (i >> 10) & 15, kk = i & 1023;
            const float v = n < 8 ? a.in[I_WIN][((size_t)l * 1024 + kk) * 2824 + 1536 + n] * a.in[I_N1G][l * 1024 + kk] : 0.f;
            BAW[i] = (bf16)f2bf(v);
        }
    }
    float* rowss = (float*)(a.ws + WS_ROWSS);
    bf16* xb = (bf16*)(a.ws + WS_XB);
    for (int r = gw; r < TT; r += NGW) {
        const float* src = r < T_P ? a.in[I_XP] + (size_t)r * 1024 : a.in[I_XS] + (size_t)(r - T_P) * 1024;
        float4 v[4]; float ss = 0.f;
#pragma unroll
        for (int j = 0; j < 4; ++j) { v[j] = ((const float4*)src)[lane + 64 * j]; ss += (v[j].x * v[j].x + v[j].y * v[j].y) + (v[j].z * v[j].z + v[j].w * v[j].w); }
        ss = wave_sum(ss);
        if (lane == 0) rowss[r] = ss;
        uint2* bo = (uint2*)(xb + (size_t)r * 1024);
#pragma unroll
        for (int j = 0; j < 4; ++j) { uint2 w; w.x = pk2(v[j].x, v[j].y); w.y = pk2(v[j].z, v[j].w); bo[lane + 64 * j] = w; }
    }
    for (int i = blockIdx.x * 512 + tid; i < 6 * TT; i += gridDim.x * 512) rowss[TT + i] = 0.f;
    {
        bf16* LW = (bf16*)(a.ws + WS_LW);
        for (int i = blockIdx.x * 512 + tid; i < 2 * 81920; i += gridDim.x * 512) {
            const int l = i / 81920; int r = i - l * 81920; float v;
            if (r < 16384) { const int c = r >> 6, j = r & 63; v = a.in[I_CW2][((size_t)l * 64 + j) * 256 + c]; }
            else if (r < 32768) { r -= 16384; const int c = r >> 6, j = r & 63; v = a.in[I_CA2][((size_t)l * 64 + j) * 256 + c]; }
            else if (r < 65536) { r -= 32768; const int c = r >> 7, j = r & 127; v = a.in[I_CG2][((size_t)l * 128 + j) * 256 + c]; }
            else { r -= 65536; const int c = r >> 6, cin = r & 63; v = a.in[I_DW][(((size_t)l * 4 + (c >> 6)) * 64 + cin) * 64 + (c & 63)]; }
            LW[i] = (bf16)f2bf(v);
        }
    }
}

template <int N> __device__ __forceinline__ void prev_c(const Args& a, int l, int row, int ccol, float (&o)[N]) {
    const bf16* P = (const bf16*)(a.ws + WS_P);
    bool first, smp = row >= T_P; int b = 0;
    if (!smp) first = (row & 2047) == 0; else { const int rs = row - T_P; first = (rs & 3) == 0; b = rs >> 2; }
    const int pr = row > 0 ? row - 1 : 0;
    float pv[N], sv[N];
    ldbf<N>(P + (size_t)pr * PN + PC_C + ccol, pv);
    ldf<N>(a.in[I_SCS] + ((size_t)l * 128 + b) * 1024 + ccol, sv);
#pragma unroll
    for (int i = 0; i < N; ++i) o[i] = first ? (smp ? sv[i] : 0.f) : pv[i];
}

__device__ __forceinline__ int tile_row(int tile, int i) { return i < 64 ? tile * 64 + i : T_P + tile * 2 + (i - 64); }
constexpr int XS = 264;
template <int KSTEPS> __device__ __forceinline__ void lora_mfma(const bf16* X, int joff, const bf16* __restrict__ WT, int wave, int lane, f32x4 (&acc)[5][2]) {
    const int fr = lane & 15, fq = lane >> 4;
#pragma unroll
    for (int m = 0; m < 5; ++m) { acc[m][0] = (f32x4){0.f, 0.f, 0.f, 0.f}; acc[m][1] = (f32x4){0.f, 0.f, 0.f, 0.f}; }
#pragma unroll
    for (int k = 0; k < KSTEPS; ++k) {
        pg8::bf16x8 bf[2];
#pragma unroll
        for (int n = 0; n < 2; ++n) bf[n] = *(const pg8::bf16x8*)(WT + (size_t)(wave * 32 + n * 16 + fr) * (32 * KSTEPS) + k * 32 + 8 * fq);
#pragma unroll
        for (int m = 0; m < 5; ++m) {
            const pg8::bf16x8 af = *(const pg8::bf16x8*)(X + (m * 16 + fr) * XS + joff + k * 32 + 8 * fq);
#pragma unroll
            for (int n = 0; n < 2; ++n) acc[m][n] = __builtin_amdgcn_mfma_f32_16x16x32_bf16(bf[n], af, acc[m][n], 0, 0, 0);
        }
    }
}

__device__ __forceinline__ void aux_tile(const Args& a, int l, int tile, unsigned char* lds) {
    const int tid = otid(), c = tid & 255, half = tid >> 8;
    const bf16* P = (const bf16*)(a.ws + WS_P);
    bf16* X = (bf16*)lds;
    {
        const float mu = a.in[I_CMU][l * 1024 + 768 + c];
#pragma unroll
        for (int j = 0; j < 33; ++j) {
            const int i = half * 33 + j, row = tile_row(tile, i);
            const float cur = bf2f(P[(size_t)row * PN + PC_C + 768 + c]);
            float pv[1]; prev_c<1>(a, l, row, 768 + c, pv);
            float xm = cur + (pv[0] - cur) * mu;
            if (c < 64) xm = tanh_(xm); else if (c >= 128) xm = sigm(xm);
            X[i * XS + c] = (bf16)f2bf(xm);
        }
    }
    __syncthreads();
    const int wave = tid >> 6, lane = tid & 63, fr = lane & 15, fq = lane >> 4;
    const bf16* LW = (const bf16*)(a.ws + WS_LW) + (size_t)l * 81920;
    float* auxw = (float*)(a.ws + WS_AUXW); bf16* auxa = (bf16*)(a.ws + WS_AUXA); bf16* auxg = (bf16*)(a.ws + WS_AUXG);
    f32x4 acc[5][2];
    lora_mfma<2>(X, 0, LW, wave, lane, acc);
#pragma unroll
    for (int n = 0; n < 2; ++n) {
        const int cc = wave * 32 + n * 16 + 4 * fq;
        const float4 w0c = *(const float4*)(a.in[I_CW0] + l * 256 + cc);
#pragma unroll
        for (int m = 0; m < 5; ++m) {
            const int tok = m * 16 + fr;
            if (tok < 66) {
                float4 o;
                o.x = __expf(-__expf(-softplus_(-(w0c.x + acc[m][n][0])) - 0.5f)); o.y = __expf(-__expf(-softplus_(-(w0c.y + acc[m][n][1])) - 0.5f));
                o.z = __expf(-__expf(-softplus_(-(w0c.z + acc[m][n][2])) - 0.5f)); o.w = __expf(-__expf(-softplus_(-(w0c.w + acc[m][n][3])) - 0.5f));
                *(float4*)(auxw + (size_t)tile_row(tile, tok) * 256 + cc) = o;
            }
        }
    }
    lora_mfma<2>(X, 64, LW + 16384, wave, lane, acc);
#pragma unroll
    for (int n = 0; n < 2; ++n) {
        const int cc = wave * 32 + n * 16 + 4 * fq;
        const float4 a0c = *(const float4*)(a.in[I_CA0] + l * 256 + cc);
#pragma unroll
        for (int m = 0; m < 5; ++m) {
            const int tok = m * 16 + fr;
            if (tok < 66) { uint2 o; o.x = pk2(sigm(a0c.x + acc[m][n][0]), sigm(a0c.y + acc[m][n][1])); o.y = pk2(sigm(a0c.z + acc[m][n][2]), sigm(a0c.w + acc[m][n][3])); *(uint2*)(auxa + (size_t)tile_row(tile, tok) * 256 + cc) = o; }
        }
    }
    lora_mfma<4>(X, 128, LW + 32768, wave, lane, acc);
#pragma unroll
    for (int n = 0; n < 2; ++n) {
        const int cc = wave * 32 + n * 16 + 4 * fq;
#pragma unroll
        for (int m = 0; m < 5; ++m) {
            const int tok = m * 16 + fr;
            if (tok < 66) { uint2 o; o.x = pk2(acc[m][n][0], acc[m][n][1]); o.y = pk2(acc[m][n][2], acc[m][n][3]); *(uint2*)(auxg + (size_t)tile_row(tile, tok) * 256 + cc) = o; }
        }
    }
    __syncthreads();
}

__device__ __forceinline__ void pool_tile(const Args& a, int l, int tile, unsigned char* lds) {
    bf16* X = (bf16*)lds;
    const int tid = otid(), c = tid & 255, half = tid >> 8, r0 = tile * 64;
    const bf16* P = (const bf16*)(a.ws + WS_P);
    bf16* mixed = (bf16*)(a.ws + WS_MIXED);
    const int gi = c >> 6, w = 2 << gi;
    unsigned short* Sg = (unsigned short*)(lds + 43008);
#pragma unroll
    for (int j = 0; j < 40; ++j) {
        const int k = half * 40 + j;
        if (k < 79) { const int gr = r0 - 15 + k; unsigned short v = 0; if (gr >= 0) v = P[(size_t)gr * PN + PC_D + c]; Sg[k * 256 + c] = v; }
    }
    __syncthreads();
    for (int j = 0; j < 32; ++j) {
        const int i = half * 32 + j, row = r0 + i;
        const unsigned short* sp = Sg + (15 + i) * 256 + c;
        const float xc = bf2f(sp[0]);
        const int b = row >> 11, t = row & 2047;
        const int n = t + 1 < w ? t + 1 : w;
        float sum = xc;
#pragma unroll
        for (int q = 1; q < 16; ++q) { const float hv = bf2f(sp[-q * 256]); if (q < n) sum += hv; }
        if (t >= 2033) a.out[O_PDP + (((size_t)l * 8 + b) * 15 + (t - 2033)) * 256 + c] = xc;
        X[i * XS + c] = (bf16)f2bf(sum / (float)n - xc);
    }
    {
        const int i = 64 + half, rs = tile * 2 + half, row = T_P + rs, b = rs >> 2, t = rs & 3;
        const float* sb = a.in[I_SDP] + ((size_t)l * 128 + b) * 15 * 256 + c;
        const float xc = bf2f(P[(size_t)row * PN + PC_D + c]);
        float hv[15];
#pragma unroll
        for (int q = 1; q < 16; ++q) {
            const int tq = t - q;
            const float pv = bf2f(P[(size_t)(row - (tq >= 0 ? q : 0)) * PN + PC_D + c]);
            const float sv = sb[(tq >= 0 ? 0 : 15 + tq) * 256];
            hv[q - 1] = tq >= 0 ? pv : sv;
        }
        float sum = xc;
#pragma unroll
        for (int q = 1; q < 16; ++q) if (q < w) sum += hv[q - 1];
        float* so = a.out + O_SDP + ((size_t)l * 128 + b) * 15 * 256 + c;
        so[(11 + t) * 256] = xc;
        if (t == 0) {
            float tv[11];
#pragma unroll
            for (int jj = 0; jj < 11; ++jj) tv[jj] = sb[(jj + 4) * 256];
#pragma unroll
            for (int jj = 0; jj < 11; ++jj) so[jj * 256] = tv[jj];
        }
        X[i * XS + c] = (bf16)f2bf(sum / (float)w - xc);
    }
    __syncthreads();
    {
        const int wave = tid >> 6, lane = tid & 63, fr = lane & 15, fq = lane >> 4;
        const bf16* LW = (const bf16*)(a.ws + WS_LW) + (size_t)l * 81920 + 65536;
        f32x4 acc[5][2];
        lora_mfma<2>(X, (wave >> 1) * 64, LW, wave, lane, acc);
#pragma unroll
        for (int n = 0; n < 2; ++n) {
            const int cc = wave * 32 + n * 16 + 4 * fq;
            const float4 sc = *(const float4*)(a.in[I_DSC] + l * 256 + cc);
#pragma unroll
            for (int m = 0; m < 5; ++m) {
                const int tok = m * 16 + fr;
                if (tok < 66) { uint2 o; o.x = pk2(acc[m][n][0] * sc.x, acc[m][n][1] * sc.y); o.y = pk2(acc[m][n][2] * sc.z, acc[m][n][3] * sc.w); *(uint2*)(mixed + (size_t)tile_row(tile, tok) * 1024 + 768 + cc) = o; }
            }
        }
    }
    for (int i = 0; i < 66; ++i) {
        const int row = tile_row(tile, i); int b, t, tl; bool smp;
        if (row < T_P) { b = row >> 11; t = row & 2047; tl = 2047; smp = false; } else { const int rs = row - T_P; b = rs >> 2; t = rs & 3; tl = 3; smp = true; }
        if (t == tl) {
            float* o = a.out + (smp ? O_SCS + ((size_t)l * 128 + b) * 1024 : O_PCS + ((size_t)l * 8 + b) * 1024);
            const float v0 = bf2f(P[(size_t)row * PN + PC_C + tid]), v1 = bf2f(P[(size_t)row * PN + PC_C + 512 + tid]);
            o[tid] = v0; o[512 + tid] = v1;
        }
        if (t >= tl - 2) {
            const int j = t - (tl - 2);
            float* o = a.out + (smp ? O_SBC + (((size_t)l * 128 + b) * 3 + j) * 768 : O_PBC + (((size_t)l * 8 + b) * 3 + j) * 768);
            const float v0 = bf2f(P[(size_t)row * PN + PC_BQ + tid]);
            o[tid] = v0;
            if (tid < 256) o[512 + tid] = bf2f(P[(size_t)row * PN + PC_BQ + 512 + tid]);
        }
    }
    __syncthreads();
}

__device__ __forceinline__ void gmlp_prompt_item(const Args& a, int l, int it, unsigned char* lds) {
    const int tid = otid(), t = tid >> 2, q = tid & 3;
    const int b = it >> 6, nc = (it >> 2) & 15, h = it & 3;
    const int row = b * 2048 + nc * 128 + t;
    const bf16* Pb = (const bf16*)(a.ws + WS_P);
    const bf16* Prow = Pb + (size_t)row * PN;
    bf16* mixed = (bf16*)(a.ws + WS_MIXED);
    bf16* wsb = (bf16*)lds;
    bf16* vT = (bf16*)(lds + 34816);
    const float rstd = rsqrtf(((const float*)(a.ws + WS_ROWSS))[(size_t)(5 + l) * TT + row] * (1.f / 256.f) + NORM_EPS);
    {
        const float* vg = a.in[I_AVG] + l * 256 + h * 64 + q * 16;
#pragma unroll
        for (int k = 0; k < 2; ++k) { float x[8]; ld8(Prow + 256 + h * 64 + q * 16 + k * 8, x);
#pragma unroll
            for (int e = 0; e < 8; ++e) vT[(q * 16 + k * 8 + e) * 136 + t] = (bf16)f2bf(gelu_t(x[e]) * rstd * vg[k * 8 + e]); }
    }
    {
        const float* wsrc = a.in[I_AWS] + ((size_t)l * 4 + h) * 16384;
        float4 wv[8];
#pragma unroll
        for (int j = 0; j < 8; ++j) { const int idx = tid + 512 * j; wv[j] = *(const float4*)(wsrc + (idx >> 5) * 128 + (idx & 31) * 4); }
#pragma unroll
        for (int j = 0; j < 8; ++j) {
            const int idx = tid + 512 * j, rr = idx >> 5, s0 = (idx & 31) * 4;
            uint2 o; o.x = pk2(s0 <= rr ? wv[j].x : 0.f, s0 + 1 <= rr ? wv[j].y : 0.f); o.y = pk2(s0 + 2 <= rr ? wv[j].z : 0.f, s0 + 3 <= rr ? wv[j].w : 0.f);
            *(uint2*)(wsb + rr * 136 + s0) = o;
        }
    }
    __syncthreads();
    const int wave = tid >> 6, lane = tid & 63, fr = lane & 15, fq = lane >> 4;
    f32x4 acc[4];
#pragma unroll
    for (int n = 0; n < 4; ++n) acc[n] = (f32x4){0.f, 0.f, 0.f, 0.f};
    const int nk = (wave >> 1) + 1;
#pragma unroll
    for (int k = 0; k < 4; ++k) {
        if (k < nk) {
            const pg8::bf16x8 af = *(const pg8::bf16x8*)(wsb + (wave * 16 + fr) * 136 + k * 32 + 8 * fq);
#pragma unroll
            for (int n = 0; n < 4; ++n) { const pg8::bf16x8 bfr = *(const pg8::bf16x8*)(vT + (n * 16 + fr) * 136 + k * 32 + 8 * fq); acc[n] = __builtin_amdgcn_mfma_f32_16x16x32_bf16(bfr, af, acc[n], 0, 0, 0); }
        }
    }
    {
        const int tt = wave * 16 + fr, ro = b * 2048 + nc * 128 + tt;
        const float bs = a.in[I_ABS][((size_t)l * 4 + h) * 128 + tt];
#pragma unroll
        for (int n = 0; n < 4; ++n) {
            const int cc = h * 64 + n * 16 + 4 * fq;
            float u[4]; ld4(Pb + (size_t)ro * PN + cc, u);
            uint2 o; o.x = pk2(gelu_t(u[0]) * (acc[n][0] + bs), gelu_t(u[1]) * (acc[n][1] + bs)); o.y = pk2(gelu_t(u[2]) * (acc[n][2] + bs), gelu_t(u[3]) * (acc[n][3] + bs));
            *(uint2*)(mixed + (size_t)ro * 1024 + cc) = o;
        }
    }
    __syncthreads();
}
__device__ __forceinline__ void gmlp_sample_item(const Args& a, int l, int b, float* Ls  ) {
    const int tid = otid(), lane = tid & 63, wave = tid >> 6, t = tid >> 7, c0 = (tid & 127) * 2;
    const int row = T_P + b * 4 + t;
    const bf16* Prow = (const bf16*)(a.ws + WS_P) + (size_t)row * PN;
    bf16* mixed = (bf16*)(a.ws + WS_MIXED);
    float* red = Ls + 1024;
    float x[2]; ld2(Prow + 256 + c0, x);
    const float g0 = gelu_t(x[0]), g1 = gelu_t(x[1]);
    const float ss = wave_sum(g0 * g0 + g1 * g1);
    if (lane == 0) red[wave] = ss;
    __syncthreads();
    const float rstd = rsqrtf((red[2 * t] + red[2 * t + 1]) * (1.f / 256.f) + NORM_EPS);
    const float v0 = g0 * rstd * a.in[I_AVG][l * 256 + c0], v1 = g1 * rstd * a.in[I_AVG][l * 256 + c0 + 1];
    Ls[t * 256 + c0] = v0; Ls[t * 256 + c0 + 1] = v1;
    float* sav = a.out + O_SAV + (((size_t)l * 128 + b) * 4 + t) * 256 + c0;
    sav[0] = v0; sav[1] = v1;
    __syncthreads();
    const int h = c0 >> 6;
    const float* wrow = a.in[I_AWS] + (((size_t)l * 4 + h) * 128 + t) * 128;
    const float bs = a.in[I_ABS][((size_t)l * 4 + h) * 128 + t];
    float m0 = bs, m1 = bs;
    for (int s = 0; s <= t; ++s) { const float ww = wrow[s]; m0 += ww * Ls[s * 256 + c0]; m1 += ww * Ls[s * 256 + c0 + 1]; }
    float u[2]; ld2(Prow + c0, u);
    *(unsigned*)(mixed + (size_t)row * 1024 + c0) = pk2(gelu_t(u[0]) * m0, gelu_t(u[1]) * m1);
    __syncthreads();
}

__device__ __forceinline__ void ba_tile(const Args& a, int l, int tile, unsigned char* lds) {
    const int tid = otid(), wave = tid >> 6, lane = tid & 63, fr = lane & 15, fq = lane >> 4;
    const bf16* xb = (const bf16*)(a.ws + WS_XB);
    const bf16* BAW = (const bf16*)(a.ws + WS_BAW) + (size_t)l * 16384;
    float* red = (float*)lds;
    f32x4 acc[5];
#pragma unroll
    for (int m = 0; m < 5; ++m) acc[m] = (f32x4){0.f, 0.f, 0.f, 0.f};
#pragma unroll
    for (int k = 0; k < 4; ++k) {
        const int kk = wave * 128 + k * 32 + 8 * fq;
        const pg8::bf16x8 bfr = *(const pg8::bf16x8*)(BAW + fr * 1024 + kk);
#pragma unroll
        for (int m = 0; m < 5; ++m) {
            const int tok = m * 16 + fr, row = tile_row(tile, tok < 66 ? tok : 65);
            const pg8::bf16x8 af = *(const pg8::bf16x8*)(xb + (size_t)row * 1024 + kk);
            acc[m] = __builtin_amdgcn_mfma_f32_16x16x32_bf16(bfr, af, acc[m], 0, 0, 0);
        }
    }
#pragma unroll
    for (int m = 0; m < 5; ++m) *(f32x4*)(red + ((wave * 80) + m * 16 + fr) * 16 + 4 * fq) = acc[m];
    __syncthreads();
    const float* rss = (const float*)(a.ws + WS_ROWSS) + (size_t)(2 * l) * TT;
    float* BA = (float*)(a.ws + WS_BA);
    for (int e = tid; e < 66 * 8; e += 512) {
        const int tok = e >> 3, n = e & 7, row = tile_row(tile, tok);
        float s = 0.f;
#pragma unroll
        for (int w = 0; w < 8; ++w) s += red[(w * 80 + tok) * 16 + n];
        BA[(size_t)row * 8 + n] = s * rsqrtf(rss[row] * (1.f / 1024.f) + NORM_EPS);
    }
    __syncthreads();
}

__device__ __forceinline__ void phase_pre(const Args& a, int l, unsigned char* lds, int mode = 0) {
    float* L = (float*)lds;
    const int G = gridDim.x, g = blockIdx.x;
    if (mode != 2) for (int tile = g; tile < 256; tile += G) { aux_tile(a, l, tile, lds); pool_tile(a, l, tile, lds); ba_tile(a, l, tile, lds); }
    if (mode != 1) for (int it = g; it < 512; it += G) gmlp_prompt_item(a, l, it, lds);
    if (G != 256 || MK_PER_PHASE) for (int it = g; it < 128; it += G) gmlp_sample_item(a, l, it, L);
}

struct ChunkD { int valid, mixer, h, cg, b, sample, row0, t0, n, first, last; };
__device__ __forceinline__ ChunkD get_chunk(int idx, int g, int G, int mode = 0) {
    ChunkD d; d.valid = 0; d.mixer = 0; d.h = 0; d.cg = 0; d.b = 0; d.sample = 0; d.row0 = 0; d.t0 = 0; d.n = 0; d.first = 0; d.last = 0;
    int nP = g < 256 ? (256 - g + G - 1) / G : 0;
    int nS = g < 4096 ? (4096 - g + G - 1) / G : 0;
    nS = 0;
    if (mode == 2) nP = 0;
    if (idx < nP * 64) {
        const int gi = g + (idx >> 6) * G, ch = idx & 63;
        const int it = (G == 256) ? ((gi & 1) | (((gi >> 4) & 3) << 1) | (((gi >> 1) & 7) << 3) | ((gi >> 6) << 6)) : gi;
        d.valid = 1; d.mixer = it & 1; d.cg = (it >> 1) & 3; d.h = (it >> 3) & 3; d.b = it >> 5; d.sample = 0; d.row0 = d.b * 2048; d.t0 = ch * 32; d.n = 32; d.first = ch == 0; d.last = ch == 63;
    } else {
        const int j = idx - nP * 64;
        if (j < nS) { const int it = g + j * G; d.valid = 1; d.mixer = it & 1; d.cg = (it >> 1) & 3; d.h = (it >> 3) & 3; d.b = it >> 5; d.sample = 1; d.row0 = T_P + d.b * 4; d.t0 = 0; d.n = 4; d.first = 1; d.last = 1; }
    }
    return d;
}
constexpr int OPB_FLOATS = 10752;

struct Raw { uint4 u[8]; unsigned s[4]; float w[2]; };
__device__ __forceinline__ void unpack8(const uint4 u, float (&o)[8]) {
    o[0] = __uint_as_float(u.x << 16); o[1] = __uint_as_float(u.x & 0xffff0000u); o[2] = __uint_as_float(u.y << 16); o[3] = __uint_as_float(u.y & 0xffff0000u);
    o[4] = __uint_as_float(u.z << 16); o[5] = __uint_as_float(u.z & 0xffff0000u); o[6] = __uint_as_float(u.w << 16); o[7] = __uint_as_float(u.w & 0xffff0000u);
}
__device__ __forceinline__ uint4 pack8f(const float* p) {
    const float4 x = *(const float4*)p, y = *(const float4*)(p + 4);
    uint4 o; o.x = pk2(x.x, x.y); o.y = pk2(x.z, x.w); o.z = pk2(y.x, y.y); o.w = pk2(y.z, y.w); return o;
}
__device__ __forceinline__ void raw_load(const Args& a, int l, const ChunkD& d, int ptid, Raw& R) {
    const int tok = ptid >> 3, sub = ptid & 7;
    if (!d.valid || tok >= d.n) return;
    const int t = d.t0 + tok, row = d.row0 + t;
    const bf16* P = (const bf16*)(a.ws + WS_P);
    const uint4 z4 = make_uint4(0u, 0u, 0u, 0u);
    if (d.mixer == 0) {
        const int cq = d.h * 64 + sub * 8, cv = 512 + d.h * 64 + d.cg * 16 + sub * 2;
#pragma unroll
        for (int k = 0; k < 4; ++k) {
            const int tt = t - 3 + k;
            if (tt >= 0) { const bf16* pr = P + (size_t)(d.row0 + tt) * PN + PC_BQ; R.u[k] = *(const uint4*)(pr + cq); R.u[4 + k] = *(const uint4*)(pr + 256 + cq); R.s[k] = *(const unsigned*)(pr + cv); }
            else if (d.sample) { const float* sp = a.in[I_SBC] + (((size_t)l * 128 + d.b) * 3 + (tt + 3)) * 768; R.u[k] = pack8f(sp + cq); R.u[4 + k] = pack8f(sp + 256 + cq); R.s[k] = pk2(sp[cv], sp[cv + 1]); }
            else { R.u[k] = z4; R.u[4 + k] = z4; R.s[k] = 0u; }
        }
        { const float* ba = (const float*)(a.ws + WS_BA) + (size_t)row * 8; R.w[0] = ba[d.h]; R.w[1] = ba[4 + d.h]; }
    } else {
        const int ch = d.h * 64 + sub * 8, vcl = 512 + d.h * 64 + d.cg * 16 + sub * 2;
        const bf16* pc = P + (size_t)row * PN + PC_C;
        R.u[0] = *(const uint4*)(pc + ch); R.u[1] = *(const uint4*)(pc + 256 + ch); R.s[0] = *(const unsigned*)(pc + vcl);
        if (t > 0) { const bf16* pp = pc - PN; R.u[2] = *(const uint4*)(pp + ch); R.u[3] = *(const uint4*)(pp + 256 + ch); R.s[1] = *(const unsigned*)(pp + vcl); }
        else if (d.sample) { const float* sp = a.in[I_SCS] + ((size_t)l * 128 + d.b) * 1024; R.u[2] = pack8f(sp + ch); R.u[3] = pack8f(sp + 256 + ch); R.s[1] = pk2(sp[vcl], sp[vcl + 1]); }
        else { R.u[2] = z4; R.u[3] = z4; R.s[1] = 0u; }
        R.u[4] = *(const uint4*)((const bf16*)(a.ws + WS_AUXA) + (size_t)row * 256 + ch);
        const float* wp = (const float*)(a.ws + WS_AUXW) + (size_t)row * 256 + ch;
        R.u[5] = *(const uint4*)wp; R.u[6] = *(const uint4*)(wp + 4);
    }
}
__device__ __forceinline__ void prep_math(const Args& a, int l, const ChunkD& d, const Raw& R, float* ob, float* CST, int ptid) {
    const int tok = ptid >> 3, sub = ptid & 7;
    if (!d.valid || tok >= d.n) return;
    const int row = d.row0 + d.t0 + tok;
    float* Rp = ob + tok * 64 + sub * 8;
    float* V = ob + 10240 + tok * 16 + sub * 2;
    float r[8], w[8], k[8], kk[8], bb[8], v[2];
    if (d.mixer == 0) {
        const int cq = d.h * 64 + sub * 8, cv = 512 + d.h * 64 + d.cg * 16 + sub * 2;
        float q[8], kr[8];
#pragma unroll
        for (int i = 0; i < 8; ++i) { q[i] = 0.f; kr[i] = 0.f; }
        v[0] = 0.f; v[1] = 0.f;
        float* cst = CST + sub * 80;
        if (d.first) {
#pragma unroll
            for (int kx = 0; kx < 4; ++kx) {
                const float* cw = a.in[I_BCW] + ((size_t)l * 4 + kx) * 768;
                *(float4*)(cst + kx * 20) = *(const float4*)(cw + cq); *(float4*)(cst + kx * 20 + 4) = *(const float4*)(cw + cq + 4);
                *(float4*)(cst + kx * 20 + 8) = *(const float4*)(cw + 256 + cq); *(float4*)(cst + kx * 20 + 12) = *(const float4*)(cw + 256 + cq + 4);
                *(float2*)(cst + kx * 20 + 16) = *(const float2*)(cw + cv);
            }
        }
#pragma unroll
        for (int kx = 0; kx < 4; ++kx) {
            float xq[8], xk[8]; unpack8(R.u[kx], xq); unpack8(R.u[4 + kx], xk);
            const float4 a0 = *(const float4*)(cst + kx * 20), a1 = *(const float4*)(cst + kx * 20 + 4), b0 = *(const float4*)(cst + kx * 20 + 8), b1 = *(const float4*)(cst + kx * 20 + 12);
            const float2 c0 = *(const float2*)(cst + kx * 20 + 16);
            q[0] += xq[0] * a0.x; q[1] += xq[1] * a0.y; q[2] += xq[2] * a0.z; q[3] += xq[3] * a0.w; q[4] += xq[4] * a1.x; q[5] += xq[5] * a1.y; q[6] += xq[6] * a1.z; q[7] += xq[7] * a1.w;
            kr[0] += xk[0] * b0.x; kr[1] += xk[1] * b0.y; kr[2] += xk[2] * b0.z; kr[3] += xk[3] * b0.w; kr[4] += xk[4] * b1.x; kr[5] += xk[5] * b1.y; kr[6] += xk[6] * b1.z; kr[7] += xk[7] * b1.w;
            v[0] += __uint_as_float(R.s[kx] << 16) * c0.x; v[1] += __uint_as_float(R.s[kx] & 0xffff0000u) * c0.y;
        }
        float sq = 0.f, sk = 0.f;
#pragma unroll
        for (int i = 0; i < 8; ++i) { q[i] = silu(q[i]); kr[i] = silu(kr[i]); sq += q[i] * q[i]; sk += kr[i] * kr[i]; }
        v[0] = silu(v[0]); v[1] = silu(v[1]);
        sq = sum8(sq); sk = sum8(sk);
        const float iq = rsqrtf(sq + 1e-6f) * 0.125f, ik = rsqrtf(sk + 1e-6f);
        const float beta = sigm(R.w[0]);
        const float gg = -__expf(a.in[I_BAL][l * 4 + d.h]) * softplus_(R.w[1] + a.in[I_BDT][l * 4 + d.h]);
        const float dec = __expf(gg);
#pragma unroll
        for (int i = 0; i < 8; ++i) { const float kn = kr[i] * ik; r[i] = q[i] * iq; w[i] = dec; kk[i] = kn; k[i] = beta * kn; bb[i] = dec * beta * kn; }
    } else {
        const int ch = d.h * 64 + sub * 8, vcl = 512 + d.h * 64 + d.cg * 16 + sub * 2;
        float cur[8], pv[8], kx[8], av[8];
        const float* mu = a.in[I_CMU] + l * 1024;
        float m0[8], m1[8], kkw[8], kaw[8], rkw[8];
        float* cst = CST + sub * 80;
        if (d.first) {
            *(float4*)(cst) = *(const float4*)(mu + ch); *(float4*)(cst + 4) = *(const float4*)(mu + ch + 4);
            *(float4*)(cst + 8) = *(const float4*)(mu + 256 + ch); *(float4*)(cst + 12) = *(const float4*)(mu + 256 + ch + 4);
            const float* p1 = a.in[I_CKK] + l * 256 + ch; *(float4*)(cst + 16) = *(const float4*)p1; *(float4*)(cst + 20) = *(const float4*)(p1 + 4);
            const float* p2 = a.in[I_CKA] + l * 256 + ch; *(float4*)(cst + 24) = *(const float4*)p2; *(float4*)(cst + 28) = *(const float4*)(p2 + 4);
            const float* p3 = a.in[I_CRK] + l * 256 + ch; *(float4*)(cst + 32) = *(const float4*)p3; *(float4*)(cst + 36) = *(const float4*)(p3 + 4);
            *(float2*)(cst + 40) = *(const float2*)(mu + vcl);
        }
        ldf<8>(cst, m0); ldf<8>(cst + 8, m1); ldf<8>(cst + 16, kkw); ldf<8>(cst + 24, kaw); ldf<8>(cst + 32, rkw);
        const float mv0 = cst[40], mv1 = cst[41];
        unpack8(R.u[0], cur); unpack8(R.u[2], pv);
#pragma unroll
        for (int i = 0; i < 8; ++i) r[i] = cur[i] + (pv[i] - cur[i]) * m0[i];
        unpack8(R.u[1], cur); unpack8(R.u[3], pv);
#pragma unroll
        for (int i = 0; i < 8; ++i) kx[i] = cur[i] + (pv[i] - cur[i]) * m1[i];
        {
            const float c0 = __uint_as_float(R.s[0] << 16), c1 = __uint_as_float(R.s[0] & 0xffff0000u), p0 = __uint_as_float(R.s[1] << 16), p1 = __uint_as_float(R.s[1] & 0xffff0000u);
            v[0] = c0 + (p0 - c0) * mv0; v[1] = c1 + (p1 - c1) * mv1;
        }
        unpack8(R.u[4], av);
        float ss = 0.f;
#pragma unroll
        for (int i = 0; i < 8; ++i) { kk[i] = kx[i] * kkw[i]; ss += kk[i] * kk[i]; }
        w[0] = __uint_as_float(R.u[5].x); w[1] = __uint_as_float(R.u[5].y); w[2] = __uint_as_float(R.u[5].z); w[3] = __uint_as_float(R.u[5].w); w[4] = __uint_as_float(R.u[6].x); w[5] = __uint_as_float(R.u[6].y); w[6] = __uint_as_float(R.u[6].z); w[7] = __uint_as_float(R.u[6].w);
        ss = sum8(ss);
        const float inv = rsqrtf(ss + 1e-6f);
        float rk = 0.f;
#pragma unroll
        for (int i = 0; i < 8; ++i) { kk[i] *= inv; k[i] = kx[i] * (1.f + (av[i] - 1.f) * kaw[i]); bb[i] = kk[i] * av[i]; rk += r[i] * k[i] * rkw[i]; }
        rk = sum8(rk);
        if (sub == 0 && d.cg == 0) ((float*)(a.ws + WS_RK))[(size_t)row * 4 + d.h] = rk;
    }
    *(float4*)(Rp) = make_float4(r[0], r[1], r[2], r[3]); *(float4*)(Rp + 4) = make_float4(r[4], r[5], r[6], r[7]);
    *(float4*)(Rp + 2048) = make_float4(w[0], w[1], w[2], w[3]); *(float4*)(Rp + 2052) = make_float4(w[4], w[5], w[6], w[7]);
    *(float4*)(Rp + 4096) = make_float4(k[0], k[1], k[2], k[3]); *(float4*)(Rp + 4100) = make_float4(k[4], k[5], k[6], k[7]);
    *(float4*)(Rp + 6144) = make_float4(kk[0], kk[1], kk[2], kk[3]); *(float4*)(Rp + 6148) = make_float4(kk[4], kk[5], kk[6], kk[7]);
    *(float4*)(Rp + 8192) = make_float4(bb[0], bb[1], bb[2], bb[3]); *(float4*)(Rp + 8196) = make_float4(bb[4], bb[5], bb[6], bb[7]);
    V[0] = v[0]; V[1] = v[1];
}

__device__ __forceinline__ void flush_y(const Args& a, const ChunkD& d, const float* Yb, int ptid) {
    if (!d.valid) return;
    float* yraw = (float*)(a.ws + WS_XB) + (size_t)d.mixer * TT * 256;
    for (int e = ptid; e < d.n * 16; e += 256) {
        const float4* yp = (const float4*)(Yb + e * 16);
        const float4 a0 = yp[0], a1 = yp[1], a2 = yp[2], a3 = yp[3];
        const float y = ((a0.x + a0.y) + (a0.z + a0.w)) + ((a1.x + a1.y) + (a1.z + a1.w)) + ((a2.x + a2.y) + (a2.z + a2.w)) + ((a3.x + a3.y) + (a3.z + a3.w));
        const int st = e >> 4, c = e & 15; yraw[(size_t)(d.row0 + d.t0 + st) * 256 + d.h * 64 + d.cg * 16 + c] = y;
    }
}

typedef float f2 __attribute__((ext_vector_type(2)));
struct Ops { f32x4 r, w, k, q, b; float v; };
__device__ __forceinline__ void ops_load(Ops& o, const float* Rb, const float* Vb, int st) {
    o.r = *(const f32x4*)(Rb + st * 64); o.w = *(const f32x4*)(Rb + 2048 + st * 64); o.k = *(const f32x4*)(Rb + 4096 + st * 64);
    o.q = *(const f32x4*)(Rb + 6144 + st * 64); o.b = *(const f32x4*)(Rb + 8192 + st * 64); o.v = Vb[st * 16];
}
__device__ __forceinline__ void scan_step(const Ops& o, f2& S01, f2& S23, float* Yp) {
    const f2 p2 = o.q.xy * S01 + o.q.zw * S23;
    const float sk = dpp_sum16(p2.x + p2.y);
    const f2 vv = {o.v, o.v}, sk2 = {sk, sk};
    const f2 t01 = o.k.xy * vv - o.b.xy * sk2, t23 = o.k.zw * vv - o.b.zw * sk2;
    S01 = o.w.xy * S01 + t01; S23 = o.w.zw * S23 + t23;
    const f2 y2 = o.r.xy * S01 + o.r.zw * S23;
    *Yp = y2.x + y2.y;
}
__device__ __forceinline__ const float* state_in_ptr(const Args& a, int l, const ChunkD& d, int kg, int cc) {
    return a.in[d.mixer ? I_SCW : I_SBS] + ((((size_t)l * 128 + d.b) * 4 + d.h) * 64 + 4 * kg) * 64 + d.cg * 16 + cc;
}
__device__ __forceinline__ void consume_chunk(const Args& a, int l, const ChunkD& d, const ChunkD& nx, const float* ob, float* Yb, f2& S01, f2& S23, float (&Sn)[4], int wave, int lane) {
    const int kg = lane & 15, cc = wave * 4 + (lane >> 4);
    if (d.first) {
        if (d.sample) { S01.x = Sn[0]; S01.y = Sn[1]; S23.x = Sn[2]; S23.y = Sn[3]; }
        else { S01.x = 0.f; S01.y = 0.f; S23.x = 0.f; S23.y = 0.f; }
    }
    if (nx.valid && nx.first && nx.sample) { const float* sp = state_in_ptr(a, l, nx, kg, cc); Sn[0] = sp[0]; Sn[1] = sp[64]; Sn[2] = sp[128]; Sn[3] = sp[192]; }
    const float* Rb = ob + 4 * kg; const float* Vb = ob + 10240 + cc; float* Yp = Yb + cc * 16 + kg;
    Ops o0, o1, o2;
    ops_load(o0, Rb, Vb, 0); ops_load(o1, Rb, Vb, 1);
    for (int st = 0; st < d.n; st += 4) {
        ops_load(o2, Rb, Vb, st + 2); scan_step(o0, S01, S23, Yp + st * 256);
        ops_load(o0, Rb, Vb, st + 3); scan_step(o1, S01, S23, Yp + (st + 1) * 256);
        ops_load(o1, Rb, Vb, st + 4); scan_step(o2, S01, S23, Yp + (st + 2) * 256);
        ops_load(o2, Rb, Vb, st + 5); scan_step(o0, S01, S23, Yp + (st + 3) * 256);
        o0 = o1; o1 = o2;
    }
    if (d.last) {
        size_t off;
        if (d.sample) off = (d.mixer ? O_SCW : O_SBS) + ((((size_t)l * 128 + d.b) * 4 + d.h) * 64 + 4 * kg) * 64 + d.cg * 16 + cc;
        else off = (d.mixer ? O_PCW : O_PBS) + ((((size_t)l * 8 + d.b) * 4 + d.h) * 64 + 4 * kg) * 64 + d.cg * 16 + cc;
        float* sp = a.out + off;
        sp[0] = S01.x; sp[64] = S01.y; sp[128] = S23.x; sp[192] = S23.y;
    }
}

__device__ __forceinline__ void sample_item(const Args& a, int l, int it, float* wl  , int lane) {
    const int mixer = it & 1, h = (it >> 1) & 3, b = it >> 3;
    const bf16* P = (const bf16*)(a.ws + WS_P);
    const int row0 = T_P + b * 4;
    float S[64];
    {
        const float* sp = a.in[mixer ? I_SCW : I_SBS] + (((size_t)l * 128 + b) * 4 + h) * 4096 + lane;
#pragma unroll
        for (int k = 0; k < 64; ++k) S[k] = sp[k * 64];
    }
    float* yraw = (float*)(a.ws + WS_XB) + (size_t)mixer * TT * 256;
    const int ch = h * 64 + lane;
    float cq[4], ck[4], cv[4], mur = 0.f, muk = 0.f, muv = 0.f, kkw = 0.f, kaw = 0.f, rkw = 0.f, alog = 0.f, dtb = 0.f;
    if (mixer == 0) {
#pragma unroll
        for (int k = 0; k < 4; ++k) { const float* cw = a.in[I_BCW] + ((size_t)l * 4 + k) * 768; cq[k] = cw[ch]; ck[k] = cw[256 + ch]; cv[k] = cw[512 + ch]; }
        alog = a.in[I_BAL][l * 4 + h]; dtb = a.in[I_BDT][l * 4 + h];
    } else {
#pragma unroll
        for (int k = 0; k < 4; ++k) { cq[k] = 0.f; ck[k] = 0.f; cv[k] = 0.f; }
        const float* mu = a.in[I_CMU] + l * 1024; mur = mu[ch]; muk = mu[256 + ch]; muv = mu[512 + ch];
        kkw = a.in[I_CKK][l * 256 + ch]; kaw = a.in[I_CKA][l * 256 + ch]; rkw = a.in[I_CRK][l * 256 + ch];
    }
    float xq[7], xk[7], xv[7];
    if (mixer == 0) {
        const float* sb = a.in[I_SBC] + ((size_t)l * 128 + b) * 3 * 768;
#pragma unroll
        for (int j = 0; j < 3; ++j) { xq[j] = sb[j * 768 + ch]; xk[j] = sb[j * 768 + 256 + ch]; xv[j] = sb[j * 768 + 512 + ch]; }
#pragma unroll
        for (int j = 0; j < 4; ++j) { const bf16* pr = P + (size_t)(row0 + j) * PN + PC_BQ; xq[3 + j] = bf2f(pr[ch]); xk[3 + j] = bf2f(pr[256 + ch]); xv[3 + j] = bf2f(pr[512 + ch]); }
    } else {
        const float* sc = a.in[I_SCS] + ((size_t)l * 128 + b) * 1024;
        xq[0] = 0.f; xk[0] = 0.f; xv[0] = 0.f; xq[1] = 0.f; xk[1] = 0.f; xv[1] = 0.f;
        xq[2] = sc[ch]; xk[2] = sc[256 + ch]; xv[2] = sc[512 + ch];
#pragma unroll
        for (int j = 0; j < 4; ++j) { const bf16* pr = P + (size_t)(row0 + j) * PN + PC_C; xq[3 + j] = bf2f(pr[ch]); xk[3 + j] = bf2f(pr[256 + ch]); xv[3 + j] = bf2f(pr[512 + ch]); }
    }
#pragma unroll
    for (int t = 0; t < 4; ++t) {
        const int row = row0 + t;
        float r, w, k, kk, bb, v;
        if (mixer == 0) {
            const float q0 = silu(xq[t] * cq[0] + xq[t + 1] * cq[1] + xq[t + 2] * cq[2] + xq[t + 3] * cq[3]);
            const float k0 = silu(xk[t] * ck[0] + xk[t + 1] * ck[1] + xk[t + 2] * ck[2] + xk[t + 3] * ck[3]);
            v = silu(xv[t] * cv[0] + xv[t + 1] * cv[1] + xv[t + 2] * cv[2] + xv[t + 3] * cv[3]);
            const float iq = rsqrtf(wave_sum(q0 * q0) + 1e-6f) * 0.125f, ik = rsqrtf(wave_sum(k0 * k0) + 1e-6f);
            const float* ba = (const float*)(a.ws + WS_BA) + (size_t)row * 8;
            const float beta = sigm(ba[h]);
            const float dec = __expf(-__expf(alog) * softplus_(ba[4 + h] + dtb));
            const float kn = k0 * ik; r = q0 * iq; w = dec; kk = kn; k = beta * kn; bb = dec * beta * kn;
        } else {
            r = xq[3 + t] + (xq[2 + t] - xq[3 + t]) * mur;
            const float kx = xk[3 + t] + (xk[2 + t] - xk[3 + t]) * muk;
            v = xv[3 + t] + (xv[2 + t] - xv[3 + t]) * muv;
            w = ((const float*)(a.ws + WS_AUXW))[(size_t)row * 256 + ch];
            const float av = bf2f(((const bf16*)(a.ws + WS_AUXA))[(size_t)row * 256 + ch]);
            const float kr = kx * kkw;
            kk = kr * rsqrtf(wave_sum(kr * kr) + 1e-6f);
            k = kx * (1.f + (av - 1.f) * kaw); bb = kk * av;
            const float rk = wave_sum(r * k * rkw);
            if (lane == 0) ((float*)(a.ws + WS_RK))[(size_t)row * 4 + h] = rk;
        }
        wl[lane] = r; wl[64 + lane] = w; wl[128 + lane] = k; wl[192 + lane] = kk; wl[256 + lane] = bb;
        LDS_WAIT();
        float sk = 0.f;
#pragma unroll
        for (int k4 = 0; k4 < 16; ++k4) { const float4 x = *(const float4*)(wl + 192 + 4 * k4); sk += (x.x * S[4 * k4] + x.y * S[4 * k4 + 1]) + (x.z * S[4 * k4 + 2] + x.w * S[4 * k4 + 3]); }
        float y = 0.f;
#pragma unroll
        for (int k4 = 0; k4 < 16; ++k4) {
            const float4 ww = *(const float4*)(wl + 64 + 4 * k4), kx4 = *(const float4*)(wl + 128 + 4 * k4), b4 = *(const float4*)(wl + 256 + 4 * k4), r4 = *(const float4*)(wl + 4 * k4);
            S[4 * k4 + 0] = ww.x * S[4 * k4 + 0] + (kx4.x * v - b4.x * sk); S[4 * k4 + 1] = ww.y * S[4 * k4 + 1] + (kx4.y * v - b4.y * sk);
            S[4 * k4 + 2] = ww.z * S[4 * k4 + 2] + (kx4.z * v - b4.z * sk); S[4 * k4 + 3] = ww.w * S[4 * k4 + 3] + (kx4.w * v - b4.w * sk);
            y += (r4.x * S[4 * k4 + 0] + r4.y * S[4 * k4 + 1]) + (r4.z * S[4 * k4 + 2] + r4.w * S[4 * k4 + 3]);
        }
        yraw[(size_t)row * 256 + ch] = y;
        LDS_WAIT();
    }
    {
        float* sp = a.out + (mixer ? O_SCW : O_SBS) + (((size_t)l * 128 + b) * 4 + h) * 4096 + lane;
#pragma unroll
        for (int k = 0; k < 64; ++k) sp[k * 64] = S[k];
    }
}

__device__ __forceinline__ void phase_scan(const Args& a, int l, unsigned char* lds, int mode = 0) {
    const int tid = otid(), lane = tid & 63, wave = __builtin_amdgcn_readfirstlane(tid >> 6);
    const int G = gridDim.x, g = blockIdx.x;
    float* OB = (float*)lds;
    float* YB = OB + 2 * OPB_FLOATS + 512;
    float* CST = YB + 2 * 8192;
    const bool prod = wave >= 4; const int ptid = tid - 256;
    ChunkD cp = get_chunk(0, g, G, mode), c0 = cp, c1 = get_chunk(1, g, G, mode), c2 = get_chunk(2, g, G, mode);
    Raw RA, RB;
    f2 S01 = {0.f, 0.f}, S23 = {0.f, 0.f}; float Sn[4] = {0.f, 0.f, 0.f, 0.f};
    if (prod) { raw_load(a, l, c0, ptid, RA); prep_math(a, l, c0, RA, OB, CST, ptid); raw_load(a, l, c1, ptid, RA); }
    else if (c0.valid && c0.first && c0.sample) { const float* sp = state_in_ptr(a, l, c0, lane & 15, wave * 4 + (lane >> 4)); Sn[0] = sp[0]; Sn[1] = sp[64]; Sn[2] = sp[128]; Sn[3] = sp[192]; }
    __syncthreads();
    int idx = 0;
    while (c0.valid) {
        if (!prod) consume_chunk(a, l, c0, c1, OB + (idx & 1) * OPB_FLOATS, YB + (idx & 1) * 8192, S01, S23, Sn, wave, lane);
        else { raw_load(a, l, c2, ptid, RB); prep_math(a, l, c1, RA, OB + ((idx + 1) & 1) * OPB_FLOATS, CST, ptid); if (idx > 0) flush_y(a, cp, YB + ((idx - 1) & 1) * 8192, ptid); }
        __syncthreads();
        cp = c0; c0 = c1; c1 = c2; c2 = get_chunk(idx + 3, g, G, mode); ++idx;
        if (!c0.valid) break;
        if (!prod) consume_chunk(a, l, c0, c1, OB + (idx & 1) * OPB_FLOATS, YB + (idx & 1) * 8192, S01, S23, Sn, wave, lane);
        else { raw_load(a, l, c2, ptid, RA); prep_math(a, l, c1, RB, OB + ((idx + 1) & 1) * OPB_FLOATS, CST, ptid); flush_y(a, cp, YB + ((idx - 1) & 1) * 8192, ptid); }
        __syncthreads();
        cp = c0; c0 = c1; c1 = c2; c2 = get_chunk(idx + 3, g, G, mode); ++idx;
    }
    if (prod && idx > 0) flush_y(a, cp, YB + ((idx - 1) & 1) * 8192, ptid);
    __syncthreads();
    if (mode != 1) {
        float* wl = (float*)lds + wave * 320;
        if ((G & 1) == 0) { if (g & 1) for (int it = (g >> 1) * 8 + wave; it < 1024; it += (G >> 1) * 8) sample_item(a, l, it, wl, lane); }
        else for (int it = g * 8 + wave; it < 1024; it += G * 8) sample_item(a, l, it, wl, lane);
        __syncthreads();
        if (G == 256 && !MK_PER_PHASE && (g & 1)) gmlp_sample_item(a, l, g >> 1, (float*)lds);
    }
}

__device__ __forceinline__ void phase_post(const Args& a, int l) {
    const int tid = otid(), lane = tid & 63, wave = tid >> 6;
    const int gw = blockIdx.x * 8 + wave, NGW = gridDim.x * 8;
    const bf16* P = (const bf16*)(a.ws + WS_P);
    bf16* mixed = (bf16*)(a.ws + WS_MIXED);
    const float* yraw = (const float*)(a.ws + WS_XB);
    const int h = lane >> 4, col = lane * 4;
    for (int r = gw; r < TT; r += NGW) {
        const bf16* Prow = P + (size_t)r * PN;
        {
            const float4 o = *(const float4*)(yraw + (size_t)r * 256 + col);
            const float ss = sum16((o.x * o.x + o.y * o.y) + (o.z * o.z + o.w * o.w));
            const float rstd = rsqrtf(ss * (1.f / 64.f) + NORM_EPS);
            float gt[4]; ld4(Prow + PC_BG + col, gt);
            const float* on = a.in[I_BON] + l * 64 + (col & 63);
            uint2 w; w.x = pk2(o.x * rstd * on[0] * silu(gt[0]), o.y * rstd * on[1] * silu(gt[1])); w.y = pk2(o.z * rstd * on[2] * silu(gt[2]), o.w * rstd * on[3] * silu(gt[3]));
            *(uint2*)(mixed + (size_t)r * 1024 + 256 + col) = w;
        }
        {
            const float4 y = *(const float4*)(yraw + (size_t)TT * 256 + (size_t)r * 256 + col);
            const float mean = sum16((y.x + y.y) + (y.z + y.w)) * (1.f / 64.f);
            const float d0 = y.x - mean, d1 = y.y - mean, d2 = y.z - mean, d3 = y.w - mean;
            const float var = sum16((d0 * d0 + d1 * d1) + (d2 * d2 + d3 * d3)) * (1.f / 64.f);
            const float rstd = rsqrtf(var + 64e-5f);
            float vc[4], vp[4], gg[4]; ld4(Prow + PC_C + 512 + col, vc); prev_c<4>(a, l, r, 512 + col, vp);
            ld4((const bf16*)(a.ws + WS_AUXG) + (size_t)r * 256 + col, gg);
            const float* mu = a.in[I_CMU] + l * 1024 + 512 + col;
            const float* lg = a.in[I_CLG] + l * 256 + col; const float* lb = a.in[I_CLB] + l * 256 + col;
            const float rk = ((const float*)(a.ws + WS_RK))[(size_t)r * 4 + h];
            const float dd[4] = {d0, d1, d2, d3}; float o[4];
#pragma unroll
            for (int i = 0; i < 4; ++i) { const float v = vc[i] + (vp[i] - vc[i]) * mu[i]; o[i] = (dd[i] * rstd * lg[i] + lb[i] + rk * v) * gg[i]; }
            uint2 w; w.x = pk2(o[0], o[1]); w.y = pk2(o[2], o[3]);
            *(uint2*)(mixed + (size_t)r * 1024 + 512 + col) = w;
        }
    }
}

__device__ __forceinline__ void phase_final(const Args& a) {
    const int tid = otid(), lane = tid & 63, wave = tid >> 6;
    const int gw = blockIdx.x * 8 + wave, NGW = gridDim.x * 8;
    const float* rss = (const float*)(a.ws + WS_ROWSS) + 4 * TT;
    for (int r = gw; r < TT; r += NGW) {
        const float rs = rsqrtf(rss[r] * (1.f / 1024.f) + NORM_EPS);
        float4* xo = (float4*)(a.out + (size_t)r * 1024);
#pragma unroll
        for (int j = 0; j < 4; ++j) { float4 v = xo[lane + 64 * j]; const float4 g = ((const float4*)a.in[I_FG])[lane + 64 * j]; v.x *= rs * g.x; v.y *= rs * g.y; v.z *= rs * g.z; v.w *= rs * g.w; xo[lane + 64 * j] = v; }
    }
}

#ifndef MK_PER_PHASE
#define MK_PER_PHASE 0
#endif
#ifndef USE_SKINNY
#define USE_SKINNY 0
#endif
constexpr int GM = USE_SKINNY ? T_P : TT;
#ifndef SCAN_PROBE_MODE
#define SCAN_PROBE_MODE 0
#endif
#ifndef PRE_PROBE_MODE
#define PRE_PROBE_MODE 0
#endif
#ifndef REP_P0
#define REP_P0 1
#endif
#ifndef REP_GIN
#define REP_GIN 1
#endif
#ifndef REP_PRE
#define REP_PRE 1
#endif
#ifndef REP_SCAN
#define REP_SCAN 1
#endif
#ifndef REP_POST
#define REP_POST 1
#endif
#ifndef REP_GUP
#define REP_GUP 1
#endif
__global__ void __launch_bounds__(512, 2) mk_fwd(Args a) {
    extern __shared__ __attribute__((aligned(16))) unsigned char lds[];
    cg::grid_group grid = cg::this_grid();
    const int lo = a.ph_lo, hi = a.ph_hi, G = gridDim.x;
    volatile LAS unsigned* bst = (volatile LAS unsigned*)((LAS unsigned char*)lds + (LDS_BYTES - 16));
    if (threadIdx.x < 4) bst[threadIdx.x] = 0u;
    __syncthreads();
    XcdBarrier xbar; xbar.bar = (unsigned*)(a.ws + WS_BAR); xbar.x = 0; xbar.st = nullptr;
    if (!MK_PER_PHASE) xbar = xcd_barrier_post((unsigned*)(a.ws + WS_BAR), bst);
#define IN(k) (lo <= (k) && (k) < hi)
#define SEAM(k) do { if (lo <= (k) && (k) + 1 < hi) { if ((k) == 0) grid.sync(); else xcd_barrier(xbar); } } while (0)
#define REPEAT(n) for (int rep_ = 0; rep_ < (n); ++rep_, (rep_ < (n) ? xcd_barrier(xbar) : (void)0))
    float* rowss = (float*)(a.ws + WS_ROWSS);
    bf16* xb = (bf16*)(a.ws + WS_XB); bf16* P = (bf16*)(a.ws + WS_P); bf16* mixed = (bf16*)(a.ws + WS_MIXED); bf16* hid = (bf16*)(a.ws + WS_HID);
    if (IN(0)) REPEAT(REP_P0) phase0(a, lds);
    SEAM(0);
    for (int l = 0; l < 2; ++l) {
        const int pb = 1 + 7 * l;
        const bf16* wb = (const bf16*)(a.ws + WS_W) + (size_t)l * WL_ELEMS;
        if (IN(pb + 0)) REPEAT(REP_GIN) {
            pg8::Gemm g{xb, wb + WOFF_IN, GM, NIN, 1024}; pg8::StaticOrder S; S.init(GM, NIN, G, (int)blockIdx.x);
            EpiScale<false> E{P, PN, rowss + (2 * l) * TT, rowss + (5 + l) * TT};
            pg8::gemm_phase<EpiScale<false>, pg8::StaticOrder, true, true>((PG8_LAS unsigned char*)lds, g, S, E);
#if USE_SKINNY
            SkScale<false> E2{P, PN, rowss + (2 * l) * TT};
            skinny_gemm(xb + (size_t)T_P * 1024, wb + WOFF_IN, PN, 1024, E2);
#endif
        }
        SEAM(pb + 0);
        if (IN(pb + 1)) REPEAT(REP_PRE) phase_pre(a, l, lds, rep_ == 0 ? 0 : PRE_PROBE_MODE);
        SEAM(pb + 1);
        if (IN(pb + 2)) REPEAT(REP_SCAN) phase_scan(a, l, lds, rep_ == 0 ? 0 : SCAN_PROBE_MODE);
        SEAM(pb + 2);
        if (IN(pb + 3)) REPEAT(REP_POST) phase_post(a, l);
        SEAM(pb + 3);
        if (IN(pb + 4)) {
            pg8::Gemm g{mixed, wb + WOFF_OUT, GM, 1024, 1024};
            if (G == 256 && !USE_SKINNY && !MK_PER_PHASE) {
                DownOrder S; S.c = (int)blockIdx.x; S.snt = 2;
                EpiResSplit E{a.out, xb, rowss + (2 * l + 1) * TT, (float*)(a.ws + WS_AUXW), l == 0 ? a.in[I_XP] : nullptr, l == 0 ? a.in[I_XS] : nullptr};
                pg8::gemm_phase<EpiResSplit, DownOrder, true, true>((PG8_LAS unsigned char*)lds, g, S, E);
                xcd_barrier(xbar);
                sample_fix(a, rowss + (2 * l + 1) * TT, (const float*)(a.ws + WS_AUXW), l == 0 ? a.in[I_XS] : nullptr);
            } else {
                pg8::StaticOrder S; S.init(GM, 1024, G, (int)blockIdx.x);
                EpiRes E{a.out, xb, rowss + (2 * l + 1) * TT, l == 0 ? a.in[I_XP] : nullptr, l == 0 ? a.in[I_XS] : nullptr};
                pg8::gemm_phase<EpiRes, pg8::StaticOrder, true, true>((PG8_LAS unsigned char*)lds, g, S, E);
#if USE_SKINNY
                SkRes E2{a.out, xb, rowss + (2 * l + 1) * TT};
                skinny_gemm(mixed + (size_t)T_P * 1024, wb + WOFF_OUT, 1024, 1024, E2);
#endif
            }
        }
        SEAM(pb + 4);
        if (IN(pb + 5)) REPEAT(REP_GUP) {
            pg8::Gemm g{xb, wb + WOFF_UP, GM, FF, 1024}; pg8::StaticOrder S; S.init(GM, FF, G, (int)blockIdx.x);
            EpiScale<true> E{hid, FF, rowss + (2 * l + 1) * TT};
            pg8::gemm_phase<EpiScale<true>, pg8::StaticOrder, true, true>((PG8_LAS unsigned char*)lds, g, S, E);
            if (l == 0 && !MK_PER_PHASE && G == 256 && blockIdx.x >= 32) {
                const int tid_ = otid();
                convert_layer(a, 1, (float*)(lds + (tid_ >> 6) * 16384), ((int)blockIdx.x - 32) * 8 + (tid_ >> 6), (G - 32) * 8, tid_ & 63);
            }
#if USE_SKINNY
            SkScale<true> E2{hid, FF, rowss + (2 * l + 1) * TT};
            skinny_gemm(xb + (size_t)T_P * 1024, wb + WOFF_UP, FF, 1024, E2);
#endif
        }
        SEAM(pb + 5);
        if (IN(pb + 6)) {
            pg8::Gemm g{hid, wb + WOFF_DOWN, GM, 1024, FF};
            if (G == 256 && !USE_SKINNY && !MK_PER_PHASE) {
                DownOrder S; S.c = (int)blockIdx.x; S.snt = 8;
                if (l == 1) {
                    EpiResFinal E{a.out, rowss + 4 * TT, (float*)(a.ws + WS_AUXW), a.in[I_FG], (unsigned*)(a.ws + WS_PCNT)};
                    pg8::gemm_phase<EpiResFinal, DownOrder, true, true>((PG8_LAS unsigned char*)lds, g, S, E);
                    xcd_barrier(xbar);
                    sample_fix_final(a, (const float*)(a.ws + WS_AUXW));
                } else {
                EpiResSplit E{a.out, xb, rowss + (2 * l + 2) * TT, (float*)(a.ws + WS_AUXW), nullptr, nullptr};
                pg8::gemm_phase<EpiResSplit, DownOrder, true, true>((PG8_LAS unsigned char*)lds, g, S, E);
                xcd_barrier(xbar);
                sample_fix(a, rowss + (2 * l + 2) * TT, (const float*)(a.ws + WS_AUXW));
                }
            } else {
                pg8::StaticOrder S; S.init(GM, 1024, G, (int)blockIdx.x);
                EpiRes E{a.out, xb, rowss + (2 * l + 2) * TT, nullptr, nullptr};
                pg8::gemm_phase<EpiRes, pg8::StaticOrder, true, true>((PG8_LAS unsigned char*)lds, g, S, E);
#if USE_SKINNY
                SkRes E2{a.out, xb, rowss + (2 * l + 2) * TT};
                skinny_gemm(hid + (size_t)T_P * FF, wb + WOFF_DOWN, 1024, FF, E2);
#endif
            }
        }
        if (!(l == 1 && G == 256 && !USE_SKINNY && !MK_PER_PHASE)) SEAM(pb + 6);
    }
    if (IN(15) && !(G == 256 && !USE_SKINNY && !MK_PER_PHASE)) phase_final(a);
#undef IN
#undef SEAM
}

extern "C" void kernel_launch(void* const* d_in, const int* in_sizes, int n_in, void* d_out, int out_size, void* d_ws, size_t ws_size, hipStream_t stream) {
    static int grid = 0;
    if (grid == 0) {
        int dev = 0, cus = 0, per_cu = 0;
        (void)hipGetDevice(&dev);
        (void)hipDeviceGetAttribute(&cus, hipDeviceAttributeMultiprocessorCount, dev);
        if (hipFuncSetAttribute((const void*)mk_fwd, hipFuncAttributeMaxDynamicSharedMemorySize, LDS_BYTES) != hipSuccess) { fprintf(stderr, "kernel_launch: hipFuncSetAttribute failed\n"); }
        if (hipOccupancyMaxActiveBlocksPerMultiprocessor(&per_cu, (const void*)mk_fwd, 512, LDS_BYTES) != hipSuccess || per_cu < 1) { fprintf(stderr, "kernel_launch: occupancy query reports %d\n", per_cu); per_cu = 1; }
        (void)hipGetLastError();
        if (per_cu > 1) per_cu = 1;
        if (cus <= 0) cus = 256;
        grid = cus * per_cu;
    }
    Args a{};
    for (int i = 0; i < 34; ++i) a.in[i] = (const float*)d_in[i];
    a.out = (float*)d_out; a.ws = (unsigned char*)d_ws;
    (void)hipMemsetAsync((unsigned char*)d_ws + WS_BAR, 0, BAR_ZERO_BYTES, stream);
#if MK_PER_PHASE
    for (int ph = 0; ph < NPHASE; ++ph) { a.ph_lo = ph; a.ph_hi = ph + 1; hipLaunchKernelGGL(mk_fwd, dim3(grid), dim3(512), LDS_BYTES, stream, a); }
#else
    a.ph_lo = 0; a.ph_hi = NPHASE;
    void* args[] = {&a};
    const hipError_t e = hipLaunchCooperativeKernel((const void*)mk_fwd, dim3(grid), dim3(512), args, LDS_BYTES, stream);
    if (e != hipSuccess) fprintf(stderr, "cooperative launch failed: %s (grid %d)\n", hipGetErrorString(e), grid);
#endif
}
```
